# Optimizing an MI355X kernel written in HIP

```python
import math
import jax, jax.numpy as jnp
from jax import lax
import numpy as np

D_MODEL = 1024
BATCH = 8
SEQ = 2048
DEPTH = 4

M_HEADS = 4
M_HEAD_DIM = 64
M_CHUNK = 64
M_WIDTH = M_HEADS * M_HEAD_DIM
SB_HEADS = 4
SB_HEAD_DIM = 64
SB_BLOCK = 128
SB_WIDTH = SB_HEADS * SB_HEAD_DIM
G_HEADS = 4
G_HEAD_DIM = 128
G_CHUNK = 64
G_CONV = 4
G_WIDTH = G_HEADS * G_HEAD_DIM
D_MIX = M_WIDTH + SB_WIDTH + G_WIDTH
IN_SPLITS = (M_WIDTH, M_WIDTH, M_WIDTH, M_WIDTH, M_HEADS, M_HEADS,
             SB_WIDTH, SB_WIDTH, SB_WIDTH,
             G_WIDTH, G_WIDTH, G_WIDTH, G_WIDTH, G_HEADS, G_HEADS)
D_IN = sum(IN_SPLITS)
N_EXPERTS = 32
TOP_K = 4
D_FF = D_MODEL
SWIGLU_LIMIT = 7.0
SWIGLU_ALPHA = 1.702
MOE_BLOCK = 256
PLE_DIM = 256
DEEPNORM_ALPHA = (2 * DEPTH) ** 0.25
DEEPNORM_BETA = (8 * DEPTH) ** -0.25
LN_EPS = 1e-5
NORM_EPS = 1e-6

kernel_name = 'hybrid_mlstm_stickbreak_gdn_moe_deepnorm'

F32 = jnp.float32


def layer_norm(x, g, b):
    xf = x.astype(F32)
    mu = jnp.mean(xf, -1, keepdims=True)
    var = jnp.mean(jnp.square(xf - mu), -1, keepdims=True)
    return ((xf - mu) * lax.rsqrt(var + LN_EPS) * g + b).astype(x.dtype)


def rms_normalize(x):
    return x * lax.rsqrt(jnp.mean(x * x, -1, keepdims=True) + NORM_EPS)


def l2_normalize(x):
    return x * lax.rsqrt(jnp.sum(x * x, -1, keepdims=True) + NORM_EPS)


def split_heads(t, heads):
    B, S, W = t.shape
    return t.reshape(B, S, heads, W // heads).astype(F32)


def to_chunks(t, size):
    B, S, H = t.shape[:3]
    t = t.reshape((B, S // size, size, H) + t.shape[3:])
    return jnp.moveaxis(t, (1, 3), (0, 2))


def from_chunks(t):
    t = jnp.moveaxis(t, (0, 2), (1, 3))
    B, N, L, H, d = t.shape
    return t.reshape(B, N * L, H, d)


def causal_depthwise_conv(x, w):
    C = x.shape[-1]
    return lax.conv_general_dilated(x, w[:, None, :], window_strides=(1,),
                                    padding=[(w.shape[0] - 1, 0)],
                                    dimension_numbers=('NWC', 'WIO', 'NWC'),
                                    feature_group_count=C)


def mlstm_mixer(q, k, v, o_pre, i_pre, f_pre, i_bias, f_bias, norm_w):
    q = to_chunks(split_heads(q, M_HEADS), M_CHUNK)
    k = to_chunks(split_heads(k, M_HEADS), M_CHUNK) * (M_HEAD_DIM ** -0.5)
    v = to_chunks(split_heads(v, M_HEADS), M_CHUNK)
    log_i = to_chunks(i_pre.astype(F32) + i_bias.astype(F32), M_CHUNK)
    log_f = to_chunks(jax.nn.log_sigmoid(f_pre.astype(F32) + f_bias.astype(F32)), M_CHUNK)
    b = jnp.cumsum(log_f, axis=-1)
    causal = jnp.tril(jnp.ones((M_CHUNK, M_CHUNK), bool))
    log_w = jnp.where(causal, b[..., :, None] - b[..., None, :] + log_i[..., None, :], -jnp.inf)
    m_intra = jnp.max(log_w, -1)
    log_w_end = b[..., -1:] - b + log_i
    m_end = jnp.max(log_w_end, -1)

    def step(carry, xs):
        C, n, m = carry
        qc, kc, vc, bc, lw, mi, lwe, me = xs
        m_t = jnp.maximum(bc + m[..., None], mi)
        inter = jnp.exp(bc + m[..., None] - m_t)
        s = jnp.einsum('bhtd,bhsd->bhts', qc, kc) * jnp.exp(lw - m_t[..., None])
        num = inter[..., None] * jnp.einsum('bhtd,bhde->bhte', qc, C) + jnp.einsum('bhts,bhse->bhte', s, vc)
        den = inter * jnp.einsum('bhtd,bhd->bht', qc, n) + jnp.sum(s, -1)
        h = num / jnp.maximum(jnp.abs(den), jnp.exp(-m_t))[..., None]
        m_new = jnp.maximum(bc[..., -1] + m, me)
        carry_scale = jnp.exp(bc[..., -1] + m - m_new)
        wk = jnp.exp(lwe - m_new[..., None])[..., None] * kc
        C = carry_scale[..., None, None] * C + jnp.einsum('bhsd,bhse->bhde', wk, vc)
        n = carry_scale[..., None] * n + jnp.sum(wk, -2)
        return (C, n, m_new), h

    N, B, H, L, d = q.shape
    init = (jnp.zeros((B, H, d, d), F32), jnp.zeros((B, H, d), F32), jnp.full((B, H), -jnp.inf, F32))
    _, h = lax.scan(step, init, (q, k, v, b, log_w, m_intra, log_w_end, m_end))
    h = rms_normalize(from_chunks(h))
    h = h.reshape(B, N * L, H * d) * norm_w
    return jax.nn.sigmoid(o_pre.astype(F32)) * h


def stick_breaking_mixer(q, k, v, norm_w):
    q = split_heads(q, SB_HEADS) * (SB_HEAD_DIM ** -0.5)
    k = split_heads(k, SB_HEADS)
    v = split_heads(v, SB_HEADS)
    B, S, H, d = q.shape
    outs = []
    for start in range(0, S, SB_BLOCK):
        end = start + SB_BLOCK
        z = jnp.einsum('bqhd,bkhd->bhqk', q[:, start:end], k[:, :end])
        before = jnp.arange(end)[None, :] < jnp.arange(start, end)[:, None]
        log_keep = jnp.where(before, jax.nn.log_sigmoid(-z), 0.0)
        log_rest = lax.cumsum(log_keep, axis=3, reverse=True) - log_keep
        a = jnp.where(before, jnp.exp(jax.nn.log_sigmoid(z) + log_rest), 0.0)
        outs.append(jnp.einsum('bhqk,bkhd->bqhd', a, v[:, :end]))
    o = rms_normalize(jnp.concatenate(outs, axis=1))
    return o.reshape(B, S, H * d) * norm_w


def gated_deltanet_mixer(q, k, v, z, a, b, conv_w, A_log, dt_bias, norm_w):
    qkv = jnp.concatenate([q, k, v], -1).astype(F32)
    qkv = jax.nn.silu(causal_depthwise_conv(qkv, conv_w.astype(F32)))
    q, k, v = jnp.split(qkv, 3, axis=-1)
    q = l2_normalize(split_heads(q, G_HEADS)) * (G_HEAD_DIM ** -0.5)
    k = l2_normalize(split_heads(k, G_HEADS))
    v = split_heads(v, G_HEADS)
    B, S, H, d = q.shape
    beta = jax.nn.sigmoid(b.astype(F32))
    g = -jnp.exp(A_log.astype(F32)) * jax.nn.softplus(a.astype(F32) + dt_bias.astype(F32))
    q, k, v = to_chunks(q, G_CHUNK), to_chunks(k, G_CHUNK), to_chunks(v, G_CHUNK)
    beta = to_chunks(beta, G_CHUNK)
    gam = jnp.cumsum(to_chunks(g, G_CHUNK), axis=-1)
    incl = jnp.tril(jnp.ones((G_CHUNK, G_CHUNK), bool))
    strict = jnp.tril(jnp.ones((G_CHUNK, G_CHUNK), bool), -1)
    decay = jnp.exp(jnp.where(incl, gam[..., :, None] - gam[..., None, :], -jnp.inf))
    m = jnp.where(strict, beta[..., :, None] * jnp.einsum('nbhtd,nbhsd->nbhts', k, k) * decay, 0.0)
    rhs = jnp.concatenate([v * beta[..., None], k * (beta * jnp.exp(gam))[..., None]], -1)
    sol = lax.linalg.triangular_solve(m + jnp.eye(G_CHUNK, dtype=F32), rhs, left_side=True,
                                      lower=True, unit_diagonal=True)
    u, w = sol[..., :d], sol[..., d:]
    qk = jnp.einsum('nbhtd,nbhsd->nbhts', q, k) * decay
    q_dec = q * jnp.exp(gam)[..., None]
    k_dec = k * jnp.exp(gam[..., -1:] - gam)[..., None]
    chunk_decay = jnp.exp(gam[..., -1])

    def step(state, xs):
        uc, wc, qkc, qdc, kdc, cd = xs
        v_new = uc - jnp.einsum('bhtd,bhde->bhte', wc, state)
        o = jnp.einsum('bhtd,bhde->bhte', qdc, state) + jnp.einsum('bhts,bhse->bhte', qkc, v_new)
        state = cd[..., None, None] * state + jnp.einsum('bhtd,bhte->bhde', kdc, v_new)
        return state, o

    _, o = lax.scan(step, jnp.zeros((B, H, d, d), F32), (u, w, qk, q_dec, k_dec, chunk_decay))
    o = rms_normalize(from_chunks(o)) * norm_w
    return o.reshape(B, S, H * d) * jax.nn.silu(z.astype(F32))


def moe_ffn(x, w_router, b_router, w_gu, b_gu, w_down, b_down):
    B, S, D = x.shape
    T = B * S
    xf = x.reshape(T, D)
    logits = xf.astype(F32) @ w_router.astype(F32) + b_router.astype(F32)
    top_vals, top_idx = lax.top_k(logits, TOP_K)
    gates = jax.nn.softmax(top_vals, axis=-1)
    A = T * TOP_K
    flat_e = top_idx.reshape(A)
    flat_tok = jnp.arange(A, dtype=jnp.int32) // TOP_K
    flat_gate = gates.reshape(A)
    order = jnp.argsort(flat_e)
    e_sorted = flat_e[order]
    counts = jnp.bincount(flat_e, length=N_EXPERTS)
    padded = (counts + MOE_BLOCK - 1) // MOE_BLOCK * MOE_BLOCK
    pad_end = jnp.cumsum(padded)
    pad_start = pad_end - padded
    grp_start = jnp.cumsum(counts) - counts
    dest = pad_start[e_sorted] + jnp.arange(A, dtype=jnp.int32) - grp_start[e_sorted]
    n_blocks = -(-A // MOE_BLOCK) + N_EXPERTS
    P = n_blocks * MOE_BLOCK
    slot_tok = jnp.zeros((P,), jnp.int32).at[dest].set(flat_tok[order])
    slot_gate = jnp.zeros((P,), F32).at[dest].set(flat_gate[order])
    block_e = jnp.minimum(jnp.searchsorted(pad_end, jnp.arange(n_blocks) * MOE_BLOCK, side='right'),
                          N_EXPERTS - 1)
    x_slots = xf[slot_tok].reshape(n_blocks, MOE_BLOCK, D)

    def expert_block(args):
        xb, e = args
        h = xb @ w_gu[e] + b_gu[e]
        gate, up = jnp.split(h, 2, axis=-1)
        gate = jnp.minimum(gate, SWIGLU_LIMIT)
        up = jnp.clip(up, -SWIGLU_LIMIT, SWIGLU_LIMIT)
        act = (up + 1.0) * gate * jax.nn.sigmoid(SWIGLU_ALPHA * gate)
        return act @ w_down[e] + b_down[e]

    y = lax.map(expert_block, (x_slots, block_e)).reshape(P, D)
    y = y * slot_gate[:, None].astype(y.dtype)
    out = jnp.zeros((T, D), y.dtype).at[slot_tok].add(y)
    return out.reshape(B, S, D).astype(x.dtype)


def decoder_layer(h, p_i, w_in, m_i_bias, m_f_bias, m_norm_w, sb_norm_w, g_conv_w, g_A_log,
                  g_dt_bias, g_norm_w, w_out, ln1_g, ln1_b, w_router, b_router, w_gu, b_gu,
                  w_down, b_down, w_ple_gate, w_ple_proj, ln2_g, ln2_b):
    u = h @ w_in
    offsets = [int(o) for o in np.cumsum(IN_SPLITS)[:-1]]
    (mq, mk, mv, mo, mi, mf, sq, sk, sv, gq, gk, gv, gz, ga, gb) = jnp.split(u, offsets, axis=-1)
    y_m = mlstm_mixer(mq, mk, mv, mo, mi, mf, m_i_bias, m_f_bias, m_norm_w)
    y_s = stick_breaking_mixer(sq, sk, sv, sb_norm_w)
    y_g = gated_deltanet_mixer(gq, gk, gv, gz, ga, gb, g_conv_w, g_A_log, g_dt_bias, g_norm_w)
    y = jnp.concatenate([y_m, y_s, y_g], axis=-1).astype(h.dtype)
    h = layer_norm(DEEPNORM_ALPHA * h + y @ w_out, ln1_g, ln1_b)
    ple = jax.nn.sigmoid(h @ w_ple_gate) * (p_i @ w_ple_proj)
    ffn = moe_ffn(h, w_router, b_router, w_gu, b_gu, w_down, b_down)
    return layer_norm(DEEPNORM_ALPHA * h + ffn + ple, ln2_g, ln2_b)


def setup_inputs(seed: int = 0) -> dict:
    key = jax.random.key(seed)
    ks = iter(jax.random.split(key, 32))
    L = DEPTH

    def normal(shape, scale):
        return jax.random.normal(next(ks), shape, F32) * scale

    x = normal((BATCH, SEQ, D_MODEL), 1.0)
    p = normal((DEPTH, BATCH, SEQ, PLE_DIM), 1.0)
    ln0_g = 1.0 + normal((D_MODEL,), 0.02)
    ln0_b = normal((D_MODEL,), 0.02)
    w_in = normal((L, D_MODEL, D_IN), D_MODEL ** -0.5)
    m_i_bias = -2.0 + normal((L, M_HEADS), 0.1)
    m_f_bias = jnp.linspace(3.0, 6.0, M_HEADS, dtype=F32)[None, :] + normal((L, M_HEADS), 0.1)
    m_norm_w = 1.0 + normal((L, M_WIDTH), 0.02)
    sb_norm_w = 1.0 + normal((L, SB_WIDTH), 0.02)
    g_conv_w = normal((L, G_CONV, 3 * G_WIDTH), G_CONV ** -0.5)
    g_A_log = jnp.log(jax.random.uniform(next(ks), (L, G_HEADS), F32, 1.0, 16.0))
    dt = jnp.exp(jax.random.uniform(next(ks), (L, G_HEADS), F32, math.log(1e-3), math.log(1e-1)))
    g_dt_bias = dt + jnp.log(-jnp.expm1(-dt))
    g_norm_w = 1.0 + normal((L, G_HEAD_DIM), 0.02)
    w_out = normal((L, D_MIX, D_MODEL), D_MIX ** -0.5 * DEEPNORM_BETA)
    ln1_g = 1.0 + normal((L, D_MODEL), 0.02)
    ln1_b = normal((L, D_MODEL), 0.02)
    w_router = normal((L, D_MODEL, N_EXPERTS), D_MODEL ** -0.5)
    b_router = normal((L, N_EXPERTS), 0.01)
    w_gu = normal((L, N_EXPERTS, D_MODEL, 2 * D_FF), D_MODEL ** -0.5)
    b_gu = normal((L, N_EXPERTS, 2 * D_FF), 0.01)
    w_down = normal((L, N_EXPERTS, D_FF, D_MODEL), D_FF ** -0.5 * DEEPNORM_BETA)
    b_down = normal((L, N_EXPERTS, D_MODEL), 0.01)
    w_ple_gate = normal((L, D_MODEL, D_MODEL), D_MODEL ** -0.5)
    w_ple_proj = normal((L, PLE_DIM, D_MODEL), PLE_DIM ** -0.5 * DEEPNORM_BETA)
    ln2_g = 1.0 + normal((L, D_MODEL), 0.02)
    ln2_b = normal((L, D_MODEL), 0.02)
    return {'x': x, 'p': p, 'ln0_g': ln0_g, 'ln0_b': ln0_b, 'w_in': w_in,
            'm_i_bias': m_i_bias, 'm_f_bias': m_f_bias, 'm_norm_w': m_norm_w,
            'sb_norm_w': sb_norm_w, 'g_conv_w': g_conv_w, 'g_A_log': g_A_log,
            'g_dt_bias': g_dt_bias, 'g_norm_w': g_norm_w, 'w_out': w_out,
            'ln1_g': ln1_g, 'ln1_b': ln1_b, 'w_router': w_router, 'b_router': b_router,
            'w_gu': w_gu, 'b_gu': b_gu, 'w_down': w_down, 'b_down': b_down,
            'w_ple_gate': w_ple_gate, 'w_ple_proj': w_ple_proj, 'ln2_g': ln2_g, 'ln2_b': ln2_b}


def reference(x, p, ln0_g, ln0_b, w_in, m_i_bias, m_f_bias, m_norm_w, sb_norm_w, g_conv_w,
              g_A_log, g_dt_bias, g_norm_w, w_out, ln1_g, ln1_b, w_router, b_router, w_gu,
              b_gu, w_down, b_down, w_ple_gate, w_ple_proj, ln2_g, ln2_b):
    h = layer_norm(x, ln0_g, ln0_b)
    for i in range(DEPTH):
        h = decoder_layer(h, p[i], w_in[i], m_i_bias[i], m_f_bias[i], m_norm_w[i], sb_norm_w[i],
                          g_conv_w[i], g_A_log[i], g_dt_bias[i], g_norm_w[i], w_out[i],
                          ln1_g[i], ln1_b[i], w_router[i], b_router[i], w_gu[i], b_gu[i],
                          w_down[i], b_down[i], w_ple_gate[i], w_ple_proj[i], ln2_g[i], ln2_b[i])
    return h
```

```cpp
#include <hip/hip_runtime.h>
#include <cstdio>
#include <cstdint>

#ifndef MK_MULTI
#define MK_MULTI 0
#endif

namespace {
#define LAS __attribute__((address_space(3)))
typedef unsigned short bf16_t;
typedef short bf16x8 __attribute__((ext_vector_type(8)));
typedef float f32x4 __attribute__((ext_vector_type(4)));
typedef unsigned u32x4 __attribute__((ext_vector_type(4)));
typedef unsigned u32x2 __attribute__((ext_vector_type(2)));
#define ST16_NT(p, v) (*(u32x4*)(p) = (v))

constexpr int D = 1024, BATCH = 8, SEQ = 2048, DEPTH = 4, T = BATCH * SEQ;
constexpr int DIN = 3856, NU = 3840, NINP = 4096;
constexpr int U_MQ = 0, U_MK = 256, U_MV = 512, U_MO = 768, U_SQ = 1024, U_SK = 1280, U_SV = 1536, U_GQ = 1792, U_GZ = 3328;
constexpr int NE = 32, DFF = 1024, MOEB = 256;
constexpr int NBLK = (T * 4) / MOEB + NE;
constexpr int PSLOTS = NBLK * MOEB;
constexpr float ALPHA = 1.6817928305074290f;
constexpr float LN_EPS = 1e-5f, NORM_EPS = 1e-6f;
constexpr int NTHREADS = 512, NWAVES = 8;

constexpr size_t MiB = 1u << 20;
constexpr size_t WS_CTL = 0;
constexpr size_t WS_HF = 1 * MiB;
constexpr size_t WS_HB = WS_HF + 64 * MiB;
constexpr size_t WS_H1F = WS_HB + 32 * MiB;
constexpr size_t WS_H1B = WS_H1F + 64 * MiB;
constexpr size_t WS_U16 = WS_H1B + 32 * MiB;
constexpr size_t WS_GT = WS_U16 + 120 * MiB;
constexpr size_t WS_Y = WS_GT + 1 * MiB;
constexpr size_t WS_TMP = WS_Y + 32 * MiB;
constexpr size_t WS_PLE = WS_TMP + 64 * MiB;
constexpr size_t WS_PB = WS_PLE + 64 * MiB;
constexpr size_t WS_GQ = WS_PB + 32 * MiB;
constexpr size_t WS_GK = WS_GQ + 32 * MiB;
constexpr size_t WS_GV = WS_GK + 32 * MiB;
constexpr size_t WS_GO = WS_GV + 32 * MiB;
constexpr size_t WS_HM = WS_GO + 32 * MiB;
constexpr size_t WS_YB = WS_HM + 144 * MiB;
constexpr size_t WS_RT = WS_YB + 144 * MiB;
constexpr size_t RT_TOPIDX = 0, RT_TOPGATE = 256 * 1024, RT_TOKSLOT = 512 * 1024, RT_SLOTTOK = 768 * 1024, RT_SLOTGATE = 1088 * 1024, RT_BLOCKE = 1408 * 1024, RT_WGCNT = 1536 * 1024  ;
constexpr size_t WS_W = WS_RT + 4 * MiB;
constexpr size_t W_IN = 0, W_OUT = 8 * MiB, W_PG = 10 * MiB, W_PP = 12 * MiB, W_GU = 13 * MiB, W_DN = 141 * MiB, W_LAYER = 205 * MiB;
constexpr size_t WS_END = WS_W + 4 * W_LAYER;
constexpr int CW_BAR = 4096;
constexpr int CW_SBQ = 8192;
constexpr size_t CTL_BYTES = 64 * 1024;
static_assert((CW_SBQ + 8 * 64) * 4 <= (int)CTL_BYTES, "control words inside the per-call memset");

struct Params { const float* in[26]; float* out; unsigned char* ws; };

__device__ __forceinline__ float bf2f(bf16_t b) { return __uint_as_float(((unsigned)b) << 16); }
typedef __bf16 bf16x2_t __attribute__((ext_vector_type(2)));
typedef float f32x2_t __attribute__((ext_vector_type(2)));
__device__ __forceinline__ unsigned cvt_pk_bf16(float lo, float hi) { const f32x2_t v = {lo, hi}; const bf16x2_t b = __builtin_convertvector(v, bf16x2_t); return __builtin_bit_cast(unsigned, b); }
__device__ __forceinline__ unsigned f2bf(float f) { unsigned u = __float_as_uint(f); return (u + 0x7fffu + ((u >> 16) & 1u)) >> 16; }
__device__ __forceinline__ unsigned pk2(float lo, float hi) { return cvt_pk_bf16(lo, hi); }
__device__ __forceinline__ int lane_id_opaque() { int l = (int)__builtin_amdgcn_mbcnt_hi(~0u, __builtin_amdgcn_mbcnt_lo(~0u, 0u)); asm volatile("" : "+v"(l)); return l; }
__device__ __forceinline__ float shx(float v, int o, int lane) { return __uint_as_float((unsigned)__builtin_amdgcn_ds_bpermute((lane ^ o) << 2, (int)__float_as_uint(v))); }
__device__ __forceinline__ int shxi(int v, int o, int lane) { return __builtin_amdgcn_ds_bpermute((lane ^ o) << 2, v); }
__device__ __forceinline__ float wave_sum(float v) {
    const int lane = lane_id_opaque();
#pragma unroll
    for (int o = 32; o >= 1; o >>= 1) v += shx(v, o, lane);
    return v;
}
__device__ __forceinline__ float rl(float x, int d) { return __uint_as_float((unsigned)__builtin_amdgcn_readlane((int)__float_as_uint(x), d)); }
__device__ __forceinline__ float sigmoidf_(float x) { return __builtin_amdgcn_rcpf(1.0f + __expf(-x)); }
__device__ __forceinline__ float softplusf_(float x) { return fmaxf(x, 0.f) + log1pf(__expf(-fabsf(x))); }
__device__ __forceinline__ float siluf_(float x) { return x * sigmoidf_(x); }

#define XB_TMO      128
#define XB_XCNT(j)  (256  + 64 * (j))
#define XB_XSUB(j)  (1280 + 64 * (j))
#define XB_XGEN(j)  (2304 + 64 * (j))
#define XB_TOP      3328
#define XB_TOPGEN   3392
#define XCD_BAR_WORDS 3456
#define XB_SPIN_CAP (1u << 18)
__device__ __forceinline__ unsigned xb_ld(unsigned* p)              { return __hip_atomic_load(p, __ATOMIC_RELAXED, __HIP_MEMORY_SCOPE_AGENT); }
__device__ __forceinline__ unsigned xb_add(unsigned* p, unsigned v) { return __hip_atomic_fetch_add(p, v, __ATOMIC_RELAXED, __HIP_MEMORY_SCOPE_AGENT); }
__device__ __forceinline__ unsigned xb_xcc_id() { return (unsigned)__builtin_amdgcn_s_getreg((3 << 11) | 20) & 0xFu; }
#define XB_SPIN(cond, bar) do { unsigned _sp = 0; while (cond) { __builtin_amdgcn_s_sleep(1); \
    if ((++_sp & 255u) == 0u) { if (xb_ld(&(bar)[XB_TMO])) break; if (_sp > XB_SPIN_CAP) { atomicAdd(&(bar)[XB_TMO], 1u); break; } } } } while (0)
struct XcdBarrier { unsigned* bar; unsigned x; volatile LAS unsigned* st; };
__device__ __forceinline__ XcdBarrier xcd_barrier_post(unsigned* bar, volatile LAS unsigned* st) {
    XcdBarrier b; b.bar = bar; b.x = xb_xcc_id(); b.st = st;
    if (threadIdx.x == 0) (void)xb_add(&bar[XB_XCNT(b.x)], 1u);
    return b;
}
__device__ __forceinline__ void xcd_barrier_complete(unsigned* bar, unsigned x, unsigned& nloc, unsigned& nx) {
    const unsigned G = gridDim.x * gridDim.y * gridDim.z;
    unsigned sum, cnt, mine, sp = 0u;
    for (;;) {
        sum = 0u; cnt = 0u; mine = 0u;
#pragma unroll
        for (unsigned j = 0; j < 16; ++j) { const unsigned c = xb_ld(&bar[XB_XCNT(j)]); sum += c; cnt += (c > 0u) ? 1u : 0u; mine = (j == x) ? c : mine; }
        if (sum == G) break;
        __builtin_amdgcn_s_sleep(1);
        if ((++sp & 255u) == 0u) { if (xb_ld(&bar[XB_TMO])) break; if (sp > XB_SPIN_CAP) { atomicAdd(&bar[XB_TMO], 1u); break; } }
    }
    nloc = mine > 0u ? mine : 1u; nx = cnt > 0u ? cnt : 1u;
}
__device__ __forceinline__ void xcd_barrier(const XcdBarrier& b) {
    asm volatile("s_waitcnt vmcnt(0)" ::: "memory");
    __syncthreads();
    if (threadIdx.x == 0) {
        unsigned* bar = b.bar;
        __builtin_amdgcn_s_waitcnt(0);
        unsigned nloc = b.st[0], nx = b.st[1];
        if (nloc == 0u) { xcd_barrier_complete(bar, b.x, nloc, nx); b.st[0] = nloc; b.st[1] = nx; }
        const unsigned old = xb_add(&bar[XB_XSUB(b.x)], 1u);
        const unsigned gen = old / nloc;
        if (old + 1u == (gen + 1u) * nloc) {
            __builtin_amdgcn_fence(__ATOMIC_RELEASE, "agent");
            asm volatile("s_waitcnt vmcnt(0)" ::: "memory");
            const unsigned og = xb_add(&bar[XB_TOP], 1u);
            const unsigned tg = og / nx;
            if (og + 1u == (tg + 1u) * nx) xb_add(&bar[XB_TOPGEN], 1u);
            else XB_SPIN(xb_ld(&bar[XB_TOPGEN]) == tg, bar);
            __builtin_amdgcn_fence(__ATOMIC_ACQUIRE, "agent");
            xb_add(&bar[XB_XGEN(b.x)], 1u);
            asm volatile("s_waitcnt vmcnt(0)" ::: "memory");
        } else {
            XB_SPIN(xb_ld(&bar[XB_XGEN(b.x)]) == gen, bar);
            __builtin_amdgcn_fence(__ATOMIC_ACQUIRE, "agent");
            asm volatile("s_waitcnt vmcnt(0)" ::: "memory");
        }
    }
    __syncthreads();
}

constexpr int BM = 256, BK = 64, HALF = 128, HTB = HALF * BK * 2, STAGE_BYTES = 8 * HTB, NXCD = 8, WGM = 8;
constexpr int LDS_TAB = STAGE_BYTES;
constexpr int LDS_UE = LDS_TAB + 12288;
constexpr int LDS_MISC = LDS_UE + 64;
constexpr int LDS_BYTES = 147456;
__host__ __device__ __forceinline__ int lds_byte(int r, int c) { const int st = (r >> 4) * 2 + (c >> 5), rr = r & 15, cc = c & 31, ob = rr * 64 + cc * 2; return st * 1024 + (ob ^ (((ob >> 9) & 1) << 5)); }
__host__ __device__ __forceinline__ void stage_rc(int b, int& R, int& C) { const int st = b / 1024, sb = b % 1024, swz = sb ^ (((sb >> 9) & 1) << 5); R = (st >> 1) * 16 + swz / 64; C = (st & 1) * 32 + (swz % 64) / 2; }
__host__ __device__ __forceinline__ int perm32(int rho) { const int n = rho >> 4, i = rho & 15; return 8 * (i >> 2) + 4 * n + (i & 3); }

constexpr int CV_IN = 16 * 31, CV_OUT = 16 * 8, CV_PG = 16 * 8, CV_PP = 4 * 8, CV_GU1 = 16 * 16, CV_DN1 = 16 * 8;
constexpr int CV_LAYER = CV_IN + CV_OUT + CV_PG + CV_PP + NE * CV_GU1 + NE * CV_DN1;
struct Unit { int pm, pn, e, L; };
__device__ __forceinline__ void convert_item(const Params& P, int l, int r, int lane);

struct DenseOrder {
    int nM, nN, nwg, G, c, K; const char* Bt;
    __device__ void init(int M, int N, int K_, const void* Bt_, int G_, int c_) { nM = M / BM; nN = N / BM; nwg = nM * nN; G = G_; c = c_; K = K_; Bt = (const char*)Bt_; }
    __device__ __forceinline__ bool next(int i, Unit& u) const {
        const long L = (long)i * G + c; if (L >= nwg) return false;
        int wgid = (int)L; { const int q = nwg / NXCD, r = nwg % NXCD, xcd = wgid % NXCD, off = wgid / NXCD; wgid = (xcd < r ? xcd * (q + 1) : r * (q + 1) + (xcd - r) * q) + off; }
        const int nig = WGM * nN, gid = wgid / nig, fm = gid * WGM, gsz = (nM - fm) < WGM ? (nM - fm) : WGM;
        u.pm = fm + ((wgid % nig) % gsz); u.pn = (wgid % nig) / gsz; u.e = 0; u.L = (int)L; return true;
    }
    __device__ __forceinline__ const char* b_base(const Unit& u) const { return Bt + (size_t)u.pn * BM * K * 2; }
    __device__ __forceinline__ unsigned a_off(int, const Unit& u, int row) const { return (unsigned)(u.pm * BM + row) * (unsigned)(K * 2); }
};
__device__ __forceinline__ bool moe_map(int i, int cm, int nblk, int nN, int& rb, int& pn) {
    const int x = cm >> 5, j = cm & 31, b0 = (x * nblk) >> 3, b1 = ((x + 1) * nblk) >> 3, q = i * 32 + j, rl = q / nN;
    rb = b0 + rl; pn = q - rl * nN; return rb < b1;
}
template <bool GATHER> struct MoeOrder {
    int nN, nunits, G, cm, K; const char* Wt; size_t estride; const LAS int* tab; const LAS int* ue;
    __device__ __forceinline__ bool next(int i, Unit& u) const {
        int rb, pn; if (!moe_map(i, cm, nunits / nN, nN, rb, pn)) return false;
        u.pm = rb; u.pn = pn; u.e = ue[i]; u.L = i * G + cm; return true;
    }
    __device__ __forceinline__ const char* b_base(const Unit& u) const { return Wt + (size_t)u.e * estride + (size_t)u.pn * BM * K * 2; }
    __device__ __forceinline__ unsigned a_off(int i, const Unit& u, int row) const {
        if (GATHER) return (unsigned)tab[i * 256 + row] * (unsigned)(K * 2);
        return (unsigned)(u.pm * BM + row) * (unsigned)(K * 2);
    }
};

template <class Epi, class Sched>
__device__ __forceinline__ void gemm_phase(LAS unsigned char* lds, const int tid, const char* Abase, const int K, const Sched& S, const Epi& E) {
    const int wid = __builtin_amdgcn_readfirstlane(tid >> 6), lane = tid & 63, wr = wid >> 2, wc = wid & 3, fr = lane & 15, fq = lane >> 4;
    const int nt = K / BK;
    int Rr[2]; unsigned cb[2], voffB[2];
#pragma unroll
    for (int i = 0; i < 2; ++i) { int R, C; stage_rc(tid * 16 + i * 8192, R, C); const int Rb = Epi::PERM ? ((R & ~31) + perm32(R & 31)) : R;
        Rr[i] = R; cb[i] = (unsigned)C * 2u; voffB[i] = (unsigned)(Rb * K + C) * 2u; }
    const size_t kstep = (size_t)(BK * 2);
    const size_t hstep = (size_t)HALF * K * 2;
    const unsigned ldsw = (unsigned)wid * 1024u;
    const int aoff = lds_byte(wr * 64 + fr, fq * 8), boff = lds_byte(wc * 32 + fr, fq * 8);
#define G_SA(b, h) (((b) * 2 + (h)) * HTB)
#define G_SB(b, h) ((4 + (b) * 2 + (h)) * HTB)
#define G_STAGE_B(bufoff, gbase) do { _Pragma("unroll") for (int _i = 0; _i < 2; ++_i) \
        __builtin_amdgcn_global_load_lds((const unsigned*)((const char*)(gbase) + voffB[_i]), (LAS unsigned*)(lds + (bufoff) + ldsw + _i * 8192), 16, 0, 0); } while (0)
#define G_STAGE_A(bufoff, kbyte, ao) do { _Pragma("unroll") for (int _i = 0; _i < 2; ++_i) \
        __builtin_amdgcn_global_load_lds((const unsigned*)(Abase + (size_t)(kbyte) + (ao)[_i]), (LAS unsigned*)(lds + (bufoff) + ldsw + _i * 8192), 16, 0, 0); } while (0)
#define G_LDA(dst, b, h) do { _Pragma("unroll") for (int m = 0; m < 4; ++m) _Pragma("unroll") for (int k = 0; k < 2; ++k) dst[m][k] = *(const LAS bf16x8*)(lds + G_SA(b, h) + aoff + m * 2048 + k * 1024); } while (0)
#define G_LDB(dst, b, h) do { _Pragma("unroll") for (int n = 0; n < 2; ++n) _Pragma("unroll") for (int k = 0; k < 2; ++k) dst[n][k] = *(const LAS bf16x8*)(lds + G_SB(b, h) + boff + n * 2048 + k * 1024); } while (0)
#define G_MMA(ai, bj, At, Bt) do { __builtin_amdgcn_s_setprio(1); _Pragma("unroll") for (int m = 0; m < 4; ++m) _Pragma("unroll") for (int n = 0; n < 2; ++n) _Pragma("unroll") for (int k = 0; k < 2; ++k) \
        acc[ai][bj][m][n] = __builtin_amdgcn_mfma_f32_16x16x32_bf16(Bt[n][k], At[m][k], acc[ai][bj][m][n], 0, 0, 0); __builtin_amdgcn_s_setprio(0); } while (0)
#define G_WAIT_V(n) asm volatile("s_waitcnt vmcnt(" #n ")" ::: "memory")
#define G_WAIT_L(n) asm volatile("s_waitcnt lgkmcnt(" #n ")" ::: "memory")
#define G_BAR __builtin_amdgcn_s_barrier()
#define G_SCHED __builtin_amdgcn_sched_barrier(0)
    Unit cur, nxt; int ui = 0;
    if (!S.next(0, cur)) return;
    f32x4 acc[2][2][4][2];
#pragma unroll
    for (int a = 0; a < 2; ++a)
#pragma unroll
        for (int b = 0; b < 2; ++b)
#pragma unroll
            for (int m = 0; m < 4; ++m)
#pragma unroll
                for (int n = 0; n < 2; ++n) acc[a][b][m][n] = (f32x4){0.f, 0.f, 0.f, 0.f};
    bf16x8 At[4][2], B0[2][2], B1[2][2];
    unsigned aoc[2][2], aon[2][2];
#pragma unroll
    for (int h = 0; h < 2; ++h)
#pragma unroll
        for (int i = 0; i < 2; ++i) aoc[h][i] = S.a_off(0, cur, h * HALF + Rr[i]) + cb[i];
    const char* cB = S.b_base(cur);
    G_STAGE_B(G_SB(0, 0), cB); G_STAGE_A(G_SA(0, 0), 0, aoc[0]); G_STAGE_B(G_SB(0, 1), cB + hstep); G_STAGE_A(G_SA(0, 1), 0, aoc[1]);
    if (wr == 1) G_BAR;
    G_WAIT_V(4); G_BAR;
    G_STAGE_B(G_SB(1, 0), cB + kstep); G_STAGE_A(G_SA(1, 0), kstep, aoc[0]); G_STAGE_B(G_SB(1, 1), cB + hstep + kstep);
    G_WAIT_V(6); G_BAR;
    for (;;) {
        const bool has_next = S.next(ui + 1, nxt);
        const char* nB = has_next ? S.b_base(nxt) : cB;
#pragma unroll
        for (int h = 0; h < 2; ++h)
#pragma unroll
            for (int i = 0; i < 2; ++i) aon[h][i] = has_next ? (S.a_off(ui + 1, nxt, h * HALF + Rr[i]) + cb[i]) : aoc[h][i];
        for (int t = 0; t < nt; t += 2) {
            const bool last = (t == nt - 2);
            const size_t k1 = (size_t)(t + 1) * kstep;
            const size_t k2 = last ? (size_t)0 : (size_t)(t + 2) * kstep;
            const char* b2 = last ? nB : cB + (size_t)(t + 2) * kstep;
            const char* b3 = b2 + kstep;
            unsigned a2o[2][2];
#pragma unroll
            for (int h = 0; h < 2; ++h)
#pragma unroll
                for (int i = 0; i < 2; ++i) a2o[h][i] = last ? aon[h][i] : aoc[h][i];
            G_LDB(B0, 0, 0); G_SCHED; G_LDA(At, 0, 0); G_STAGE_A(G_SA(1, 1), k1, aoc[1]);
            G_WAIT_L(8); G_BAR; G_WAIT_L(0); G_MMA(0, 0, At, B0); G_BAR; G_SCHED;
            G_LDB(B1, 0, 1); G_STAGE_B(G_SB(0, 0), b2);
            G_BAR; G_WAIT_L(0); G_MMA(0, 1, At, B1); G_BAR;
            G_LDA(At, 0, 1); G_STAGE_A(G_SA(0, 0), k2, a2o[0]);
            G_BAR; G_WAIT_L(0); G_MMA(1, 0, At, B0); G_BAR; G_SCHED;
            G_STAGE_B(G_SB(0, 1), b2 + hstep);
            G_WAIT_V(6); G_BAR; G_MMA(1, 1, At, B1); G_BAR;
            G_LDB(B0, 1, 0); G_SCHED; G_LDA(At, 1, 0); G_STAGE_A(G_SA(0, 1), k2, a2o[1]);
            G_WAIT_L(8); G_BAR; G_WAIT_L(0); G_MMA(0, 0, At, B0); G_BAR; G_SCHED;
            G_LDB(B1, 1, 1); G_STAGE_B(G_SB(1, 0), b3);
            G_BAR; G_WAIT_L(0); G_MMA(0, 1, At, B1); G_BAR;
            G_LDA(At, 1, 1); G_STAGE_A(G_SA(1, 0), k2 + kstep, a2o[0]);
            G_BAR; G_WAIT_L(0); G_MMA(1, 0, At, B0); G_BAR; G_SCHED;
            G_STAGE_B(G_SB(1, 1), b3 + hstep);
            G_WAIT_V(6); G_BAR; G_MMA(1, 1, At, B1); G_BAR;
        }
        E(acc, cur, wr, wc, fr, fq);
        E.after_unit(cur, wid, lane);
        if (!has_next) break;
#pragma unroll
        for (int a = 0; a < 2; ++a)
#pragma unroll
            for (int b = 0; b < 2; ++b)
#pragma unroll
                for (int m = 0; m < 4; ++m)
#pragma unroll
                    for (int n = 0; n < 2; ++n) acc[a][b][m][n] = (f32x4){0.f, 0.f, 0.f, 0.f};
        cur = nxt; cB = nB; ++ui;
#pragma unroll
        for (int h = 0; h < 2; ++h)
#pragma unroll
            for (int i = 0; i < 2; ++i) aoc[h][i] = aon[h][i];
    }
    G_WAIT_V(0);
    if (wr == 0) G_BAR;
    G_BAR;
#undef G_SA
#undef G_SB
#undef G_STAGE_A
#undef G_STAGE_B
#undef G_LDA
#undef G_LDB
#undef G_MMA
#undef G_WAIT_V
#undef G_WAIT_L
#undef G_BAR
#undef G_SCHED
}

struct EpiU {
    static constexpr bool PERM = true;
    __device__ __forceinline__ void after_unit(const Unit&, int, int) const {}
    bf16_t* U; float* GT;
    __device__ __forceinline__ void operator()(const f32x4 (&acc)[2][2][4][2], const Unit& u, int wr, int wc, int fr, int fq) const {
        const int row0 = u.pm * BM + wr * 64 + fr;
        if (u.pn < 15) {
            const int col0 = u.pn * BM + wc * 32 + 8 * fq;
#pragma unroll
            for (int ai = 0; ai < 2; ++ai)
#pragma unroll
                for (int m = 0; m < 4; ++m) { bf16_t* rowp = U + (size_t)(row0 + ai * HALF + m * 16) * NU + col0;
#pragma unroll
                    for (int bj = 0; bj < 2; ++bj) { const f32x4 v0 = acc[ai][bj][m][0], v1 = acc[ai][bj][m][1];
                        u32x4 w; w.x = cvt_pk_bf16(v0[0], v0[1]); w.y = cvt_pk_bf16(v0[2], v0[3]); w.z = cvt_pk_bf16(v1[0], v1[1]); w.w = cvt_pk_bf16(v1[2], v1[3]);
                        ST16_NT(rowp + bj * HALF, w); } }
        } else if (wc == 0 && fq < 2) {
#pragma unroll
            for (int ai = 0; ai < 2; ++ai)
#pragma unroll
                for (int m = 0; m < 4; ++m) { float* rowp = GT + (size_t)(row0 + ai * HALF + m * 16) * 16 + 8 * fq;
#pragma unroll
                    for (int n = 0; n < 2; ++n) *(f32x4*)(rowp + 4 * n) = acc[ai][0][m][n]; }
        }
    }
};
template <int MODE  > struct EpiF32 {
    static constexpr bool PERM = false;
    __device__ __forceinline__ void after_unit(const Unit&, int, int) const {}
    float* C; int ldc; const float* Src;
    __device__ __forceinline__ void operator()(const f32x4 (&acc)[2][2][4][2], const Unit& u, int wr, int wc, int fr, int fq) const {
        const int row0 = u.pm * BM + wr * 64 + fr, col0 = u.pn * BM + wc * 32 + 4 * fq;
#pragma unroll
        for (int ai = 0; ai < 2; ++ai)
#pragma unroll
            for (int m = 0; m < 4; ++m) { float* rowp = C + (size_t)(row0 + ai * HALF + m * 16) * ldc + col0;
#pragma unroll
                for (int bj = 0; bj < 2; ++bj)
#pragma unroll
                    for (int n = 0; n < 2; ++n) { f32x4 v = acc[ai][bj][m][n];
                        if (MODE == 1) { const f32x4 o = *(const f32x4*)(Src + (size_t)(row0 + ai * HALF + m * 16) * ldc + col0 + bj * HALF + n * 16);
#pragma unroll
                            for (int j = 0; j < 4; ++j) v[j] = sigmoidf_(v[j]) * o[j]; }
                        *(f32x4*)(rowp + bj * HALF + n * 16) = v; } }
    }
};
template <int MODE  > struct EpiB16 {
    static constexpr bool PERM = true;
    __device__ __forceinline__ void after_unit(const Unit&, int, int) const {}
    bf16_t* O; int ldc; const bf16_t* Src;
    __device__ __forceinline__ void operator()(const f32x4 (&acc)[2][2][4][2], const Unit& u, int wr, int wc, int fr, int fq) const {
        const int row0 = u.pm * BM + wr * 64 + fr, col0 = u.pn * BM + wc * 32 + 8 * fq;
#pragma unroll
        for (int ai = 0; ai < 2; ++ai)
#pragma unroll
            for (int m = 0; m < 4; ++m) { const size_t off = (size_t)(row0 + ai * HALF + m * 16) * ldc + col0;
#pragma unroll
                for (int bj = 0; bj < 2; ++bj) { f32x4 v0 = acc[ai][bj][m][0], v1 = acc[ai][bj][m][1];
                    if (MODE == 1) { const u32x4 g = *(const u32x4*)(Src + off + bj * HALF);
                        v0[0] = sigmoidf_(v0[0]) * __uint_as_float(g.x << 16); v0[1] = sigmoidf_(v0[1]) * __uint_as_float(g.x & 0xffff0000u); v0[2] = sigmoidf_(v0[2]) * __uint_as_float(g.y << 16); v0[3] = sigmoidf_(v0[3]) * __uint_as_float(g.y & 0xffff0000u);
                        v1[0] = sigmoidf_(v1[0]) * __uint_as_float(g.z << 16); v1[1] = sigmoidf_(v1[1]) * __uint_as_float(g.z & 0xffff0000u); v1[2] = sigmoidf_(v1[2]) * __uint_as_float(g.w << 16); v1[3] = sigmoidf_(v1[3]) * __uint_as_float(g.w & 0xffff0000u); }
                    u32x4 w; w.x = cvt_pk_bf16(v0[0], v0[1]); w.y = cvt_pk_bf16(v0[2], v0[3]); w.z = cvt_pk_bf16(v1[0], v1[1]); w.w = cvt_pk_bf16(v1[2], v1[3]);
                    *(u32x4*)(O + off + bj * HALF) = w; } }
    }
};
struct EpiMoe1 {
    static constexpr bool PERM = true;
    Params Pc; int lnext, G, nunits;
    __device__ __forceinline__ void after_unit(const Unit& u, int wid, int lane) const {
        if (lnext >= DEPTH) return;
        const int i = u.L / G, c = u.L - i * G;
        if (i != (c & 7)) return;
        const int n9 = nunits - 8 * G > 0 ? (nunits - 8 * G < G ? nunits - 8 * G : G) : 0, n8 = G - n9;
        int x = (CV_LAYER / NWAVES - 3 * n8 + G - 1) / G; if (x < 0) x = 0;
        const int cnt = c < n9 ? x : x + 3, start = c < n9 ? c * NWAVES * x : n9 * NWAVES * x + (c - n9) * NWAVES * (x + 3);
        for (int k = 0; k < cnt; ++k) { const int idx = start + wid * cnt + k; if (idx < CV_LAYER) convert_item(Pc, lnext, idx, lane); }
    }
    bf16_t* H; const float* b_gu;
    __device__ __forceinline__ void operator()(const f32x4 (&acc)[2][2][4][2], const Unit& u, int wr, int wc, int fr, int fq) const {
        const int row0 = u.pm * BM + wr * 64 + fr, col0 = u.pn * HALF + wc * 32 + 8 * fq;
        f32x4 bg[2], bu[2];
#pragma unroll
        for (int n = 0; n < 2; ++n) { bg[n] = *(const f32x4*)(b_gu + (size_t)u.e * 2048 + col0 + 4 * n); bu[n] = *(const f32x4*)(b_gu + (size_t)u.e * 2048 + 1024 + col0 + 4 * n); }
#pragma unroll
        for (int ai = 0; ai < 2; ++ai)
#pragma unroll
            for (int m = 0; m < 4; ++m) { float o[8];
#pragma unroll
                for (int n = 0; n < 2; ++n)
#pragma unroll
                    for (int j = 0; j < 4; ++j) { float g = acc[ai][0][m][n][j] + bg[n][j], up = acc[ai][1][m][n][j] + bu[n][j];
                        g = fminf(g, 7.0f); up = fminf(fmaxf(up, -7.0f), 7.0f);
                        o[n * 4 + j] = (up + 1.0f) * g * sigmoidf_(1.702f * g); }
                u32x4 w; w.x = cvt_pk_bf16(o[0], o[1]); w.y = cvt_pk_bf16(o[2], o[3]); w.z = cvt_pk_bf16(o[4], o[5]); w.w = cvt_pk_bf16(o[6], o[7]);
                ST16_NT(H + (size_t)(row0 + ai * HALF + m * 16) * DFF + col0, w); }
    }
};
struct EpiMoe2 {
    static constexpr bool PERM = true;
    __device__ __forceinline__ void after_unit(const Unit&, int, int) const {}
    bf16_t* Yb; const float* b_down; const float* slot_gate;
    __device__ __forceinline__ void operator()(const f32x4 (&acc)[2][2][4][2], const Unit& u, int wr, int wc, int fr, int fq) const {
        const int row0 = u.pm * BM + wr * 64 + fr, col0 = u.pn * BM + wc * 32 + 8 * fq;
        f32x4 bv[2][2];
#pragma unroll
        for (int bj = 0; bj < 2; ++bj)
#pragma unroll
            for (int n = 0; n < 2; ++n) bv[bj][n] = *(const f32x4*)(b_down + (size_t)u.e * D + col0 + bj * HALF + 4 * n);
#pragma unroll
        for (int ai = 0; ai < 2; ++ai)
#pragma unroll
            for (int m = 0; m < 4; ++m) { const int row = row0 + ai * HALF + m * 16; const float gt = slot_gate[row];
#pragma unroll
                for (int bj = 0; bj < 2; ++bj) { const f32x4 v0 = (acc[ai][bj][m][0] + bv[bj][0]) * gt, v1 = (acc[ai][bj][m][1] + bv[bj][1]) * gt;
                    u32x4 w; w.x = cvt_pk_bf16(v0[0], v0[1]); w.y = cvt_pk_bf16(v0[2], v0[3]); w.z = cvt_pk_bf16(v1[0], v1[1]); w.w = cvt_pk_bf16(v1[2], v1[3]);
                    ST16_NT(Yb + (size_t)row * D + col0 + bj * HALF, w); } }
    }
};

struct Ctx {
    LAS unsigned char* lds; int tid, lane, wave, G, bid;
};
#define WSP(T_, off) ((T_*)(P.ws + (off)))
__device__ __forceinline__ unsigned* ctl_words(const Params& P) { return (unsigned*)(P.ws + WS_CTL); }

__device__ __forceinline__ int map_win(int n) { return n < 1024 ? n : (n < 1032 ? n + 2816 : (n < 3848 ? n - 8 : n)); }
__device__ __forceinline__ int map_wgu(int n) { return n < 1024 ? ((n >> 7) * 256 + (n & 127)) : ((((n - 1024) >> 7) * 256) + 128 + ((n - 1024) & 127)); }
__device__ __forceinline__ void transpose_item(const float* W, int K, int N, bf16_t* WT, int map, int item, int lane) {
    const int nblk = (N + 127) / 128, kb = item / nblk, nb = item - kb * nblk;
    const int half = lane >> 5, nq = lane & 31, n = nb * 128 + 4 * nq, k0 = kb * 64 + 32 * half;
    if (n >= N) return;
    f32x4 v[32];
#pragma unroll
    for (int i = 0; i < 32; ++i) v[i] = *(const f32x4*)(W + (size_t)(k0 + i) * N + n);
#pragma unroll
    for (int j = 0; j < 4; ++j) { const int ng = n + j; const int nr = map == 1 ? map_win(ng) : (map == 2 ? map_wgu(ng) : ng); bf16_t* dst = WT + (size_t)nr * K + k0;
#pragma unroll
        for (int c = 0; c < 4; ++c) { u32x4 o;
#pragma unroll
            for (int x = 0; x < 4; ++x) o[x] = cvt_pk_bf16(v[8 * c + 2 * x][j], v[8 * c + 2 * x + 1][j]);
            *(u32x4*)(dst + 8 * c) = o; } }
}
__device__ __forceinline__ void convert_item(const Params& P, int l, int r, int lane) {
    unsigned char* wl = P.ws + WS_W + (size_t)l * W_LAYER;
    const float* W; bf16_t* WT; int K = D, N = D, map = 0;
    if (r < CV_IN) { W = P.in[4] + (size_t)l * D * DIN; N = DIN; WT = (bf16_t*)(wl + W_IN); map = 1; }
    else if ((r -= CV_IN) < CV_OUT) { W = P.in[13] + (size_t)l * D * D; WT = (bf16_t*)(wl + W_OUT); }
    else if ((r -= CV_OUT) < CV_PG) { W = P.in[22] + (size_t)l * D * D; WT = (bf16_t*)(wl + W_PG); }
    else if ((r -= CV_PG) < CV_PP) { W = P.in[23] + (size_t)l * 256 * D; K = 256; WT = (bf16_t*)(wl + W_PP); }
    else if ((r -= CV_PP) < NE * CV_GU1) { const int e = r / CV_GU1; r -= e * CV_GU1; W = P.in[18] + ((size_t)l * NE + e) * D * 2048; N = 2048; WT = (bf16_t*)(wl + W_GU) + (size_t)e * 2048 * D; map = 2; }
    else { r -= NE * CV_GU1; const int e = r / CV_DN1; r -= e * CV_DN1; W = P.in[20] + ((size_t)l * NE + e) * DFF * D; WT = (bf16_t*)(wl + W_DN) + (size_t)e * D * DFF; }
    transpose_item(W, K, N, WT, map, r, lane);
}
__device__ __forceinline__ void ln_store_row(const float (&v)[16], float rstd, const float* g, const float* b, float* of, bf16_t* ob, int lane) {
#pragma unroll
    for (int j = 0; j < 4; ++j) { const int c = 4 * lane + 256 * j; const f32x4 gg = *(const f32x4*)(g + c), bb = *(const f32x4*)(b + c);
        f32x4 o; o[0] = v[4 * j] * rstd * gg[0] + bb[0]; o[1] = v[4 * j + 1] * rstd * gg[1] + bb[1]; o[2] = v[4 * j + 2] * rstd * gg[2] + bb[2]; o[3] = v[4 * j + 3] * rstd * gg[3] + bb[3];
        if (of) *(f32x4*)(of + c) = o;
        if (ob) { u32x2 w; w.x = pk2(o[0], o[1]); w.y = pk2(o[2], o[3]); *(u32x2*)(ob + c) = w; } }
}
__device__ __forceinline__ void phase_prologue(const Params& P, const Ctx& C) {
    const int gw = C.bid * NWAVES + C.wave, NGW = C.G * NWAVES;
    for (int it = gw; it < CV_LAYER; it += NGW) convert_item(P, 0, it, C.lane);
    { const float* p = P.in[1]; bf16_t* pb = WSP(bf16_t, WS_PB); const size_t n4 = (size_t)DEPTH * T * 256 / 4;
      const size_t stride = (size_t)C.G * NTHREADS;
      for (size_t i0 = (size_t)C.bid * NTHREADS + C.tid; i0 < n4; i0 += 8 * stride) {
          f32x4 v[8];
#pragma unroll
          for (int k = 0; k < 8; ++k) { const size_t i = i0 + k * stride; if (i < n4) v[k] = *(const f32x4*)(p + 4 * i); }
#pragma unroll
          for (int k = 0; k < 8; ++k) { const size_t i = i0 + k * stride; if (i < n4) { u32x2 w; w.x = pk2(v[k][0], v[k][1]); w.y = pk2(v[k][2], v[k][3]); *(u32x2*)(pb + 4 * i) = w; } } } }
    for (int row0 = gw; row0 < T; row0 += 2 * NGW) {
        float v[2][16]; float s[2] = {0.f, 0.f};
#pragma unroll
        for (int k = 0; k < 2; ++k) { const int row = row0 + k * NGW < T ? row0 + k * NGW : row0; const float* x = P.in[0] + (size_t)row * D;
#pragma unroll
            for (int j = 0; j < 4; ++j) { const f32x4 t = *(const f32x4*)(x + 4 * C.lane + 256 * j); v[k][4 * j] = t[0]; v[k][4 * j + 1] = t[1]; v[k][4 * j + 2] = t[2]; v[k][4 * j + 3] = t[3]; s[k] += (t[0] + t[1]) + (t[2] + t[3]); } }
#pragma unroll
        for (int k = 0; k < 2; ++k) { const int row = row0 + k * NGW; if (row < T) {
            const float mean = wave_sum(s[k]) * (1.f / D); float q = 0.f;
#pragma unroll
            for (int i = 0; i < 16; ++i) { v[k][i] -= mean; q += v[k][i] * v[k][i]; }
            const float rstd = rsqrtf(wave_sum(q) * (1.f / D) + LN_EPS);
            ln_store_row(v[k], rstd, P.in[2], P.in[3], nullptr, WSP(bf16_t, WS_HB) + (size_t)row * D, C.lane); } }
    }
}

__device__ __forceinline__ void phase_inproj(const Params& P, const Ctx& C, int l) {
    DenseOrder S; S.init(T, NINP, D, P.ws + WS_W + (size_t)l * W_LAYER + W_IN, C.G, C.bid);
    EpiU E{WSP(bf16_t, WS_U16), WSP(float, WS_GT)};
    gemm_phase(C.lds, C.tid, (const char*)(P.ws + WS_HB), D, S, E);
}

typedef float f32x16 __attribute__((ext_vector_type(16)));
#define MFMA32(a, b, c) __builtin_amdgcn_mfma_f32_32x32x16_bf16((a), (b), (c), 0, 0, 0)
constexpr int SB_KSTR = 72, SB_VSTR = 68, SB_KBYTES = 64 * SB_KSTR * 2, SB_BUF = SB_KBYTES + 64 * SB_VSTR * 2;
__device__ __forceinline__ float shx32(float v, int lane) { return __uint_as_float((unsigned)__builtin_amdgcn_ds_bpermute((lane ^ 32) << 2, (int)__float_as_uint(v))); }
template <bool DIAG> __device__ __forceinline__ void sb_tile_math(const f32x16& sacc, float& carry, bf16x8 (&pf)[2], int r, int hh, int lane) {
    float sg[16], om[16];
#pragma unroll
    for (int i = 0; i < 16; ++i) {
        const float t = fminf(sacc[i] * (-0.125f * 1.4426950408889634f), 80.f);
        const float e = __builtin_amdgcn_exp2f(t);
        float sgm = __builtin_amdgcn_rcpf(1.0f + e), omv = e * sgm;
        if (DIAG) { const int srow_i = (i & 3) + 8 * (i >> 2) + 4 * hh; const bool masked = srow_i >= r; sgm = masked ? 0.f : sgm; omv = masked ? 1.f : omv; }
        sg[i] = sgm; om[i] = omv;
    }
    float sfx[16], pg[4], pp[4], both[4];
#pragma unroll
    for (int g = 0; g < 4; ++g) { sfx[4 * g + 3] = 1.f; sfx[4 * g + 2] = om[4 * g + 3]; sfx[4 * g + 1] = sfx[4 * g + 2] * om[4 * g + 2]; sfx[4 * g] = sfx[4 * g + 1] * om[4 * g + 1]; pg[g] = sfx[4 * g] * om[4 * g]; }
#pragma unroll
    for (int g = 0; g < 4; ++g) { pp[g] = shx32(pg[g], lane); both[g] = pg[g] * pp[g]; }
    float outer[4];
    outer[3] = 1.f; outer[2] = both[3]; outer[1] = both[3] * both[2]; outer[0] = outer[1] * both[1];
    const float total = outer[0] * both[0];
#pragma unroll
    for (int g = 0; g < 4; ++g) { if (hh == 0) outer[g] *= pp[g]; outer[g] *= carry; }
    carry *= total;
#pragma unroll
    for (int s2 = 0; s2 < 2; ++s2) { u32x4 pk;
#pragma unroll
        for (int x = 0; x < 4; ++x) { const int i0 = 8 * s2 + 2 * x; pk[x] = cvt_pk_bf16(sg[i0] * (sfx[i0] * outer[i0 >> 2]), sg[i0 + 1] * (sfx[i0 + 1] * outer[(i0 + 1) >> 2])); }
        pf[s2] = __builtin_bit_cast(bf16x8, pk); }
}
__device__ __forceinline__ void sb_unit(const Params& P, const Ctx& C, int l, int b, int h, int qb) {
    const bf16_t* base = WSP(bf16_t, WS_U16) + (size_t)b * SEQ * NU;
    int tid_ = C.tid; asm volatile("" : "+v"(tid_));
    const int w = __builtin_amdgcn_readfirstlane(tid_ >> 6), lane = tid_ & 63, r = lane & 31, hh = lane >> 5;
    const int q0 = qb * 256 + 32 * w;
    bf16x8 qf[4];
#pragma unroll
    for (int kk = 0; kk < 4; ++kk) qf[kk] = *(const bf16x8*)(base + (size_t)(q0 + r) * NU + U_SQ + h * 64 + 16 * kk + 8 * hh);
    f32x16 oacc[2];
#pragma unroll
    for (int i = 0; i < 16; ++i) { oacc[0][i] = 0.f; oacc[1][i] = 0.f; }
    float carry = 1.f;
    const int nst = 4 * (qb + 1);
    const int srow = tid_ >> 3, scol = (tid_ & 7) * 8;
    LAS unsigned* alive = (LAS unsigned*)(C.lds + 2 * SB_BUF);
    u32x4 kreg, vreg;
    { const bf16_t* rowp = base + (size_t)(64 * (nst - 1) + srow) * NU + h * 64 + scol; kreg = *(const u32x4*)(rowp + U_SK); vreg = *(const u32x4*)(rowp + U_SV); }
    for (int st = nst - 1; st >= 0; --st) {
        LAS unsigned char* buf = C.lds + (st & 1) * SB_BUF;
        *(LAS u32x4*)(buf + (srow * SB_KSTR + scol) * 2) = kreg;
        { LAS bf16_t* vt = (LAS bf16_t*)(buf + SB_KBYTES);
#pragma unroll
          for (int j = 0; j < 4; ++j) { vt[(scol + 2 * j) * SB_VSTR + srow] = (bf16_t)(vreg[j] & 0xffffu); vt[(scol + 2 * j + 1) * SB_VSTR + srow] = (bf16_t)(vreg[j] >> 16); } }
        const bool wave_alive = __any(carry != 0.f) != 0;
        if (lane == 0) alive[(st & 1) * 8 + w] = wave_alive ? 1u : 0u;
        __syncthreads();
        { unsigned any_alive = 0u;
#pragma unroll
          for (int i = 0; i < 8; ++i) any_alive |= alive[(st & 1) * 8 + i];
          if (any_alive == 0u) break; }
        if (st > 0) { const bf16_t* rowp = base + (size_t)(64 * (st - 1) + srow) * NU + h * 64 + scol; kreg = *(const u32x4*)(rowp + U_SK); vreg = *(const u32x4*)(rowp + U_SV); }
        const LAS bf16_t* vt = (const LAS bf16_t*)(buf + SB_KBYTES);
#pragma unroll
        for (int half = 1; half >= 0; --half) {
            const int kb = 64 * st + 32 * half;
            if (kb >= q0 + 32 || !wave_alive) continue;
            const bool diag = (kb == q0);
            f32x16 sacc;
#pragma unroll
            for (int i = 0; i < 16; ++i) sacc[i] = 0.f;
#pragma unroll
            for (int kk = 0; kk < 4; ++kk) { const bf16x8 kf = *(const LAS bf16x8*)(buf + ((32 * half + r) * SB_KSTR + 16 * kk + 8 * hh) * 2); sacc = MFMA32(kf, qf[kk], sacc); }
            bf16x8 pf[2];
            if (diag) sb_tile_math<true>(sacc, carry, pf, r, hh, lane); else sb_tile_math<false>(sacc, carry, pf, r, hh, lane);
#pragma unroll
            for (int dt = 0; dt < 2; ++dt)
#pragma unroll
                for (int s2 = 0; s2 < 2; ++s2) { const LAS bf16_t* vrow = vt + (32 * dt + r) * SB_VSTR + 32 * half + 16 * s2 + 4 * hh;
                    const u32x2 lo = *(const LAS u32x2*)vrow, hi = *(const LAS u32x2*)(vrow + 8);
                    u32x4 vv; vv.x = lo.x; vv.y = lo.y; vv.z = hi.x; vv.w = hi.y;
                    oacc[dt] = MFMA32(__builtin_bit_cast(bf16x8, vv), pf[s2], oacc[dt]); }
        }
    }
    float ss = 0.f;
#pragma unroll
    for (int i = 0; i < 16; ++i) ss += oacc[0][i] * oacc[0][i] + oacc[1][i] * oacc[1][i];
    ss += shx32(ss, lane);
    const float sc = rsqrtf(ss * (1.f / 64.f) + NORM_EPS);
    const float* nw = P.in[8] + l * 256 + h * 64;
    bf16_t* yrow = WSP(bf16_t, WS_Y) + (size_t)(b * SEQ + q0 + r) * D + 256 + h * 64;
#pragma unroll
    for (int dt = 0; dt < 2; ++dt)
#pragma unroll
        for (int g = 0; g < 4; ++g) { const int d0 = 32 * dt + 8 * g + 4 * hh; const f32x4 n4 = *(const f32x4*)(nw + d0);
            u32x2 o2; o2.x = cvt_pk_bf16(oacc[dt][4 * g] * sc * n4[0], oacc[dt][4 * g + 1] * sc * n4[1]); o2.y = cvt_pk_bf16(oacc[dt][4 * g + 2] * sc * n4[2], oacc[dt][4 * g + 3] * sc * n4[3]);
            *(u32x2*)(yrow + d0) = o2; }
    __syncthreads();
}

constexpr int ML_STR = 72;
constexpr int ML_MAT = 64 * ML_STR * 2;
constexpr int ML_STAGE = 4 * ML_MAT;
constexpr int ML_K = 0, ML_Q = ML_MAT, ML_VT = 2 * ML_MAT, ML_KWT = 3 * ML_MAT;
constexpr int ML_CT = 2 * ML_STAGE  , ML_N = ML_CT + 2 * ML_MAT  , ML_SSQ = ML_N + 512  ,
              ML_GB = ML_SSQ + 1024  , ML_GWL = ML_GB + 8192, ML_GEB = ML_GWL + 8192, ML_GWG = ML_GEB + 8192  , ML_GG = ML_GWG + 8192  , ML_END = ML_GG + 128;
static_assert(ML_END <= LDS_TAB, "mLSTM LDS map");
__device__ __forceinline__ float shup(float v, int o, int lane) { return __uint_as_float((unsigned)__builtin_amdgcn_ds_bpermute((lane - o) << 2, (int)__float_as_uint(v))); }
__device__ __forceinline__ float shidx(float v, int src) { return __uint_as_float((unsigned)__builtin_amdgcn_ds_bpermute(src << 2, (int)__float_as_uint(v))); }
__device__ __forceinline__ void mlstm_unit(const Params& P, const Ctx& C, int l, int b, int h, int par) {
    const bf16_t* U = WSP(bf16_t, WS_U16) + (size_t)b * SEQ * NU; const float* GT = WSP(float, WS_GT) + (size_t)b * SEQ * 16;
    LAS unsigned char* lds = C.lds;
    const int w = C.wave, lane = C.lane, r = lane & 31, hh = lane >> 5, tid = C.tid;
    const float ib = P.in[5][l * 4 + h], fb = P.in[6][l * 4 + h];
    for (int i = tid; i < (2 * ML_MAT + 512 + 1024) / 4; i += NTHREADS) ((LAS unsigned*)(lds + ML_CT))[i] = 0u;
    for (int n = w; n < SEQ / 64; n += NWAVES) {
        const size_t tk = (size_t)64 * n + lane;
        float bcs = -softplusf_(-(GT[tk * 16 + 4 + h] + fb));
#pragma unroll
        for (int o = 1; o < 64; o <<= 1) { const float t = shup(bcs, o, lane); if (lane >= o) bcs += t; }
        const float wl = (GT[tk * 16 + h] + ib) - bcs, bL = shidx(bcs, 63);
        ((LAS float*)(lds + ML_GB))[tk] = bcs; ((LAS float*)(lds + ML_GWL))[tk] = wl; ((LAS float*)(lds + ML_GEB))[tk] = __expf(bcs); ((LAS float*)(lds + ML_GWG))[tk] = __expf(bL + wl);
        if (lane == 0) ((LAS float*)(lds + ML_GG))[n] = __expf(bL);
    }
    const int srow = tid >> 3, c0 = (tid & 7) * 8;
    u32x4 qreg, kreg, vreg;
    { const bf16_t* rowp = U + (size_t)srow * NU + h * 64 + c0; qreg = *(const u32x4*)(rowp + U_MQ); kreg = *(const u32x4*)(rowp + U_MK); vreg = *(const u32x4*)(rowp + U_MV); }
    f32x16 cacc;
#pragma unroll
    for (int i = 0; i < 16; ++i) cacc[i] = 0.f;
    float n_d = 0.f;
    const int ti = w & 1, ei = (w >> 1) & 1;
    f32x16 hv; float rs_part = 0.f; u32x2 opre[4];
#pragma unroll
    for (int i = 0; i < 16; ++i) hv[i] = 0.f;
#pragma unroll
    for (int g = 0; g < 4; ++g) opre[g] = (u32x2){0u, 0u};
    const float* nw = P.in[7] + l * 256 + h * 64;
    __syncthreads();
    for (int n = 0; n <= SEQ / 64; ++n) {
        const int cb = n & 1;
        LAS unsigned char* sb = lds + cb * ML_STAGE;
        if (n < SEQ / 64) {
            const float wgt_row = ((const LAS float*)(lds + ML_GWG))[64 * n + srow];
            u32x4 ks; float kf[8];
#pragma unroll
            for (int x = 0; x < 4; ++x) { kf[2 * x] = __uint_as_float(kreg[x] << 16) * 0.125f; kf[2 * x + 1] = __uint_as_float(kreg[x] & 0xffff0000u) * 0.125f; ks[x] = (__float_as_uint(kf[2 * x]) >> 16) | (__float_as_uint(kf[2 * x + 1]) & 0xffff0000u); }
            *(LAS u32x4*)(sb + ML_K + (srow * ML_STR + c0) * 2) = ks;
            if ((n & 1) == par) *(LAS u32x4*)(sb + ML_Q + (srow * ML_STR + c0) * 2) = qreg;
            LAS bf16_t* vt = (LAS bf16_t*)(sb + ML_VT); LAS bf16_t* kwt = (LAS bf16_t*)(sb + ML_KWT);
#pragma unroll
            for (int x = 0; x < 4; ++x) { vt[(c0 + 2 * x) * ML_STR + srow] = (bf16_t)(vreg[x] & 0xffffu); vt[(c0 + 2 * x + 1) * ML_STR + srow] = (bf16_t)(vreg[x] >> 16);
                kwt[(c0 + 2 * x) * ML_STR + srow] = (bf16_t)f2bf(kf[2 * x] * wgt_row); kwt[(c0 + 2 * x + 1) * ML_STR + srow] = (bf16_t)f2bf(kf[2 * x + 1] * wgt_row); }
        }
        __syncthreads();
        if (n + 1 < SEQ / 64) { const bf16_t* rowp = U + (size_t)(64 * (n + 1) + srow) * NU + h * 64 + c0; qreg = *(const u32x4*)(rowp + U_MQ); kreg = *(const u32x4*)(rowp + U_MK); vreg = *(const u32x4*)(rowp + U_MV); }
        if (w < 4 && n > 0 && ((n - 1) & 1) == par) {
            const float tot = rs_part + ((const LAS float*)(lds + ML_SSQ))[(cb ^ 1) * 128 + (ti * 2 + (ei ^ 1)) * 32 + r];
            const float rs = rsqrtf(tot * (1.f / 64.f) + NORM_EPS);
            const size_t tok = (size_t)64 * (n - 1) + 32 * ti + r;
            bf16_t* yrow = WSP(bf16_t, WS_Y) + ((size_t)b * SEQ + tok) * D + h * 64;
#pragma unroll
            for (int g = 0; g < 4; ++g) { const int e0 = 32 * ei + 8 * g + 4 * hh; const f32x4 n4 = *(const f32x4*)(nw + e0); const u32x2 op = opre[g];
                const float o0 = sigmoidf_(__uint_as_float(op.x << 16)), o1 = sigmoidf_(__uint_as_float(op.x & 0xffff0000u)), o2 = sigmoidf_(__uint_as_float(op.y << 16)), o3 = sigmoidf_(__uint_as_float(op.y & 0xffff0000u));
                u32x2 y2; y2.x = cvt_pk_bf16(hv[4 * g] * rs * n4[0] * o0, hv[4 * g + 1] * rs * n4[1] * o1); y2.y = cvt_pk_bf16(hv[4 * g + 2] * rs * n4[2] * o2, hv[4 * g + 3] * rs * n4[3] * o3);
                *(u32x2*)(yrow + e0) = y2; }
        }
        if (n == SEQ / 64) break;
        if (w < 4) { if ((n & 1) == par) {
            { const size_t tokp = (size_t)64 * n + 32 * ti + r;
#pragma unroll
              for (int g = 0; g < 4; ++g) opre[g] = *(const u32x2*)(U + tokp * NU + U_MO + h * 64 + 32 * ei + 8 * g + 4 * hh); }
            const LAS float* gwl = (const LAS float*)(lds + ML_GWL) + 64 * n;
            const float bt = ((const LAS float*)(lds + ML_GB))[64 * n + 32 * ti + r], ebt = ((const LAS float*)(lds + ML_GEB))[64 * n + 32 * ti + r];
            bf16x8 qf[4];
#pragma unroll
            for (int kk = 0; kk < 4; ++kk) qf[kk] = *(const LAS bf16x8*)(sb + ML_Q + ((32 * ti + r) * ML_STR + 16 * kk + 8 * hh) * 2);
            f32x16 acc1, acc2;
#pragma unroll
            for (int i = 0; i < 16; ++i) { acc1[i] = 0.f; acc2[i] = 0.f; }
            float den = 0.f;
#pragma unroll
            for (int si = 0; si < 2; ++si) {
                if (si > ti) continue;
                f32x16 sacc;
#pragma unroll
                for (int i = 0; i < 16; ++i) sacc[i] = 0.f;
#pragma unroll
                for (int kk = 0; kk < 4; ++kk) { const bf16x8 kf = *(const LAS bf16x8*)(sb + ML_K + ((32 * si + r) * ML_STR + 16 * kk + 8 * hh) * 2); sacc = MFMA32(kf, qf[kk], sacc); }
                float pv[16];
#pragma unroll
                for (int g = 0; g < 4; ++g) { const f32x4 wl4 = *(const LAS f32x4*)(gwl + 32 * si + 8 * g + 4 * hh);
#pragma unroll
                    for (int x = 0; x < 4; ++x) { const int srow_i = 8 * g + 4 * hh + x; const bool keep = (si < ti) || (srow_i <= r);
                        const float pvv = keep ? sacc[4 * g + x] * __expf(bt + wl4[x]) : 0.f; pv[4 * g + x] = pvv; den += pvv; } }
#pragma unroll
                for (int s2 = 0; s2 < 2; ++s2) { u32x4 pk;
#pragma unroll
                    for (int x = 0; x < 4; ++x) pk[x] = cvt_pk_bf16(pv[8 * s2 + 2 * x], pv[8 * s2 + 2 * x + 1]);
                    const LAS bf16_t* vrow = (const LAS bf16_t*)(sb + ML_VT) + (32 * ei + r) * ML_STR + 32 * si + 16 * s2 + 4 * hh;
                    const u32x2 lo = *(const LAS u32x2*)vrow, hi = *(const LAS u32x2*)(vrow + 8);
                    u32x4 vv; vv.x = lo.x; vv.y = lo.y; vv.z = hi.x; vv.w = hi.y;
                    acc1 = MFMA32(__builtin_bit_cast(bf16x8, vv), __builtin_bit_cast(bf16x8, pk), acc1); }
            }
#pragma unroll
            for (int kk = 0; kk < 4; ++kk) { const bf16x8 cf = *(const LAS bf16x8*)(lds + ML_CT + cb * ML_MAT + ((32 * ei + r) * ML_STR + 16 * kk + 8 * hh) * 2); acc2 = MFMA32(cf, qf[kk], acc2); }
            float qn = 0.f;
            { const LAS float* nv = (const LAS float*)(lds + ML_N + cb * 256);
#pragma unroll
              for (int kk = 0; kk < 4; ++kk) { const u32x4 qq = *(const LAS u32x4*)(sb + ML_Q + ((32 * ti + r) * ML_STR + 32 * hh + 8 * kk) * 2);
                  const f32x4 n0 = *(const LAS f32x4*)(nv + 32 * hh + 8 * kk), n1 = *(const LAS f32x4*)(nv + 32 * hh + 8 * kk + 4);
                  qn += __uint_as_float(qq[0] << 16) * n0[0] + __uint_as_float(qq[0] & 0xffff0000u) * n0[1] + __uint_as_float(qq[1] << 16) * n0[2] + __uint_as_float(qq[1] & 0xffff0000u) * n0[3]
                      + __uint_as_float(qq[2] << 16) * n1[0] + __uint_as_float(qq[2] & 0xffff0000u) * n1[1] + __uint_as_float(qq[3] << 16) * n1[2] + __uint_as_float(qq[3] & 0xffff0000u) * n1[3]; } }
            den += ebt * qn;
            den += shx32(den, lane);
            const float dinv = __builtin_amdgcn_rcpf(fmaxf(fabsf(den), 1.0f));
            rs_part = 0.f;
#pragma unroll
            for (int i = 0; i < 16; ++i) { hv[i] = (acc1[i] + ebt * acc2[i]) * dinv; rs_part += hv[i] * hv[i]; }
            rs_part += shx32(rs_part, lane);
            if (hh == 0) ((LAS float*)(lds + ML_SSQ))[cb * 128 + (ti * 2 + ei) * 32 + r] = rs_part;
        } } else {
            const int di = w & 1; const float G = ((const LAS float*)(lds + ML_GG))[n];
#pragma unroll
            for (int i = 0; i < 16; ++i) cacc[i] *= G;
#pragma unroll
            for (int kk = 0; kk < 4; ++kk) { const bf16x8 vf = *(const LAS bf16x8*)(sb + ML_VT + ((32 * ei + r) * ML_STR + 16 * kk + 8 * hh) * 2);
                const bf16x8 kf = *(const LAS bf16x8*)(sb + ML_KWT + ((32 * di + r) * ML_STR + 16 * kk + 8 * hh) * 2); cacc = MFMA32(vf, kf, cacc); }
            LAS bf16_t* ct = (LAS bf16_t*)(lds + ML_CT + (cb ^ 1) * ML_MAT);
#pragma unroll
            for (int i = 0; i < 16; ++i) ct[(32 * ei + (i & 3) + 8 * (i >> 2) + 4 * hh) * ML_STR + 32 * di + r] = (bf16_t)f2bf(cacc[i]);
            if (w == 4) { float sum = 0.f;
#pragma unroll
                for (int kk = 0; kk < 8; ++kk) { const u32x4 kk4 = *(const LAS u32x4*)(sb + ML_KWT + (lane * ML_STR + 8 * kk) * 2);
#pragma unroll
                    for (int x = 0; x < 4; ++x) sum += __uint_as_float(kk4[x] << 16) + __uint_as_float(kk4[x] & 0xffff0000u); }
                n_d = G * n_d + sum; ((LAS float*)(lds + ML_N + (cb ^ 1) * 256))[lane] = n_d; }
        }
    }
    __syncthreads();
}
constexpr int GP_W = 0, GP_QD = 16384, GP_KDT = 32768, GP_QK = 49152, GP_U = 57344, GP_CD = 73728, GP_CHUNK = 74752;
constexpr size_t WS_GP = WS_GQ;
static_assert((size_t)1024 * GP_CHUNK <= 96 * MiB, "GDN prep buffer");
constexpr int PL_KSTR = 136, PL_KN = 0, PL_QN = 17408, PL_RHS = 34816, PL_RSTR = 260, PL_M = 101376, PL_MSTR = 72  , PL_QK = 118784, PL_QKSTR = 72, PL_WC = 128000, PL_GATE = 134144, PL_UWSTR = 264;
__device__ __forceinline__ unsigned bfmul2(unsigned pk, float a) { return cvt_pk_bf16(__uint_as_float(pk << 16) * a, __uint_as_float(pk & 0xffff0000u) * a); }
__device__ __forceinline__ void gdn_prep_unit(const Params& P, const Ctx& C, int l, int b, int h, int n) {
    LAS unsigned char* lds = C.lds;
    int tid_ = C.tid; asm volatile("" : "+v"(tid_));
    const int tid = tid_, w = __builtin_amdgcn_readfirstlane(tid >> 6), lane = tid & 63, r = lane & 31, hh = lane >> 5;
    const bf16_t* U = WSP(bf16_t, WS_U16) + (size_t)b * SEQ * NU; const float* GT = WSP(float, WS_GT) + (size_t)b * SEQ * 16;
    unsigned char* outp = P.ws + WS_GP + (size_t)((b * 4 + h) * 32 + n) * GP_CHUNK;
    const int t0 = 64 * n;
    { const float* cw = P.in[9] + (size_t)l * 4 * 1536; LAS float* wc = (LAS float*)(lds + PL_WC);
      for (int idx = tid; idx < 1536; idx += NTHREADS) { const int j = idx / 384, rem = idx - j * 384, p = rem >> 7, cc = rem & 127; wc[idx] = cw[j * 1536 + p * 512 + h * 128 + cc]; } }
    float beta_l, gam_l, gamL;
    { const float A = __expf(P.in[10][l * 4 + h]), dtb = P.in[11][l * 4 + h];
      const float ga = GT[(size_t)(t0 + lane) * 16 + 8 + h], gb = GT[(size_t)(t0 + lane) * 16 + 12 + h];
      float g = -A * softplusf_(ga + dtb);
#pragma unroll
      for (int o = 1; o < 64; o <<= 1) { const float t = shup(g, o, lane); if (lane >= o) g += t; }
      gam_l = g; beta_l = sigmoidf_(gb); gamL = shidx(g, 63);
      if (w == 0) { LAS float* gt = (LAS float*)(lds + PL_GATE); gt[lane] = gam_l; gt[64 + lane] = beta_l; gt[128 + lane] = __expf(gam_l); gt[192 + lane] = __expf(gamL - gam_l); } }
    __syncthreads();
    { const int t = tid >> 3, cg = tid & 7;
      const float beta_t = shidx(beta_l, t), gam_t = shidx(gam_l, t);
      float acc[3][16];
#pragma unroll
      for (int p = 0; p < 3; ++p)
#pragma unroll
          for (int c = 0; c < 16; ++c) acc[p][c] = 0.f;
      const LAS float* wc = (const LAS float*)(lds + PL_WC);
#pragma unroll
      for (int j = 0; j < 4; ++j) { const int ts = t0 + t - 3 + j;
          if (ts >= 0) {
#pragma unroll
              for (int p = 0; p < 3; ++p) { const bf16_t* src = U + (size_t)ts * NU + U_GQ + p * 512 + h * 128 + 16 * cg; const u32x4 x0 = *(const u32x4*)src, x1 = *(const u32x4*)(src + 8);
                  const LAS float* wp = wc + j * 384 + p * 128 + 16 * cg;
#pragma unroll
                  for (int c4 = 0; c4 < 4; ++c4) { const f32x4 w4 = *(const LAS f32x4*)(wp + 4 * c4); const unsigned xa = c4 < 2 ? x0[2 * c4] : x1[2 * c4 - 4], xb = c4 < 2 ? x0[2 * c4 + 1] : x1[2 * c4 - 3];
                      acc[p][4 * c4] += w4[0] * __uint_as_float(xa << 16); acc[p][4 * c4 + 1] += w4[1] * __uint_as_float(xa & 0xffff0000u);
                      acc[p][4 * c4 + 2] += w4[2] * __uint_as_float(xb << 16); acc[p][4 * c4 + 3] += w4[3] * __uint_as_float(xb & 0xffff0000u); } } } }
      float ssq = 0.f, ssk = 0.f;
#pragma unroll
      for (int c = 0; c < 16; ++c) { acc[0][c] = siluf_(acc[0][c]); acc[1][c] = siluf_(acc[1][c]); acc[2][c] = siluf_(acc[2][c]); ssq += acc[0][c] * acc[0][c]; ssk += acc[1][c] * acc[1][c]; }
      { const int ln = lane_id_opaque();
#pragma unroll
        for (int o = 1; o < 8; o <<= 1) { ssq += shx(ssq, o, ln); ssk += shx(ssk, o, ln); } }
      const float scq = rsqrtf(ssq + NORM_EPS) * 0.08838834764831845f, sck = rsqrtf(ssk + NORM_EPS), bw = beta_t * __expf(gam_t);
      u32x4 qa, qb, ka, kb;
#pragma unroll
      for (int x = 0; x < 4; ++x) { qa[x] = cvt_pk_bf16(acc[0][2 * x] * scq, acc[0][2 * x + 1] * scq); qb[x] = cvt_pk_bf16(acc[0][8 + 2 * x] * scq, acc[0][9 + 2 * x] * scq);
                                     ka[x] = cvt_pk_bf16(acc[1][2 * x] * sck, acc[1][2 * x + 1] * sck); kb[x] = cvt_pk_bf16(acc[1][8 + 2 * x] * sck, acc[1][9 + 2 * x] * sck); }
      *(LAS u32x4*)(lds + PL_QN + (t * PL_KSTR + 16 * cg) * 2) = qa; *(LAS u32x4*)(lds + PL_QN + (t * PL_KSTR + 16 * cg + 8) * 2) = qb;
      *(LAS u32x4*)(lds + PL_KN + (t * PL_KSTR + 16 * cg) * 2) = ka; *(LAS u32x4*)(lds + PL_KN + (t * PL_KSTR + 16 * cg + 8) * 2) = kb;
      LAS float* rhs = (LAS float*)(lds + PL_RHS) + t * PL_RSTR;
#pragma unroll
      for (int c4 = 0; c4 < 4; ++c4) { f32x4 rv, rk;
#pragma unroll
          for (int x = 0; x < 4; ++x) { rv[x] = beta_t * acc[2][4 * c4 + x]; rk[x] = bw * sck * acc[1][4 * c4 + x]; }
          *(LAS f32x4*)(rhs + 16 * cg + 4 * c4) = rv; *(LAS f32x4*)(rhs + 128 + 16 * cg + 4 * c4) = rk; } }
    __syncthreads();
    { const int p = w >> 2, ti = (w >> 1) & 1, si = w & 1;
      const LAS float* gt = (const LAS float*)(lds + PL_GATE);
      if (si <= ti) {
          f32x16 acc;
#pragma unroll
          for (int i = 0; i < 16; ++i) acc[i] = 0.f;
#pragma unroll
          for (int kk = 0; kk < 8; ++kk) { const bf16x8 af = *(const LAS bf16x8*)(lds + (p ? PL_QN : PL_KN) + ((32 * ti + r) * PL_KSTR + 16 * kk + 8 * hh) * 2);
              const bf16x8 bf = *(const LAS bf16x8*)(lds + PL_KN + ((32 * si + r) * PL_KSTR + 16 * kk + 8 * hh) * 2); acc = MFMA32(af, bf, acc); }
          const float gam_s = gt[32 * si + r];
#pragma unroll
          for (int g = 0; g < 4; ++g) { const f32x4 gt4 = *(const LAS f32x4*)(gt + 32 * ti + 8 * g + 4 * hh), bt4 = *(const LAS f32x4*)(gt + 64 + 32 * ti + 8 * g + 4 * hh);
#pragma unroll
              for (int x = 0; x < 4; ++x) { const int trow = 8 * g + 4 * hh + x; const float dec = __expf(fminf(gt4[x] - gam_s, 0.f)) * acc[4 * g + x];
                  if (p == 0) { const bool keep = (si < ti) || (r < trow); ((LAS _Float16*)(lds + PL_M))[(32 * ti + trow) * PL_MSTR + 32 * si + r] = (_Float16)(keep ? bt4[x] * dec : 0.f); }
                  else { const bool keep = (si < ti) || (r <= trow); ((LAS bf16_t*)(lds + PL_QK))[(32 * ti + trow) * PL_QKSTR + 32 * si + r] = (bf16_t)f2bf(keep ? dec : 0.f); } } }
      } else if (p == 1) {
#pragma unroll
          for (int i = 0; i < 16; ++i) ((LAS bf16_t*)(lds + PL_QK))[(32 * ti + (i & 3) + 8 * (i >> 2) + 4 * hh) * PL_QKSTR + 32 * si + r] = (bf16_t)0;
      } }
    __syncthreads();
    float xs[64];
    if (w < 4) {
        int vz = 0; asm volatile("" : "+v"(vz));
        typedef _Float16 f16x8 __attribute__((ext_vector_type(8)));
        const LAS float* rhs = (const LAS float*)(lds + PL_RHS) + tid; const LAS _Float16* Mh = (const LAS _Float16*)(lds + PL_M) + vz;
#pragma clang loop unroll(full)
        for (int t = 0; t < 64; ++t) { float a = rhs[t * PL_RSTR];
            const LAS _Float16* Mrow = Mh + t * PL_MSTR;
#pragma clang loop unroll(full)
            for (int s8 = 0; s8 < (t + 7) / 8; ++s8) { const f16x8 m8 = *(const LAS f16x8*)(Mrow + 8 * s8);
#pragma unroll
                for (int x = 0; x < 8; ++x) if (8 * s8 + x < t) a -= (float)m8[x] * xs[8 * s8 + x]; }
            xs[t] = a; }
    } else {
        const LAS float* gt = (const LAS float*)(lds + PL_GATE);
        for (int it = w - 4; it < 40; it += 4) {
            u32x4 o;
            if (it < 16) { const int ti = it >> 3, kk = it & 7; const u32x4 q = *(const LAS u32x4*)(lds + PL_QN + ((32 * ti + r) * PL_KSTR + 16 * kk + 8 * hh) * 2); const float eg = gt[128 + 32 * ti + r];
#pragma unroll
                for (int x = 0; x < 4; ++x) o[x] = bfmul2(q[x], eg);
                *(u32x4*)(outp + GP_QD + (size_t)((ti * 8 + kk) * 64 + lane) * 16) = o;
            } else if (it < 32) { const int dt = (it - 16) >> 2, ks = (it - 16) & 3; const LAS bf16_t* kn = (const LAS bf16_t*)(lds + PL_KN) + 32 * dt + r;
#pragma unroll
                for (int x = 0; x < 4; ++x) { const int ta = 16 * ks + 8 * ((2 * x) >> 2) + 4 * hh + ((2 * x) & 3), tb = ta + 1;
                    o[x] = cvt_pk_bf16(bf2f(kn[ta * PL_KSTR]) * gt[192 + ta], bf2f(kn[tb * PL_KSTR]) * gt[192 + tb]); }
                *(u32x4*)(outp + GP_KDT + (size_t)((dt * 4 + ks) * 64 + lane) * 16) = o;
            } else { const int ti = (it - 32) >> 2, ks = (it - 32) & 3; const LAS bf16_t* qrow = (const LAS bf16_t*)(lds + PL_QK) + (32 * ti + r) * PL_QKSTR + 16 * ks + 4 * hh;
                const u32x2 lo = *(const LAS u32x2*)qrow, hi = *(const LAS u32x2*)(qrow + 8); o.x = lo.x; o.y = lo.y; o.z = hi.x; o.w = hi.y;
                *(u32x4*)(outp + GP_QK + (size_t)((ti * 4 + ks) * 64 + lane) * 16) = o; }
        }
    }
    __syncthreads();
    if (w < 4) { LAS bf16_t* uw = (LAS bf16_t*)(lds + PL_RHS) + tid;
#pragma unroll
        for (int t = 0; t < 64; ++t) uw[t * PL_UWSTR] = (bf16_t)f2bf(xs[t]); }
    __syncthreads();
    { const LAS bf16_t* uw = (const LAS bf16_t*)(lds + PL_RHS);
      for (int it = w; it < 24; it += 8) {
          if (it < 16) { const int ti = it >> 3, kk = it & 7; const u32x4 o = *(const LAS u32x4*)(uw + (32 * ti + r) * PL_UWSTR + 128 + 16 * kk + 8 * hh);
              *(u32x4*)(outp + GP_W + (size_t)((ti * 8 + kk) * 64 + lane) * 16) = o;
          } else { const int ti = (it - 16) >> 2, es = (it - 16) & 3; u32x4 o0, o1;
#pragma unroll
              for (int x = 0; x < 8; ++x) { const int ia = 2 * x, ib = 2 * x + 1; const int ta = 32 * ti + (ia & 3) + 8 * (ia >> 2) + 4 * hh, tb = 32 * ti + (ib & 3) + 8 * (ib >> 2) + 4 * hh;
                  const unsigned v = (unsigned)uw[ta * PL_UWSTR + 32 * es + r] | ((unsigned)uw[tb * PL_UWSTR + 32 * es + r] << 16); if (x < 4) o0[x] = v; else o1[x - 4] = v; }
              unsigned char* dst = outp + GP_U + (size_t)((ti * 4 + es) * 64 + lane) * 32; *(u32x4*)dst = o0; *(u32x4*)(dst + 16) = o1; }
      }
      if (tid == 0) *(float*)(outp + GP_CD) = __expf(gamL); }
    __syncthreads();
}
__device__ __forceinline__ void phase_gprep2(const Params& P, const Ctx& C, int l) {
    { int* slot_tok = (int*)(P.ws + WS_RT + RT_SLOTTOK); for (int i = C.bid * NTHREADS + C.tid; i < PSLOTS; i += C.G * NTHREADS) slot_tok[i] = -1; }
    for (int u = C.bid; u < 1024; u += C.G) gdn_prep_unit(P, C, l, u >> 7, (u >> 5) & 3, u & 31);
}
constexpr int GS_SLOT = 61440, GS_ST = 2 * GS_SLOT, GS_STSTR = 136, GS_STBYTES = 32 * GS_STSTR * 2;
__device__ __forceinline__ void gdn_scan_unit(const Params& P, const Ctx& C, int l, int b, int h, int es) {
    LAS unsigned char* lds = C.lds;
    const int tid = C.tid, w = C.wave, lane = C.lane, r = lane & 31, hh = lane >> 5;
    const unsigned char* gp = P.ws + WS_GP + (size_t)((b * 4 + h) * 32) * GP_CHUNK;
    float* O = WSP(float, WS_GO) + (size_t)b * SEQ * 512 + h * 128 + 32 * es;
    for (int i = tid; i < 2 * GS_STBYTES / 4; i += NTHREADS) ((LAS unsigned*)(lds + GS_ST))[i] = 0u;
#define GS_ISSUE(nn) do { const unsigned char* src = gp + (size_t)(nn) * GP_CHUNK; LAS unsigned char* dst = lds + ((nn) & 1) * GS_SLOT; \
        for (int p = w; p < 60; p += 8) { const size_t go = p < 56 ? (size_t)p * 1024 : (size_t)GP_U + (size_t)(((p - 56) >> 1) * 4 + es) * 2048 + (size_t)((p - 56) & 1) * 1024; \
            __builtin_amdgcn_global_load_lds((const unsigned*)(src + go + lane * 16), (LAS unsigned*)(dst + p * 1024), 16, 0, 0); } } while (0)
    GS_ISSUE(0);
    float cd_next = *(const float*)(gp + GP_CD);
    f32x16 sacc;
#pragma unroll
    for (int i = 0; i < 16; ++i) sacc[i] = 0.f;
    asm volatile("s_waitcnt vmcnt(0)" ::: "memory");
    __syncthreads();
    for (int n = 0; n < 32; ++n) {
        const float cd = cd_next;
        if (n + 1 < 32) { GS_ISSUE(n + 1); cd_next = *(const float*)(gp + (size_t)(n + 1) * GP_CHUNK + GP_CD); }
        const LAS unsigned char* slot = lds + (n & 1) * GS_SLOT;
        const LAS unsigned char* stc = lds + GS_ST + (n & 1) * GS_STBYTES;
        if (w < 6) {
            f32x16 xa[2];
#pragma unroll
            for (int i = 0; i < 16; ++i) { xa[0][i] = 0.f; xa[1][i] = 0.f; }
            bf16x8 sf[8];
#pragma unroll
            for (int kk = 0; kk < 8; ++kk) sf[kk] = *(const LAS bf16x8*)(stc + (r * GS_STSTR + 16 * kk + 8 * hh) * 2);
#pragma unroll
            for (int ti = 0; ti < 2; ++ti)
#pragma unroll
                for (int kk = 0; kk < 8; ++kk) { const bf16x8 wf = *(const LAS bf16x8*)(slot + GP_W + ((ti * 8 + kk) * 64 + lane) * 16); xa[ti] = MFMA32(wf, sf[kk], xa[ti]); }
            bf16x8 pf[2][2];
#pragma unroll
            for (int ti = 0; ti < 2; ++ti) { const u32x4 u0 = *(const LAS u32x4*)(slot + GP_U + ti * 2048 + lane * 32), u1 = *(const LAS u32x4*)(slot + GP_U + ti * 2048 + lane * 32 + 16);
#pragma unroll
                for (int s2 = 0; s2 < 2; ++s2) { const u32x4 uu = s2 ? u1 : u0; u32x4 pk;
#pragma unroll
                    for (int x = 0; x < 4; ++x) pk[x] = cvt_pk_bf16(__uint_as_float(uu[x] << 16) - xa[ti][8 * s2 + 2 * x], __uint_as_float(uu[x] & 0xffff0000u) - xa[ti][8 * s2 + 2 * x + 1]);
                    pf[ti][s2] = __builtin_bit_cast(bf16x8, pk); } }
            if (w < 4) {
#pragma unroll
                for (int i = 0; i < 16; ++i) sacc[i] *= cd;
#pragma unroll
                for (int ks = 0; ks < 4; ++ks) { const bf16x8 kf = *(const LAS bf16x8*)(slot + GP_KDT + ((w * 4 + ks) * 64 + lane) * 16); sacc = MFMA32(kf, pf[ks >> 1][ks & 1], sacc); }
                LAS unsigned char* stn = lds + GS_ST + ((n + 1) & 1) * GS_STBYTES;
#pragma unroll
                for (int g = 0; g < 4; ++g) { u32x2 o2; o2.x = cvt_pk_bf16(sacc[4 * g], sacc[4 * g + 1]); o2.y = cvt_pk_bf16(sacc[4 * g + 2], sacc[4 * g + 3]);
                    *(LAS u32x2*)(stn + (r * GS_STSTR + 32 * w + 8 * g + 4 * hh) * 2) = o2; }
            } else {
                const int ti = w - 4;
                f32x16 oa;
#pragma unroll
                for (int i = 0; i < 16; ++i) oa[i] = 0.f;
#pragma unroll
                for (int kk = 0; kk < 8; ++kk) { const bf16x8 qf = *(const LAS bf16x8*)(slot + GP_QD + ((ti * 8 + kk) * 64 + lane) * 16); oa = MFMA32(qf, sf[kk], oa); }
#pragma unroll
                for (int ks = 0; ks < 4; ++ks) { if ((ks >> 1) > ti) continue; const bf16x8 qf = *(const LAS bf16x8*)(slot + GP_QK + ((ti * 4 + ks) * 64 + lane) * 16); oa = MFMA32(qf, pf[ks >> 1][ks & 1], oa); }
                float* orow = O + (size_t)(64 * n + 32 * ti) * 512 + r;
#pragma unroll
                for (int i = 0; i < 16; ++i) orow[(size_t)((i & 3) + 8 * (i >> 2) + 4 * hh) * 512] = oa[i];
            }
        }
        asm volatile("s_waitcnt vmcnt(0)" ::: "memory");
        __syncthreads();
    }
#undef GS_ISSUE
}
__device__ __forceinline__ void phase_mix(const Params& P, const Ctx& C, int l, int rep) {
#ifndef MIX_SEL
#define MIX_SEL 7
#endif
    const int sel = rep ? MIX_SEL : 7;
    if (C.bid < 128) { if (sel & 1) { const int j = C.bid >> 3, bh = (j >> 2) * 8 + (C.bid & 7); gdn_scan_unit(P, C, l, bh >> 2, bh & 3, j & 3); } }
    else if (C.bid < 192) { if (sel & 2) { const int q = C.bid - 128, j = q >> 3, bh = (j >> 1) * 8 + (q & 7); mlstm_unit(P, C, l, bh >> 2, bh & 3, j & 1); } }
    if (!(sel & 4)) return;
    LAS int* qslot = (LAS int*)(C.lds + LDS_MISC + 32);
    for (;;) {
        if (C.tid == 0) *qslot = (int)atomicAdd(ctl_words(P) + CW_SBQ + (l + 4 * rep) * 64, 1u);
        __syncthreads();
        const int u = *qslot;
        __syncthreads();
        if (u >= 256) break;
        sb_unit(P, C, l, (u & 31) >> 2, u & 3, 7 - (u >> 5));
    }
}
__device__ __forceinline__ void phase_gpost(const Params& P, const Ctx& C, int l) {
    const float* O = WSP(float, WS_GO); const bf16_t* U = WSP(bf16_t, WS_U16); bf16_t* Y = WSP(bf16_t, WS_Y); const float* nw = P.in[12] + l * 128 + (C.lane & 15) * 8;
    const int gw = C.bid * NWAVES + C.wave, NGW = C.G * NWAVES, lane = C.lane;
    const f32x4 n0 = *(const f32x4*)nw, n1 = *(const f32x4*)(nw + 4);
    for (int tok0 = gw; tok0 < T; tok0 += 4 * NGW) {
        f32x4 a[4], b[4]; u32x4 z[4];
#pragma unroll
        for (int k = 0; k < 4; ++k) { const int tok = tok0 + k * NGW; if (tok < T) { a[k] = *(const f32x4*)(O + (size_t)tok * 512 + lane * 8); b[k] = *(const f32x4*)(O + (size_t)tok * 512 + lane * 8 + 4); z[k] = *(const u32x4*)(U + (size_t)tok * NU + U_GZ + lane * 8); } }
#pragma unroll
        for (int k = 0; k < 4; ++k) { const int tok = tok0 + k * NGW; if (tok < T) {
            float ss = (a[k][0] * a[k][0] + a[k][1] * a[k][1]) + (a[k][2] * a[k][2] + a[k][3] * a[k][3]) + (b[k][0] * b[k][0] + b[k][1] * b[k][1]) + (b[k][2] * b[k][2] + b[k][3] * b[k][3]);
            { const int ln = lane_id_opaque();
#pragma unroll
              for (int o = 1; o < 16; o <<= 1) ss += shx(ss, o, ln); }
            const float sc = rsqrtf(ss * (1.f / 128.f) + NORM_EPS);
            u32x4 o;
            o.x = cvt_pk_bf16(a[k][0] * sc * n0[0] * siluf_(__uint_as_float(z[k].x << 16)), a[k][1] * sc * n0[1] * siluf_(__uint_as_float(z[k].x & 0xffff0000u)));
            o.y = cvt_pk_bf16(a[k][2] * sc * n0[2] * siluf_(__uint_as_float(z[k].y << 16)), a[k][3] * sc * n0[3] * siluf_(__uint_as_float(z[k].y & 0xffff0000u)));
            o.z = cvt_pk_bf16(b[k][0] * sc * n1[0] * siluf_(__uint_as_float(z[k].z << 16)), b[k][1] * sc * n1[1] * siluf_(__uint_as_float(z[k].z & 0xffff0000u)));
            o.w = cvt_pk_bf16(b[k][2] * sc * n1[2] * siluf_(__uint_as_float(z[k].w << 16)), b[k][3] * sc * n1[3] * siluf_(__uint_as_float(z[k].w & 0xffff0000u)));
            *(u32x4*)(Y + (size_t)tok * D + 512 + lane * 8) = o; } }
    }
}
__device__ __forceinline__ void phase_outproj(const Params& P, const Ctx& C, int l) {
    DenseOrder S; S.init(T, D, D, P.ws + WS_W + (size_t)l * W_LAYER + W_OUT, C.G, C.bid);
    EpiB16<0> E{WSP(bf16_t, WS_TMP), D, nullptr};
    gemm_phase(C.lds, C.tid, (const char*)(P.ws + WS_Y), D, S, E);
}
__device__ __forceinline__ void phase_ln1(const Params& P, const Ctx& C, int l, int rep) {
    const int gw = C.bid * NWAVES + C.wave, NGW = C.G * NWAVES, lane = C.lane;
    const bf16_t* HB = WSP(bf16_t, WS_HB); const bf16_t* TMP = WSP(bf16_t, WS_TMP);
    const float* wr = P.in[16] + (size_t)l * D * NE; const float* br = P.in[17] + l * NE;
    const float* g = P.in[14] + l * D; const float* bb = P.in[15] + l * D;
    int* top_idx = (int*)(P.ws + WS_RT + RT_TOPIDX); float* top_gate = (float*)(P.ws + WS_RT + RT_TOPGATE);
    LAS float* xs = (LAS float*)(C.lds + C.wave * 16384);
    const int e_me = lane & 31, half = lane >> 5;
    LAS unsigned* hist = (LAS unsigned*)(C.lds + LDS_TAB);
    if (C.tid < NE) hist[C.tid] = 0u;
    __syncthreads();
    for (int gi = gw; gi < T / 4; gi += NGW) {
        u32x2 hbr[4][4], tbr[4][4];
#pragma unroll
        for (int rr = 0; rr < 4; ++rr)
#pragma unroll
            for (int j = 0; j < 4; ++j) { hbr[rr][j] = *(const u32x2*)(HB + (size_t)(4 * gi + rr) * D + 4 * lane + 256 * j); tbr[rr][j] = *(const u32x2*)(TMP + (size_t)(4 * gi + rr) * D + 4 * lane + 256 * j); }
#pragma unroll
        for (int rr = 0; rr < 4; ++rr) {
            const int row = 4 * gi + rr;
            float v[16]; float s = 0.f;
#pragma unroll
            for (int j = 0; j < 4; ++j) { const u32x2 hb = hbr[rr][j]; const u32x2 tb = tbr[rr][j]; const float t[4] = {__uint_as_float(tb.x << 16), __uint_as_float(tb.x & 0xffff0000u), __uint_as_float(tb.y << 16), __uint_as_float(tb.y & 0xffff0000u)};
                const float a[4] = {__uint_as_float(hb.x << 16), __uint_as_float(hb.x & 0xffff0000u), __uint_as_float(hb.y << 16), __uint_as_float(hb.y & 0xffff0000u)};
#pragma unroll
                for (int x = 0; x < 4; ++x) { v[4 * j + x] = ALPHA * a[x] + t[x]; s += v[4 * j + x]; } }
            const float mean = wave_sum(s) * (1.f / D); float q = 0.f;
#pragma unroll
            for (int i = 0; i < 16; ++i) { v[i] -= mean; q += v[i] * v[i]; }
            const float rstd = rsqrtf(wave_sum(q) * (1.f / D) + LN_EPS);
#pragma unroll
            for (int j = 0; j < 4; ++j) { const int c = 4 * lane + 256 * j; const f32x4 gg = *(const f32x4*)(g + c), b4 = *(const f32x4*)(bb + c);
                f32x4 o;
#pragma unroll
                for (int x = 0; x < 4; ++x) o[x] = v[4 * j + x] * rstd * gg[x] + b4[x];
                u32x2 w; w.x = pk2(o[0], o[1]); w.y = pk2(o[2], o[3]); *(u32x2*)(WSP(bf16_t, WS_H1B) + (size_t)row * D + c) = w;
                *(LAS f32x4*)(xs + rr * 1024 + c) = o; }
        }
        float acc[4] = {0.f, 0.f, 0.f, 0.f};
        { const float* wp = wr + (size_t)(half * 512) * NE + e_me; const LAS float* xp = xs + half * 512;
#pragma unroll 8
          for (int k = 0; k < 512; k += 4) { const float w0 = wp[(size_t)k * NE], w1 = wp[(size_t)(k + 1) * NE], w2 = wp[(size_t)(k + 2) * NE], w3 = wp[(size_t)(k + 3) * NE];
#pragma unroll
              for (int rr = 0; rr < 4; ++rr) { const f32x4 x4 = *(const LAS f32x4*)(xp + rr * 1024 + k); acc[rr] += (x4[0] * w0 + x4[1] * w1) + (x4[2] * w2 + x4[3] * w3); } } }
        const float bias = br[e_me];
#pragma unroll
        for (int rr = 0; rr < 4; ++rr) {
            const int row = 4 * gi + rr;
            float logit = acc[rr] + shx(acc[rr], 32, lane) + bias;
            float vals[4]; int ids[4];
#pragma unroll
            for (int r = 0; r < 4; ++r) {
                float bv = logit; int bi = e_me;
#pragma unroll
                for (int o = 16; o >= 1; o >>= 1) { const float ov = shx(bv, o, lane); const int oi = shxi(bi, o, lane); if (ov > bv || (ov == bv && oi < bi)) { bv = ov; bi = oi; } }
                vals[r] = bv; ids[r] = bi; if (e_me == bi) logit = -INFINITY;
            }
            float ex[4], se = 0.f;
#pragma unroll
            for (int r = 0; r < 4; ++r) { ex[r] = __expf(vals[r] - vals[0]); se += ex[r]; }
            if (lane == 0) {
#pragma unroll
                for (int r = 0; r < 4; ++r) { top_idx[row * 4 + r] = ids[r]; top_gate[row * 4 + r] = ex[r] * __builtin_amdgcn_rcpf(se); __hip_atomic_fetch_add(&hist[ids[r]], 1u, __ATOMIC_RELAXED, __HIP_MEMORY_SCOPE_WORKGROUP); }
            }
        }
    }
    __syncthreads();
    if (C.tid < NE) ((unsigned*)(P.ws + WS_RT + RT_WGCNT))[(size_t)rep * 256 * NE + C.bid * NE + C.tid] = hist[C.tid];
}
__device__ __forceinline__ void phase_scatter(const Params& P, const Ctx& C, int l, int rep) {
    LAS int* pad_start = (LAS int*)(C.lds + LDS_TAB);
    LAS unsigned* cur = (LAS unsigned*)(C.lds + LDS_TAB + 256);
    LAS unsigned* ptot = (LAS unsigned*)(C.lds + LDS_TAB + 512);
    LAS unsigned* ppre = (LAS unsigned*)(C.lds + LDS_TAB + 512 + 2048);
    const unsigned* wgcnt = (const unsigned*)(P.ws + WS_RT + RT_WGCNT);
    { const int e = C.tid & 31, part = C.tid >> 5; unsigned st = 0, sp = 0;
      unsigned cv[16];
#pragma unroll
      for (int i = 0; i < 16; ++i) { const int wb = part * 16 + i; cv[i] = wb < C.G ? wgcnt[wb * NE + e] : 0u; }
#pragma unroll
      for (int i = 0; i < 16; ++i) { const int wb = part * 16 + i; st += cv[i]; if (wb < C.bid) sp += cv[i]; }
      ptot[part * 32 + e] = st; ppre[part * 32 + e] = sp; }
    __syncthreads();
    if (C.tid < NE) { unsigned st = 0, sp = 0; for (int p = 0; p < 16; ++p) { st += ptot[p * 32 + C.tid]; sp += ppre[p * 32 + C.tid]; } ptot[C.tid] = st; ppre[C.tid] = sp; }
    __syncthreads();
    if (C.tid == 0) { int acc = 0; for (int e = 0; e < NE; ++e) { pad_start[e] = acc; cur[e] = (unsigned)acc + ppre[e]; acc += ((int)ptot[e] + MOEB - 1) / MOEB * MOEB; } pad_start[NE] = acc; }
    __syncthreads();
    const int* top_idx = (const int*)(P.ws + WS_RT + RT_TOPIDX); const float* top_gate = (const float*)(P.ws + WS_RT + RT_TOPGATE);
    int* tok_slot = (int*)(P.ws + WS_RT + RT_TOKSLOT); int* slot_tok = (int*)(P.ws + WS_RT + RT_SLOTTOK); float* slot_gate = (float*)(P.ws + WS_RT + RT_SLOTGATE);
    { const int gw = C.bid * NWAVES + C.wave, NGW = C.G * NWAVES;
      for (int gi = gw; gi < T / 4; gi += NGW) if (C.lane < 16) { const int a = 16 * gi + C.lane;
          const int e = top_idx[a]; const int slot = (int)__hip_atomic_fetch_add(&cur[e], 1u, __ATOMIC_RELAXED, __HIP_MEMORY_SCOPE_WORKGROUP);
          slot_tok[slot] = a >> 2; slot_gate[slot] = top_gate[a]; tok_slot[a] = slot; } }
    if (C.bid == 0) { int* block_e = (int*)(P.ws + WS_RT + RT_BLOCKE);
        for (int nb = C.tid; nb < NBLK; nb += NTHREADS) { int c = 0; for (int e = 0; e < NE; ++e) c += (pad_start[e + 1] <= nb * MOEB) ? 1 : 0; block_e[nb] = c < NE - 1 ? c : NE - 1; }
        if (C.tid == 0) block_e[NBLK] = pad_start[NE] / MOEB; }
    __syncthreads();
    DenseOrder S; S.init(T, D, 256, P.ws + WS_W + (size_t)l * W_LAYER + W_PP, C.G, C.bid);
    EpiB16<0> E{WSP(bf16_t, WS_PLE), D, nullptr};
    gemm_phase(C.lds, C.tid, (const char*)(P.ws + WS_PB + (size_t)l * T * 256 * 2), 256, S, E);
}
template <bool GATHER> __device__ __forceinline__ void moe_order_init(MoeOrder<GATHER>& S, const Params& P, const Ctx& C, int nN, int K, const void* Wt, size_t estride) {
    const int* block_e = (const int*)(P.ws + WS_RT + RT_BLOCKE); const int* slot_tok = (const int*)(P.ws + WS_RT + RT_SLOTTOK);
    LAS int* tab = (LAS int*)(C.lds + LDS_TAB); LAS int* ue = (LAS int*)(C.lds + LDS_UE);
    const int nblk = block_e[NBLK];
    S.nN = nN; S.nunits = nblk * nN; S.G = C.G; S.cm = (C.G % 8 == 0) ? (C.bid % 8) * (C.G / 8) + C.bid / 8 : C.bid; S.K = K; S.Wt = (const char*)Wt; S.estride = estride; S.tab = tab; S.ue = ue;
    { int ev[12], tk[12];
#pragma unroll
      for (int i = 0; i < 12; ++i) { int rb, pnx; const bool ok = moe_map(i, S.cm, nblk, nN, rb, pnx); if (!ok) rb = 0;
          ev[i] = (ok && C.tid < 64) ? block_e[rb] : 0; tk[i] = (GATHER && ok && C.tid < 256) ? slot_tok[rb * 256 + C.tid] : 0; }
#pragma unroll
      for (int i = 0; i < 12; ++i) { if (C.tid == 0) ue[i] = ev[i]; if (GATHER && C.tid < 256) tab[i * 256 + C.tid] = tk[i] < 0 ? 0 : tk[i]; } }
    __syncthreads();
}
__device__ __forceinline__ void phase_moe1(const Params& P, const Ctx& C, int l) {
    { DenseOrder S; S.init(T, D, D, P.ws + WS_W + (size_t)l * W_LAYER + W_PG, C.G, C.bid);
      EpiB16<1> E{WSP(bf16_t, WS_TMP), D, WSP(bf16_t, WS_PLE)};
      gemm_phase(C.lds, C.tid, (const char*)(P.ws + WS_H1B), D, S, E); }
    MoeOrder<true> S; moe_order_init<true>(S, P, C, 8, D, P.ws + WS_W + (size_t)l * W_LAYER + W_GU, (size_t)2048 * D * 2);
    EpiMoe1 E{P, l + 1, C.G, S.nunits, WSP(bf16_t, WS_HM), P.in[19] + (size_t)l * NE * 2048};
    gemm_phase(C.lds, C.tid, (const char*)(P.ws + WS_H1B), D, S, E);
}
__device__ __forceinline__ void phase_moe2(const Params& P, const Ctx& C, int l) {
    MoeOrder<false> S; moe_order_init<false>(S, P, C, 4, DFF, P.ws + WS_W + (size_t)l * W_LAYER + W_DN, (size_t)D * DFF * 2);
    EpiMoe2 E{WSP(bf16_t, WS_YB), P.in[21] + (size_t)l * NE * D, (const float*)(P.ws + WS_RT + RT_SLOTGATE)};
    gemm_phase(C.lds, C.tid, (const char*)(P.ws + WS_HM), DFF, S, E);
}
__device__ __forceinline__ void phase_ln2(const Params& P, const Ctx& C, int l) {
    const int gw = C.bid * NWAVES + C.wave, NGW = C.G * NWAVES, lane = C.lane;
    const bf16_t* H1B = WSP(bf16_t, WS_H1B); const bf16_t* PLE = WSP(bf16_t, WS_TMP); const bf16_t* Yb = WSP(bf16_t, WS_YB); const int* tok_slot = (const int*)(P.ws + WS_RT + RT_TOKSLOT);
    for (int row0 = gw; row0 < T; row0 += 2 * NGW) {
        int sl[2][4];
#pragma unroll
        for (int k = 0; k < 2; ++k) { const int row = row0 + k * NGW < T ? row0 + k * NGW : row0;
#pragma unroll
            for (int r = 0; r < 4; ++r) sl[k][r] = tok_slot[row * 4 + r]; }
        float v[2][16]; float s[2] = {0.f, 0.f};
#pragma unroll
        for (int k = 0; k < 2; ++k) { const int row = row0 + k * NGW < T ? row0 + k * NGW : row0;
#pragma unroll
            for (int j = 0; j < 4; ++j) { const int c = 4 * lane + 256 * j; const u32x2 hb = *(const u32x2*)(H1B + (size_t)row * D + c); const u32x2 plb = *(const u32x2*)(PLE + (size_t)row * D + c);
                float f[4] = {__uint_as_float(plb.x << 16), __uint_as_float(plb.x & 0xffff0000u), __uint_as_float(plb.y << 16), __uint_as_float(plb.y & 0xffff0000u)};
#pragma unroll
                for (int r = 0; r < 4; ++r) { const u32x2 y = *(const u32x2*)(Yb + (size_t)sl[k][r] * D + c); f[0] += __uint_as_float(y.x << 16); f[1] += __uint_as_float(y.x & 0xffff0000u); f[2] += __uint_as_float(y.y << 16); f[3] += __uint_as_float(y.y & 0xffff0000u); }
                v[k][4 * j] = ALPHA * __uint_as_float(hb.x << 16) + f[0]; v[k][4 * j + 1] = ALPHA * __uint_as_float(hb.x & 0xffff0000u) + f[1];
                v[k][4 * j + 2] = ALPHA * __uint_as_float(hb.y << 16) + f[2]; v[k][4 * j + 3] = ALPHA * __uint_as_float(hb.y & 0xffff0000u) + f[3];
                s[k] += (v[k][4 * j] + v[k][4 * j + 1]) + (v[k][4 * j + 2] + v[k][4 * j + 3]); } }
#pragma unroll
        for (int k = 0; k < 2; ++k) { const int row = row0 + k * NGW; if (row < T) {
            const float mean = wave_sum(s[k]) * (1.f / D); float q = 0.f;
#pragma unroll
            for (int i = 0; i < 16; ++i) { v[k][i] -= mean; q += v[k][i] * v[k][i]; }
            const float rstd = rsqrtf(wave_sum(q) * (1.f / D) + LN_EPS);
            float* of = (l == DEPTH - 1) ? P.out + (size_t)row * D : nullptr;
            ln_store_row(v[k], rstd, P.in[24] + l * D, P.in[25] + l * D, of, (l == DEPTH - 1) ? nullptr : WSP(bf16_t, WS_HB) + (size_t)row * D, lane); } }
    }
}

enum { PH_PRO = 0, PH_INPROJ, PH_GPREP, PH_MIX, PH_GPOST, PH_OUTPROJ, PH_LN1, PH_SCAT, PH_MOE1, PH_MOE2, PH_LN2 };
__device__ __forceinline__ Ctx make_ctx(unsigned char* lds) {
    Ctx C; C.lds = (LAS unsigned char*)lds; C.tid = threadIdx.x; C.lane = C.tid & 63; C.wave = __builtin_amdgcn_readfirstlane(C.tid >> 6); C.G = gridDim.x; C.bid = blockIdx.x; return C;
}
template <int PH> __device__ __forceinline__ void run_phase(const Params& P, const Ctx& C, int l, int rep = 0) {
    if (PH == PH_PRO) phase_prologue(P, C);
    if (PH == PH_INPROJ) phase_inproj(P, C, l);
    if (PH == PH_GPREP) phase_gprep2(P, C, l);
    if (PH == PH_MIX) phase_mix(P, C, l, rep);
    if (PH == PH_GPOST) phase_gpost(P, C, l);
    if (PH == PH_OUTPROJ) phase_outproj(P, C, l);
    if (PH == PH_LN1) phase_ln1(P, C, l, rep);
    if (PH == PH_SCAT) phase_scatter(P, C, l, rep);
    if (PH == PH_MOE1) phase_moe1(P, C, l);
    if (PH == PH_MOE2) phase_moe2(P, C, l);
    if (PH == PH_LN2) phase_ln2(P, C, l);
}
#if MK_MULTI
template <int PH> __global__ void __launch_bounds__(NTHREADS, 2) kphase(Params P, int l) {
    extern __shared__ __attribute__((aligned(16))) unsigned char lds[];
    const Ctx C = make_ctx(lds);
    run_phase<PH>(P, C, l);
}
#else
__device__ __forceinline__ Params load_params() {
    Params r{};
#if defined(__HIP_DEVICE_COMPILE__)
    const __attribute__((address_space(4))) unsigned long long* p = (const __attribute__((address_space(4))) unsigned long long*)__builtin_amdgcn_kernarg_segment_ptr();
    asm volatile("" : "+s"(p));
#pragma unroll
    for (int i = 0; i < 26; ++i) r.in[i] = (const float*)(const __attribute__((address_space(1))) float*)p[i];
    r.out = (float*)(__attribute__((address_space(1))) float*)p[26]; r.ws = (unsigned char*)(__attribute__((address_space(1))) unsigned char*)p[27];
#endif
    return r;
}
__device__ __forceinline__ Ctx make_ctx_opaque(unsigned char* lds) {
    int t = threadIdx.x, b = blockIdx.x, g = gridDim.x; asm volatile("" : "+v"(t)); asm volatile("" : "+s"(b), "+s"(g));
    LAS unsigned char* lp = (LAS unsigned char*)lds; asm volatile("" : "+s"(lp));
    Ctx C; C.lds = lp; C.tid = t; C.lane = t & 63; C.wave = __builtin_amdgcn_readfirstlane(t >> 6); C.G = g; C.bid = b; return C;
}
#define GRID_BAR() do { XcdBarrier b2 = bar; asm volatile("" : "+s"(b2.bar), "+s"(b2.x)); xcd_barrier(b2); } while (0)
#ifndef PROBE_MASK
#define PROBE_MASK 0
#endif
#define PHASE1(PH, l, rep) do { asm volatile("; PHASE_BEGIN " #PH); const Params Pl = load_params(); const Ctx Cl = make_ctx_opaque(lds); run_phase<PH>(Pl, Cl, (l), (rep)); asm volatile("; PHASE_END " #PH); } while (0)
#define PHASE(PH, l) do { PHASE1(PH, l, 0); if ((PROBE_MASK >> PH) & 1) { GRID_BAR(); PHASE1(PH, l, 1); } } while (0)
__global__ void __launch_bounds__(NTHREADS, 2) mega(Params Pk) {
    extern __shared__ __attribute__((aligned(16))) unsigned char lds[];
    const Ctx C = make_ctx(lds);
    if (C.tid < 4) ((LAS unsigned*)(C.lds + LDS_MISC))[C.tid] = 0u;
    __syncthreads();
    XcdBarrier bar;
    { const Params Pl = load_params(); bar = xcd_barrier_post(ctl_words(Pl) + CW_BAR, (volatile LAS unsigned*)(C.lds + LDS_MISC)); }
    PHASE(PH_PRO, 0); GRID_BAR();
#define LAYER(l) do { PHASE(PH_INPROJ, l); GRID_BAR(); PHASE(PH_GPREP, l); GRID_BAR(); PHASE(PH_MIX, l); GRID_BAR(); PHASE(PH_GPOST, l); GRID_BAR(); \
        PHASE(PH_OUTPROJ, l); GRID_BAR(); PHASE(PH_LN1, l); GRID_BAR(); PHASE(PH_SCAT, l); GRID_BAR(); PHASE(PH_MOE1, l); GRID_BAR(); \
        PHASE(PH_MOE2, l); GRID_BAR(); PHASE(PH_LN2, l); if ((l) + 1 < DEPTH) GRID_BAR(); } while (0)
    LAYER(0); LAYER(1); LAYER(2); LAYER(3);
}
#endif
}

extern "C" void kernel_launch(void* const* d_in, const int* in_sizes, int n_in, void* d_out, int out_size, void* d_ws, size_t ws_size, hipStream_t stream) {
    static int grid = 0;
    if (grid == 0) {
        if (n_in != 26 || out_size != T * D || ws_size < WS_END) { fprintf(stderr, "kernel_launch: unexpected shapes (n_in %d out %d ws %zu need %zu)\n", n_in, out_size, ws_size, (size_t)WS_END); grid = -1; return; }
        int dev = 0, cus = 0; hipGetDevice(&dev); hipDeviceGetAttribute(&cus, hipDeviceAttributeMultiprocessorCount, dev);
#if MK_MULTI
#define SETATTR(PH) hipFuncSetAttribute((const void*)kphase<PH>, hipFuncAttributeMaxDynamicSharedMemorySize, LDS_BYTES)
        SETATTR(PH_PRO); SETATTR(PH_INPROJ); SETATTR(PH_GPREP); SETATTR(PH_MIX); SETATTR(PH_GPOST); SETATTR(PH_OUTPROJ); SETATTR(PH_LN1); SETATTR(PH_SCAT); SETATTR(PH_MOE1); SETATTR(PH_MOE2); SETATTR(PH_LN2);
#else
        hipFuncSetAttribute((const void*)mega, hipFuncAttributeMaxDynamicSharedMemorySize, LDS_BYTES);
        int per_cu = 0; hipOccupancyMaxActiveBlocksPerMultiprocessor(&per_cu, (const void*)mega, NTHREADS, LDS_BYTES);
        if (per_cu < 1) fprintf(stderr, "kernel_launch: occupancy query reports %d blocks per CU\n", per_cu);
#endif
        (void)hipGetLastError();
        grid = cus > 0 ? cus : 256;
    }
    if (grid < 0) return;
    hipMemsetAsync((char*)d_ws + WS_CTL, 0, CTL_BYTES, stream);
    Params P{};
    for (int i = 0; i < 26; ++i) P.in[i] = (const float*)d_in[i];
    P.out = (float*)d_out; P.ws = (unsigned char*)d_ws;
#if MK_MULTI
#define LAUNCH(PH, l) hipLaunchKernelGGL(kphase<PH>, dim3(grid), dim3(NTHREADS), LDS_BYTES, stream, P, l)
    LAUNCH(PH_PRO, 0);
    for (int l = 0; l < DEPTH; ++l) {
        LAUNCH(PH_INPROJ, l); LAUNCH(PH_GPREP, l); LAUNCH(PH_MIX, l); LAUNCH(PH_GPOST, l); LAUNCH(PH_OUTPROJ, l);
        LAUNCH(PH_LN1, l); LAUNCH(PH_SCAT, l); LAUNCH(PH_MOE1, l); LAUNCH(PH_MOE2, l); LAUNCH(PH_LN2, l);
    }
#else
    hipLaunchKernelGGL(mega, dim3(grid), dim3(NTHREADS), LDS_BYTES, stream, P);
#endif
}
```

```cpp
#include <hip/hip_runtime.h>
#include <cstdio>
#include <cstdint>

#ifndef MK_MULTI
#define MK_MULTI 0
#endif

namespace {
#define LAS __attribute__((address_space(3)))
typedef unsigned short bf16_t;
typedef short bf16x8 __attribute__((ext_vector_type(8)));
typedef float f32x4 __attribute__((ext_vector_type(4)));
typedef unsigned u32x4 __attribute__((ext_vector_type(4)));
typedef unsigned u32x2 __attribute__((ext_vector_type(2)));
#define ST16_NT(p, v) (*(u32x4*)(p) = (v))
__device__ __forceinline__ void st16_wt(void* p, u32x4 v) { asm volatile("global_store_dwordx4 %0, %1, off sc1\n\ts_nop 2" :: "v"(p), "v"(v) : "memory"); }

constexpr int D = 1024, BATCH = 8, SEQ = 2048, DEPTH = 4, T = BATCH * SEQ;
constexpr int DIN = 3856, NU = 3840, NINP = 4096;
constexpr int U_MQ = 0, U_MK = 256, U_MV = 512, U_MO = 768, U_SQ = 1024, U_SK = 1280, U_SV = 1536, U_GQ = 1792, U_GZ = 3328;
constexpr int NE = 32, DFF = 1024, MOEB = 256;
constexpr int NBLK = (T * 4) / MOEB + NE;
constexpr int PSLOTS = NBLK * MOEB;
constexpr float ALPHA = 1.6817928305074290f;
constexpr float LN_EPS = 1e-5f, NORM_EPS = 1e-6f;
constexpr int NTHREADS = 512, NWAVES = 8;

constexpr size_t MiB = 1u << 20;
constexpr size_t WS_CTL = 0;
constexpr size_t WS_HF = 1 * MiB;
constexpr size_t WS_HB = WS_HF + 64 * MiB;
constexpr size_t WS_H1F = WS_HB + 32 * MiB;
constexpr size_t WS_H1B = WS_H1F + 64 * MiB;
constexpr size_t WS_U16 = WS_H1B + 32 * MiB;
constexpr size_t WS_GT = WS_U16 + 120 * MiB;
constexpr size_t WS_Y = WS_GT + 1 * MiB;
constexpr size_t WS_TMP = WS_Y + 32 * MiB;
constexpr size_t WS_PLE = WS_TMP + 64 * MiB;
constexpr size_t WS_PB = WS_PLE + 64 * MiB;
constexpr size_t WS_GQ = WS_PB + 32 * MiB;
constexpr size_t WS_GK = WS_GQ + 32 * MiB;
constexpr size_t WS_GV = WS_GK + 32 * MiB;
constexpr size_t WS_GO = WS_GV + 32 * MiB;
constexpr size_t WS_HM = WS_GO + 32 * MiB;
constexpr size_t WS_YB = WS_HM + 144 * MiB;
constexpr size_t WS_RT = WS_YB + 144 * MiB;
constexpr size_t RT_TOPIDX = 0, RT_TOPGATE = 256 * 1024, RT_TOKSLOT = 512 * 1024, RT_SLOTTOK = 768 * 1024, RT_SLOTGATE = 1088 * 1024, RT_BLOCKE = 1408 * 1024, RT_WGCNT = 1536 * 1024  ;
constexpr size_t WS_W = WS_RT + 4 * MiB;
constexpr size_t W_IN = 0, W_OUT = 8 * MiB, W_PG = 10 * MiB, W_PP = 12 * MiB, W_GU = 13 * MiB, W_DN = 141 * MiB, W_LAYER = 205 * MiB;
constexpr size_t WS_END = WS_W + 4 * W_LAYER;
constexpr int CW_BAR = 4096;
constexpr int CW_SBQ = 8192;
constexpr int CW_MOEC = 16384;
constexpr size_t CTL_BYTES = 192 * 1024;
static_assert((CW_MOEC + DEPTH * NBLK * 16) * 4 <= (int)CTL_BYTES, "control words inside the per-call memset");

struct Params { const float* in[26]; float* out; unsigned char* ws; };

__device__ __forceinline__ float bf2f(bf16_t b) { return __uint_as_float(((unsigned)b) << 16); }
typedef __bf16 bf16x2_t __attribute__((ext_vector_type(2)));
typedef float f32x2_t __attribute__((ext_vector_type(2)));
__device__ __forceinline__ unsigned cvt_pk_bf16(float lo, float hi) { const f32x2_t v = {lo, hi}; const bf16x2_t b = __builtin_convertvector(v, bf16x2_t); return __builtin_bit_cast(unsigned, b); }
__device__ __forceinline__ unsigned f2bf(float f) { unsigned u = __float_as_uint(f); return (u + 0x7fffu + ((u >> 16) & 1u)) >> 16; }
__device__ __forceinline__ unsigned pk2(float lo, float hi) { return cvt_pk_bf16(lo, hi); }
__device__ __forceinline__ int lane_id_opaque() { int l = (int)__builtin_amdgcn_mbcnt_hi(~0u, __builtin_amdgcn_mbcnt_lo(~0u, 0u)); asm volatile("" : "+v"(l)); return l; }
__device__ __forceinline__ float shx(float v, int o, int lane) { return __uint_as_float((unsigned)__builtin_amdgcn_ds_bpermute((lane ^ o) << 2, (int)__float_as_uint(v))); }
__device__ __forceinline__ int shxi(int v, int o, int lane) { return __builtin_amdgcn_ds_bpermute((lane ^ o) << 2, v); }
__device__ __forceinline__ float wave_sum(float v) {
    const int lane = lane_id_opaque();
#pragma unroll
    for (int o = 32; o >= 1; o >>= 1) v += shx(v, o, lane);
    return v;
}
__device__ __forceinline__ float rl(float x, int d) { return __uint_as_float((unsigned)__builtin_amdgcn_readlane((int)__float_as_uint(x), d)); }
__device__ __forceinline__ float sigmoidf_(float x) { return __builtin_amdgcn_rcpf(1.0f + __expf(-x)); }
__device__ __forceinline__ float softplusf_(float x) { return fmaxf(x, 0.f) + log1pf(__expf(-fabsf(x))); }
__device__ __forceinline__ float siluf_(float x) { return x * sigmoidf_(x); }

#define XB_TMO      128
#define XB_XCNT(j)  (256  + 64 * (j))
#define XB_XSUB(j)  (1280 + 64 * (j))
#define XB_XGEN(j)  (2304 + 64 * (j))
#define XB_TOP      3328
#define XB_TOPGEN   3392
#define XCD_BAR_WORDS 3456
#define XB_SPIN_CAP (1u << 18)
__device__ __forceinline__ unsigned xb_ld(unsigned* p)              { return __hip_atomic_load(p, __ATOMIC_RELAXED, __HIP_MEMORY_SCOPE_AGENT); }
__device__ __forceinline__ unsigned xb_add(unsigned* p, unsigned v) { return __hip_atomic_fetch_add(p, v, __ATOMIC_RELAXED, __HIP_MEMORY_SCOPE_AGENT); }
__device__ __forceinline__ unsigned xb_xcc_id() { return (unsigned)__builtin_amdgcn_s_getreg((3 << 11) | 20) & 0xFu; }
#define XB_SPIN(cond, bar) do { unsigned _sp = 0; while (cond) { __builtin_amdgcn_s_sleep(1); \
    if ((++_sp & 255u) == 0u) { if (xb_ld(&(bar)[XB_TMO])) break; if (_sp > XB_SPIN_CAP) { atomicAdd(&(bar)[XB_TMO], 1u); break; } } } } while (0)
struct XcdBarrier { unsigned* bar; unsigned x; volatile LAS unsigned* st; };
__device__ __forceinline__ XcdBarrier xcd_barrier_post(unsigned* bar, volatile LAS unsigned* st) {
    XcdBarrier b; b.bar = bar; b.x = xb_xcc_id(); b.st = st;
    if (threadIdx.x == 0) (void)xb_add(&bar[XB_XCNT(b.x)], 1u);
    return b;
}
__device__ __forceinline__ void xcd_barrier_complete(unsigned* bar, unsigned x, unsigned& nloc, unsigned& nx) {
    const unsigned G = gridDim.x * gridDim.y * gridDim.z;
    unsigned sum, cnt, mine, sp = 0u;
    for (;;) {
        sum = 0u; cnt = 0u; mine = 0u;
#pragma unroll
        for (unsigned j = 0; j < 16; ++j) { const unsigned c = xb_ld(&bar[XB_XCNT(j)]); sum += c; cnt += (c > 0u) ? 1u : 0u; mine = (j == x) ? c : mine; }
        if (sum == G) break;
        __builtin_amdgcn_s_sleep(1);
        if ((++sp & 255u) == 0u) { if (xb_ld(&bar[XB_TMO])) break; if (sp > XB_SPIN_CAP) { atomicAdd(&bar[XB_TMO], 1u); break; } }
    }
    nloc = mine > 0u ? mine : 1u; nx = cnt > 0u ? cnt : 1u;
}
__device__ __forceinline__ void xcd_barrier(const XcdBarrier& b) {
    asm volatile("s_waitcnt vmcnt(0)" ::: "memory");
    __syncthreads();
    if (threadIdx.x == 0) {
        unsigned* bar = b.bar;
        __builtin_amdgcn_s_waitcnt(0);
        unsigned nloc = b.st[0], nx = b.st[1];
        if (nloc == 0u) { xcd_barrier_complete(bar, b.x, nloc, nx); b.st[0] = nloc; b.st[1] = nx; }
        const unsigned old = xb_add(&bar[XB_XSUB(b.x)], 1u);
        const unsigned gen = old / nloc;
        if (old + 1u == (gen + 1u) * nloc) {
            __builtin_amdgcn_fence(__ATOMIC_RELEASE, "agent");
            asm volatile("s_waitcnt vmcnt(0)" ::: "memory");
            const unsigned og = xb_add(&bar[XB_TOP], 1u);
            const unsigned tg = og / nx;
            if (og + 1u == (tg + 1u) * nx) xb_add(&bar[XB_TOPGEN], 1u);
            else XB_SPIN(xb_ld(&bar[XB_TOPGEN]) == tg, bar);
            __builtin_amdgcn_fence(__ATOMIC_ACQUIRE, "agent");
            xb_add(&bar[XB_XGEN(b.x)], 1u);
            asm volatile("s_waitcnt vmcnt(0)" ::: "memory");
        } else {
            XB_SPIN(xb_ld(&bar[XB_XGEN(b.x)]) == gen, bar);
            __builtin_amdgcn_fence(__ATOMIC_ACQUIRE, "agent");
            asm volatile("s_waitcnt vmcnt(0)" ::: "memory");
        }
    }
    __syncthreads();
}

constexpr int BM = 256, BK = 64, HALF = 128, HTB = HALF * BK * 2, STAGE_BYTES = 8 * HTB, NXCD = 8, WGM = 8;
constexpr int LDS_TAB = STAGE_BYTES;
constexpr int LDS_UE = LDS_TAB + 12288;
constexpr int LDS_MISC = LDS_UE + 64;
constexpr int LDS_BYTES = 147456;
__host__ __device__ __forceinline__ int lds_byte(int r, int c) { const int st = (r >> 4) * 2 + (c >> 5), rr = r & 15, cc = c & 31, ob = rr * 64 + cc * 2; return st * 1024 + (ob ^ (((ob >> 9) & 1) << 5)); }
__host__ __device__ __forceinline__ void stage_rc(int b, int& R, int& C) { const int st = b / 1024, sb = b % 1024, swz = sb ^ (((sb >> 9) & 1) << 5); R = (st >> 1) * 16 + swz / 64; C = (st & 1) * 32 + (swz % 64) / 2; }
__host__ __device__ __forceinline__ int perm32(int rho) { const int n = rho >> 4, i = rho & 15; return 8 * (i >> 2) + 4 * n + (i & 3); }

constexpr int CV_IN = 16 * 31, CV_OUT = 16 * 8, CV_PG = 16 * 8, CV_PP = 4 * 8, CV_GU1 = 16 * 16, CV_DN1 = 16 * 8;
constexpr int CV_LAYER = CV_IN + CV_OUT + CV_PG + CV_PP + NE * CV_GU1 + NE * CV_DN1;
struct Unit { int pm, pn, e, L; };
__device__ __forceinline__ void convert_item(const Params& P, int l, int r, int lane);

struct DenseOrder {
    int nM, nN, nwg, G, c, K; const char* Bt;
    __device__ void init(int M, int N, int K_, const void* Bt_, int G_, int c_) { nM = M / BM; nN = N / BM; nwg = nM * nN; G = G_; c = c_; K = K_; Bt = (const char*)Bt_; }
    __device__ __forceinline__ bool next(int i, Unit& u) const {
        const long L = (long)i * G + c; if (L >= nwg) return false;
        int wgid = (int)L; { const int q = nwg / NXCD, r = nwg % NXCD, xcd = wgid % NXCD, off = wgid / NXCD; wgid = (xcd < r ? xcd * (q + 1) : r * (q + 1) + (xcd - r) * q) + off; }
        const int nig = WGM * nN, gid = wgid / nig, fm = gid * WGM, gsz = (nM - fm) < WGM ? (nM - fm) : WGM;
        u.pm = fm + ((wgid % nig) % gsz); u.pn = (wgid % nig) / gsz; u.e = 0; u.L = (int)L; return true;
    }
    __device__ __forceinline__ const char* b_base(const Unit& u) const { return Bt + (size_t)u.pn * BM * K * 2; }
    __device__ __forceinline__ void a_ready(const Unit&) const {}
    __device__ __forceinline__ unsigned a_off(int, const Unit& u, int row) const { return (unsigned)(u.pm * BM + row) * (unsigned)(K * 2); }
};
template <bool GATHER> struct MoeOrder {
    int nN, nunits, G, cm, K; const char* Wt; size_t estride; const LAS int* tab; const LAS int* ue;
    unsigned* ready;
    __device__ __forceinline__ void a_ready(const Unit& u) const {
        if (GATHER) return;
        if (threadIdx.x < 64) {
            unsigned sp = 0;
            while ((unsigned)__builtin_amdgcn_readfirstlane(__hip_atomic_load(ready + 16 * u.pm, __ATOMIC_RELAXED, __HIP_MEMORY_SCOPE_AGENT)) < 64u) { __builtin_amdgcn_s_sleep(2); if (++sp > (1u << 21)) break; }
            __builtin_amdgcn_fence(__ATOMIC_ACQUIRE, "agent");
            asm volatile("s_waitcnt vmcnt(0)" ::: "memory");
        }
        asm volatile("" ::: "memory"); __builtin_amdgcn_s_barrier(); asm volatile("" ::: "memory");
    }
    __device__ __forceinline__ bool next(int i, Unit& u) const {
        const int L = i * G + cm; if (L >= nunits) return false;
        u.pm = L / nN; u.pn = L - u.pm * nN; u.e = ue[i]; u.L = L; return true;
    }
    __device__ __forceinline__ const char* b_base(const Unit& u) const { return Wt + (size_t)u.e * estride + (size_t)u.pn * BM * K * 2; }
    __device__ __forceinline__ unsigned a_off(int i, const Unit& u, int row) const {
        if (GATHER) return (unsigned)tab[i * 256 + row] * (unsigned)(K * 2);
        return (unsigned)(u.pm * BM + row) * (unsigned)(K * 2);
    }
};

template <class Epi, class Sched>
__device__ __forceinline__ void gemm_phase(LAS unsigned char* lds, const int tid, const char* Abase, const int K, const Sched& S, const Epi& E) {
    const int wid = __builtin_amdgcn_readfirstlane(tid >> 6), lane = tid & 63, wr = wid >> 2, wc = wid & 3, fr = lane & 15, fq = lane >> 4;
    const int nt = K / BK;
    int Rr[2]; unsigned cb[2], voffB[2];
#pragma unroll
    for (int i = 0; i < 2; ++i) { int R, C; stage_rc(tid * 16 + i * 8192, R, C); const int Rb = Epi::PERM ? ((R & ~31) + perm32(R & 31)) : R;
        Rr[i] = R; cb[i] = (unsigned)C * 2u; voffB[i] = (unsigned)(Rb * K + C) * 2u; }
    const size_t kstep = (size_t)(BK * 2);
    const size_t hstep = (size_t)HALF * K * 2;
    const unsigned ldsw = (unsigned)wid * 1024u;
    const int aoff = lds_byte(wr * 64 + fr, fq * 8), boff = lds_byte(wc * 32 + fr, fq * 8);
#define G_SA(b, h) (((b) * 2 + (h)) * HTB)
#define G_SB(b, h) ((4 + (b) * 2 + (h)) * HTB)
#define G_STAGE_B(bufoff, gbase) do { _Pragma("unroll") for (int _i = 0; _i < 2; ++_i) \
        __builtin_amdgcn_global_load_lds((const unsigned*)((const char*)(gbase) + voffB[_i]), (LAS unsigned*)(lds + (bufoff) + ldsw + _i * 8192), 16, 0, 0); } while (0)
#define G_STAGE_A(bufoff, kbyte, ao) do { _Pragma("unroll") for (int _i = 0; _i < 2; ++_i) \
        __builtin_amdgcn_global_load_lds((const unsigned*)(Abase + (size_t)(kbyte) + (ao)[_i]), (LAS unsigned*)(lds + (bufoff) + ldsw + _i * 8192), 16, 0, 0); } while (0)
#define G_LDA(dst, b, h) do { _Pragma("unroll") for (int m = 0; m < 4; ++m) _Pragma("unroll") for (int k = 0; k < 2; ++k) dst[m][k] = *(const LAS bf16x8*)(lds + G_SA(b, h) + aoff + m * 2048 + k * 1024); } while (0)
#define G_LDB(dst, b, h) do { _Pragma("unroll") for (int n = 0; n < 2; ++n) _Pragma("unroll") for (int k = 0; k < 2; ++k) dst[n][k] = *(const LAS bf16x8*)(lds + G_SB(b, h) + boff + n * 2048 + k * 1024); } while (0)
#define G_MMA(ai, bj, At, Bt) do { __builtin_amdgcn_s_setprio(1); _Pragma("unroll") for (int m = 0; m < 4; ++m) _Pragma("unroll") for (int n = 0; n < 2; ++n) _Pragma("unroll") for (int k = 0; k < 2; ++k) \
        acc[ai][bj][m][n] = __builtin_amdgcn_mfma_f32_16x16x32_bf16(Bt[n][k], At[m][k], acc[ai][bj][m][n], 0, 0, 0); __builtin_amdgcn_s_setprio(0); } while (0)
#define G_WAIT_V(n) asm volatile("s_waitcnt vmcnt(" #n ")" ::: "memory")
#define G_WAIT_L(n) asm volatile("s_waitcnt lgkmcnt(" #n ")" ::: "memory")
#define G_BAR __builtin_amdgcn_s_barrier()
#define G_SCHED __builtin_amdgcn_sched_barrier(0)
    Unit cur, nxt; int ui = 0;
    if (!S.next(0, cur)) return;
    f32x4 acc[2][2][4][2];
#pragma unroll
    for (int a = 0; a < 2; ++a)
#pragma unroll
        for (int b = 0; b < 2; ++b)
#pragma unroll
            for (int m = 0; m < 4; ++m)
#pragma unroll
                for (int n = 0; n < 2; ++n) acc[a][b][m][n] = (f32x4){0.f, 0.f, 0.f, 0.f};
    bf16x8 At[4][2], B0[2][2], B1[2][2];
    unsigned aoc[2][2], aon[2][2];
#pragma unroll
    for (int h = 0; h < 2; ++h)
#pragma unroll
        for (int i = 0; i < 2; ++i) aoc[h][i] = S.a_off(0, cur, h * HALF + Rr[i]) + cb[i];
    const char* cB = S.b_base(cur);
    S.a_ready(cur);
    Unit prv = cur; bool have_prv = false;
    G_STAGE_B(G_SB(0, 0), cB); G_STAGE_A(G_SA(0, 0), 0, aoc[0]); G_STAGE_B(G_SB(0, 1), cB + hstep); G_STAGE_A(G_SA(0, 1), 0, aoc[1]);
    if (wr == 1) G_BAR;
    G_WAIT_V(4); G_BAR;
    G_STAGE_B(G_SB(1, 0), cB + kstep); G_STAGE_A(G_SA(1, 0), kstep, aoc[0]); G_STAGE_B(G_SB(1, 1), cB + hstep + kstep);
    G_WAIT_V(6); G_BAR;
    for (;;) {
        const bool has_next = S.next(ui + 1, nxt);
        const char* nB = has_next ? S.b_base(nxt) : cB;
#pragma unroll
        for (int h = 0; h < 2; ++h)
#pragma unroll
            for (int i = 0; i < 2; ++i) aon[h][i] = has_next ? (S.a_off(ui + 1, nxt, h * HALF + Rr[i]) + cb[i]) : aoc[h][i];
        for (int t = 0; t < nt; t += 2) {
            const bool last = (t == nt - 2);
            if (last) { if (have_prv) { E.publish(prv, lane); have_prv = false; } if (has_next) S.a_ready(nxt); }
            const size_t k1 = (size_t)(t + 1) * kstep;
            const size_t k2 = last ? (size_t)0 : (size_t)(t + 2) * kstep;
            const char* b2 = last ? nB : cB + (size_t)(t + 2) * kstep;
            const char* b3 = b2 + kstep;
            unsigned a2o[2][2];
#pragma unroll
            for (int h = 0; h < 2; ++h)
#pragma unroll
                for (int i = 0; i < 2; ++i) a2o[h][i] = last ? aon[h][i] : aoc[h][i];
            G_LDB(B0, 0, 0); G_SCHED; G_LDA(At, 0, 0); G_STAGE_A(G_SA(1, 1), k1, aoc[1]);
            G_WAIT_L(8); G_BAR; G_WAIT_L(0); G_MMA(0, 0, At, B0); G_BAR; G_SCHED;
            G_LDB(B1, 0, 1); G_STAGE_B(G_SB(0, 0), b2);
            G_BAR; G_WAIT_L(0); G_MMA(0, 1, At, B1); G_BAR;
            G_LDA(At, 0, 1); G_STAGE_A(G_SA(0, 0), k2, a2o[0]);
            G_BAR; G_WAIT_L(0); G_MMA(1, 0, At, B0); G_BAR; G_SCHED;
            G_STAGE_B(G_SB(0, 1), b2 + hstep);
            G_WAIT_V(6); G_BAR; G_MMA(1, 1, At, B1); G_BAR;
            G_LDB(B0, 1, 0); G_SCHED; G_LDA(At, 1, 0); G_STAGE_A(G_SA(0, 1), k2, a2o[1]);
            G_WAIT_L(8); G_BAR; G_WAIT_L(0); G_MMA(0, 0, At, B0); G_BAR; G_SCHED;
            G_LDB(B1, 1, 1); G_STAGE_B(G_SB(1, 0), b3);
            G_BAR; G_WAIT_L(0); G_MMA(0, 1, At, B1); G_BAR;
            G_LDA(At, 1, 1); G_STAGE_A(G_SA(1, 0), k2 + kstep, a2o[0]);
            G_BAR; G_WAIT_L(0); G_MMA(1, 0, At, B0); G_BAR; G_SCHED;
            G_STAGE_B(G_SB(1, 1), b3 + hstep);
            G_WAIT_V(6); G_BAR; G_MMA(1, 1, At, B1); G_BAR;
        }
        E(acc, cur, wr, wc, fr, fq);
        prv = cur; have_prv = true;
        E.after_unit(cur, wid, lane);
        if (!has_next) break;
#pragma unroll
        for (int a = 0; a < 2; ++a)
#pragma unroll
            for (int b = 0; b < 2; ++b)
#pragma unroll
                for (int m = 0; m < 4; ++m)
#pragma unroll
                    for (int n = 0; n < 2; ++n) acc[a][b][m][n] = (f32x4){0.f, 0.f, 0.f, 0.f};
        cur = nxt; cB = nB; ++ui;
#pragma unroll
        for (int h = 0; h < 2; ++h)
#pragma unroll
            for (int i = 0; i < 2; ++i) aoc[h][i] = aon[h][i];
    }
    G_WAIT_V(0);
    if (have_prv) E.publish(prv, lane);
    if (wr == 0) G_BAR;
    G_BAR;
#undef G_SA
#undef G_SB
#undef G_STAGE_A
#undef G_STAGE_B
#undef G_LDA
#undef G_LDB
#undef G_MMA
#undef G_WAIT_V
#undef G_WAIT_L
#undef G_BAR
#undef G_SCHED
}

struct EpiU {
    static constexpr bool PERM = true;
    __device__ __forceinline__ void after_unit(const Unit&, int, int) const {}
    __device__ __forceinline__ void publish(const Unit&, int) const {}
    bf16_t* U; float* GT;
    __device__ __forceinline__ void operator()(const f32x4 (&acc)[2][2][4][2], const Unit& u, int wr, int wc, int fr, int fq) const {
        const int row0 = u.pm * BM + wr * 64 + fr;
        if (u.pn < 15) {
            const int col0 = u.pn * BM + wc * 32 + 8 * fq;
#pragma unroll
            for (int ai = 0; ai < 2; ++ai)
#pragma unroll
                for (int m = 0; m < 4; ++m) { bf16_t* rowp = U + (size_t)(row0 + ai * HALF + m * 16) * NU + col0;
#pragma unroll
                    for (int bj = 0; bj < 2; ++bj) { const f32x4 v0 = acc[ai][bj][m][0], v1 = acc[ai][bj][m][1];
                        u32x4 w; w.x = cvt_pk_bf16(v0[0], v0[1]); w.y = cvt_pk_bf16(v0[2], v0[3]); w.z = cvt_pk_bf16(v1[0], v1[1]); w.w = cvt_pk_bf16(v1[2], v1[3]);
                        ST16_NT(rowp + bj * HALF, w); } }
        } else if (wc == 0 && fq < 2) {
#pragma unroll
            for (int ai = 0; ai < 2; ++ai)
#pragma unroll
                for (int m = 0; m < 4; ++m) { float* rowp = GT + (size_t)(row0 + ai * HALF + m * 16) * 16 + 8 * fq;
#pragma unroll
                    for (int n = 0; n < 2; ++n) *(f32x4*)(rowp + 4 * n) = acc[ai][0][m][n]; }
        }
    }
};
template <int MODE  > struct EpiF32 {
    static constexpr bool PERM = false;
    __device__ __forceinline__ void after_unit(const Unit&, int, int) const {}
    __device__ __forceinline__ void publish(const Unit&, int) const {}
    float* C; int ldc; const float* Src;
    __device__ __forceinline__ void operator()(const f32x4 (&acc)[2][2][4][2], const Unit& u, int wr, int wc, int fr, int fq) const {
        const int row0 = u.pm * BM + wr * 64 + fr, col0 = u.pn * BM + wc * 32 + 4 * fq;
#pragma unroll
        for (int ai = 0; ai < 2; ++ai)
#pragma unroll
            for (int m = 0; m < 4; ++m) { float* rowp = C + (size_t)(row0 + ai * HALF + m * 16) * ldc + col0;
#pragma unroll
                for (int bj = 0; bj < 2; ++bj)
#pragma unroll
                    for (int n = 0; n < 2; ++n) { f32x4 v = acc[ai][bj][m][n];
                        if (MODE == 1) { const f32x4 o = *(const f32x4*)(Src + (size_t)(row0 + ai * HALF + m * 16) * ldc + col0 + bj * HALF + n * 16);
#pragma unroll
                            for (int j = 0; j < 4; ++j) v[j] = sigmoidf_(v[j]) * o[j]; }
                        *(f32x4*)(rowp + bj * HALF + n * 16) = v; } }
    }
};
template <int MODE  > struct EpiB16 {
    static constexpr bool PERM = true;
    __device__ __forceinline__ void after_unit(const Unit&, int, int) const {}
    __device__ __forceinline__ void publish(const Unit&, int) const {}
    bf16_t* O; int ldc; const bf16_t* Src;
    __device__ __forceinline__ void operator()(const f32x4 (&acc)[2][2][4][2], const Unit& u, int wr, int wc, int fr, int fq) const {
        const int row0 = u.pm * BM + wr * 64 + fr, col0 = u.pn * BM + wc * 32 + 8 * fq;
#pragma unroll
        for (int ai = 0; ai < 2; ++ai)
#pragma unroll
            for (int m = 0; m < 4; ++m) { const size_t off = (size_t)(row0 + ai * HALF + m * 16) * ldc + col0;
#pragma unroll
                for (int bj = 0; bj < 2; ++bj) { f32x4 v0 = acc[ai][bj][m][0], v1 = acc[ai][bj][m][1];
                    if (MODE == 1) { const u32x4 g = *(const u32x4*)(Src + off + bj * HALF);
                        v0[0] = sigmoidf_(v0[0]) * __uint_as_float(g.x << 16); v0[1] = sigmoidf_(v0[1]) * __uint_as_float(g.x & 0xffff0000u); v0[2] = sigmoidf_(v0[2]) * __uint_as_float(g.y << 16); v0[3] = sigmoidf_(v0[3]) * __uint_as_float(g.y & 0xffff0000u);
                        v1[0] = sigmoidf_(v1[0]) * __uint_as_float(g.z << 16); v1[1] = sigmoidf_(v1[1]) * __uint_as_float(g.z & 0xffff0000u); v1[2] = sigmoidf_(v1[2]) * __uint_as_float(g.w << 16); v1[3] = sigmoidf_(v1[3]) * __uint_as_float(g.w & 0xffff0000u); }
                    u32x4 w; w.x = cvt_pk_bf16(v0[0], v0[1]); w.y = cvt_pk_bf16(v0[2], v0[3]); w.z = cvt_pk_bf16(v1[0], v1[1]); w.w = cvt_pk_bf16(v1[2], v1[3]);
                    *(u32x4*)(O + off + bj * HALF) = w; } }
    }
};
struct EpiMoe1 {
    static constexpr bool PERM = true;
    Params Pc; int lnext, G, nunits;
    __device__ __forceinline__ void after_unit(const Unit& u, int wid, int lane) const {
        if (lnext >= DEPTH) return;
        const int i = u.L / G, c = u.L - i * G;
        if (i != (c & 7)) return;
        const int n9 = nunits - 8 * G > 0 ? (nunits - 8 * G < G ? nunits - 8 * G : G) : 0, n8 = G - n9;
        int x = (CV_LAYER / NWAVES - 3 * n8 + G - 1) / G; if (x < 0) x = 0;
        const int cnt = c < n9 ? x : x + 3, start = c < n9 ? c * NWAVES * x : n9 * NWAVES * x + (c - n9) * NWAVES * (x + 3);
        for (int k = 0; k < cnt; ++k) { const int idx = start + wid * cnt + k; if (idx < CV_LAYER) convert_item(Pc, lnext, idx, lane); }
    }
    bf16_t* H; const float* b_gu;
    unsigned* ready;
    __device__ __forceinline__ void publish(const Unit& u, int lane) const { if (lane == 0) __hip_atomic_fetch_add(ready + 16 * u.pm, 1u, __ATOMIC_RELAXED, __HIP_MEMORY_SCOPE_AGENT); }
    __device__ __forceinline__ void operator()(const f32x4 (&acc)[2][2][4][2], const Unit& u, int wr, int wc, int fr, int fq) const {
        const int row0 = u.pm * BM + wr * 64 + fr, col0 = u.pn * HALF + wc * 32 + 8 * fq;
        f32x4 bg[2], bu[2];
#pragma unroll
        for (int n = 0; n < 2; ++n) { bg[n] = *(const f32x4*)(b_gu + (size_t)u.e * 2048 + col0 + 4 * n); bu[n] = *(const f32x4*)(b_gu + (size_t)u.e * 2048 + 1024 + col0 + 4 * n); }
#pragma unroll
        for (int ai = 0; ai < 2; ++ai)
#pragma unroll
            for (int m = 0; m < 4; ++m) { float o[8];
#pragma unroll
                for (int n = 0; n < 2; ++n)
#pragma unroll
                    for (int j = 0; j < 4; ++j) { float g = acc[ai][0][m][n][j] + bg[n][j], up = acc[ai][1][m][n][j] + bu[n][j];
                        g = fminf(g, 7.0f); up = fminf(fmaxf(up, -7.0f), 7.0f);
                        o[n * 4 + j] = (up + 1.0f) * g * sigmoidf_(1.702f * g); }
                u32x4 w; w.x = cvt_pk_bf16(o[0], o[1]); w.y = cvt_pk_bf16(o[2], o[3]); w.z = cvt_pk_bf16(o[4], o[5]); w.w = cvt_pk_bf16(o[6], o[7]);
                st16_wt(H + (size_t)(row0 + ai * HALF + m * 16) * DFF + col0, w); }
    }
};
struct EpiMoe2 {
    static constexpr bool PERM = true;
    __device__ __forceinline__ void after_unit(const Unit&, int, int) const {}
    __device__ __forceinline__ void publish(const Unit&, int) const {}
    bf16_t* Yb; const float* b_down; const float* slot_gate;
    __device__ __forceinline__ void operator()(const f32x4 (&acc)[2][2][4][2], const Unit& u, int wr, int wc, int fr, int fq) const {
        const int row0 = u.pm * BM + wr * 64 + fr, col0 = u.pn * BM + wc * 32 + 8 * fq;
        f32x4 bv[2][2];
#pragma unroll
        for (int bj = 0; bj < 2; ++bj)
#pragma unroll
            for (int n = 0; n < 2; ++n) bv[bj][n] = *(const f32x4*)(b_down + (size_t)u.e * D + col0 + bj * HALF + 4 * n);
#pragma unroll
        for (int ai = 0; ai < 2; ++ai)
#pragma unroll
            for (int m = 0; m < 4; ++m) { const int row = row0 + ai * HALF + m * 16; const float gt = slot_gate[row];
#pragma unroll
                for (int bj = 0; bj < 2; ++bj) { const f32x4 v0 = (acc[ai][bj][m][0] + bv[bj][0]) * gt, v1 = (acc[ai][bj][m][1] + bv[bj][1]) * gt;
                    u32x4 w; w.x = cvt_pk_bf16(v0[0], v0[1]); w.y = cvt_pk_bf16(v0[2], v0[3]); w.z = cvt_pk_bf16(v1[0], v1[1]); w.w = cvt_pk_bf16(v1[2], v1[3]);
                    ST16_NT(Yb + (size_t)row * D + col0 + bj * HALF, w); } }
    }
};

struct Ctx {
    LAS unsigned char* lds; int tid, lane, wave, G, bid;
};
#define WSP(T_, off) ((T_*)(P.ws + (off)))
__device__ __forceinline__ unsigned* ctl_words(const Params& P) { return (unsigned*)(P.ws + WS_CTL); }

__device__ __forceinline__ int map_win(int n) { return n < 1024 ? n : (n < 1032 ? n + 2816 : (n < 3848 ? n - 8 : n)); }
__device__ __forceinline__ int map_wgu(int n) { return n < 1024 ? ((n >> 7) * 256 + (n & 127)) : ((((n - 1024) >> 7) * 256) + 128 + ((n - 1024) & 127)); }
__device__ __forceinline__ void transpose_item(const float* W, int K, int N, bf16_t* WT, int map, int item, int lane) {
    const int nblk = (N + 127) / 128, kb = item / nblk, nb = item - kb * nblk;
    const int half = lane >> 5, nq = lane & 31, n = nb * 128 + 4 * nq, k0 = kb * 64 + 32 * half;
    if (n >= N) return;
    f32x4 v[32];
#pragma unroll
    for (int i = 0; i < 32; ++i) v[i] = *(const f32x4*)(W + (size_t)(k0 + i) * N + n);
#pragma unroll
    for (int j = 0; j < 4; ++j) { const int ng = n + j; const int nr = map == 1 ? map_win(ng) : (map == 2 ? map_wgu(ng) : ng); bf16_t* dst = WT + (size_t)nr * K + k0;
#pragma unroll
        for (int c = 0; c < 4; ++c) { u32x4 o;
#pragma unroll
            for (int x = 0; x < 4; ++x) o[x] = cvt_pk_bf16(v[8 * c + 2 * x][j], v[8 * c + 2 * x + 1][j]);
            *(u32x4*)(dst + 8 * c) = o; } }
}
__device__ __forceinline__ void convert_item(const Params& P, int l, int r, int lane) {
    unsigned char* wl = P.ws + WS_W + (size_t)l * W_LAYER;
    const float* W; bf16_t* WT; int K = D, N = D, map = 0;
    if (r < CV_IN) { W = P.in[4] + (size_t)l * D * DIN; N = DIN; WT = (bf16_t*)(wl + W_IN); map = 1; }
    else if ((r -= CV_IN) < CV_OUT) { W = P.in[13] + (size_t)l * D * D; WT = (bf16_t*)(wl + W_OUT); }
    else if ((r -= CV_OUT) < CV_PG) { W = P.in[22] + (size_t)l * D * D; WT = (bf16_t*)(wl + W_PG); }
    else if ((r -= CV_PG) < CV_PP) { W = P.in[23] + (size_t)l * 256 * D; K = 256; WT = (bf16_t*)(wl + W_PP); }
    else if ((r -= CV_PP) < NE * CV_GU1) { const int e = r / CV_GU1; r -= e * CV_GU1; W = P.in[18] + ((size_t)l * NE + e) * D * 2048; N = 2048; WT = (bf16_t*)(wl + W_GU) + (size_t)e * 2048 * D; map = 2; }
    else { r -= NE * CV_GU1; const int e = r / CV_DN1; r -= e * CV_DN1; W = P.in[20] + ((size_t)l * NE + e) * DFF * D; WT = (bf16_t*)(wl + W_DN) + (size_t)e * D * DFF; }
    transpose_item(W, K, N, WT, map, r, lane);
}
__device__ __forceinline__ void ln_store_row(const float (&v)[16], float rstd, const float* g, const float* b, float* of, bf16_t* ob, int lane) {
#pragma unroll
    for (int j = 0; j < 4; ++j) { const int c = 4 * lane + 256 * j; const f32x4 gg = *(const f32x4*)(g + c), bb = *(const f32x4*)(b + c);
        f32x4 o; o[0] = v[4 * j] * rstd * gg[0] + bb[0]; o[1] = v[4 * j + 1] * rstd * gg[1] + bb[1]; o[2] = v[4 * j + 2] * rstd * gg[2] + bb[2]; o[3] = v[4 * j + 3] * rstd * gg[3] + bb[3];
        if (of) *(f32x4*)(of + c) = o;
        if (ob) { u32x2 w; w.x = pk2(o[0], o[1]); w.y = pk2(o[2], o[3]); *(u32x2*)(ob + c) = w; } }
}
__device__ __forceinline__ void phase_prologue(const Params& P, const Ctx& C) {
    const int gw = C.bid * NWAVES + C.wave, NGW = C.G * NWAVES;
    for (int it = gw; it < CV_LAYER; it += NGW) convert_item(P, 0, it, C.lane);
    { const float* p = P.in[1]; bf16_t* pb = WSP(bf16_t, WS_PB); const size_t n4 = (size_t)DEPTH * T * 256 / 4;
      const size_t stride = (size_t)C.G * NTHREADS;
      for (size_t i0 = (size_t)C.bid * NTHREADS + C.tid; i0 < n4; i0 += 8 * stride) {
          f32x4 v[8];
#pragma unroll
          for (int k = 0; k < 8; ++k) { const size_t i = i0 + k * stride; if (i < n4) v[k] = *(const f32x4*)(p + 4 * i); }
#pragma unroll
          for (int k = 0; k < 8; ++k) { const size_t i = i0 + k * stride; if (i < n4) { u32x2 w; w.x = pk2(v[k][0], v[k][1]); w.y = pk2(v[k][2], v[k][3]); *(u32x2*)(pb + 4 * i) = w; } } } }
    for (int row0 = gw; row0 < T; row0 += 2 * NGW) {
        float v[2][16]; float s[2] = {0.f, 0.f};
#pragma unroll
        for (int k = 0; k < 2; ++k) { const int row = row0 + k * NGW < T ? row0 + k * NGW : row0; const float* x = P.in[0] + (size_t)row * D;
#pragma unroll
            for (int j = 0; j < 4; ++j) { const f32x4 t = *(const f32x4*)(x + 4 * C.lane + 256 * j); v[k][4 * j] = t[0]; v[k][4 * j + 1] = t[1]; v[k][4 * j + 2] = t[2]; v[k][4 * j + 3] = t[3]; s[k] += (t[0] + t[1]) + (t[2] + t[3]); } }
#pragma unroll
        for (int k = 0; k < 2; ++k) { const int row = row0 + k * NGW; if (row < T) {
            const float mean = wave_sum(s[k]) * (1.f / D); float q = 0.f;
#pragma unroll
            for (int i = 0; i < 16; ++i) { v[k][i] -= mean; q += v[k][i] * v[k][i]; }
            const float rstd = rsqrtf(wave_sum(q) * (1.f / D) + LN_EPS);
            ln_store_row(v[k], rstd, P.in[2], P.in[3], nullptr, WSP(bf16_t, WS_HB) + (size_t)row * D, C.lane); } }
    }
}

__device__ __forceinline__ void phase_inproj(const Params& P, const Ctx& C, int l) {
    DenseOrder S; S.init(T, NINP, D, P.ws + WS_W + (size_t)l * W_LAYER + W_IN, C.G, C.bid);
    EpiU E{WSP(bf16_t, WS_U16), WSP(float, WS_GT)};
    gemm_phase(C.lds, C.tid, (const char*)(P.ws + WS_HB), D, S, E);
}

typedef float f32x16 __attribute__((ext_vector_type(16)));
#define MFMA32(a, b, c) __builtin_amdgcn_mfma_f32_32x32x16_bf16((a), (b), (c), 0, 0, 0)
constexpr int SB_KSTR = 72, SB_VSTR = 68, SB_KBYTES = 64 * SB_KSTR * 2, SB_BUF = SB_KBYTES + 64 * SB_VSTR * 2;
__device__ __forceinline__ float shx32(float v, int lane) { return __uint_as_float((unsigned)__builtin_amdgcn_ds_bpermute((lane ^ 32) << 2, (int)__float_as_uint(v))); }
template <bool DIAG> __device__ __forceinline__ void sb_tile_math(const f32x16& sacc, float& carry, bf16x8 (&pf)[2], int r, int hh, int lane) {
    float sg[16], om[16];
#pragma unroll
    for (int i = 0; i < 16; ++i) {
        const float t = fminf(sacc[i] * (-0.125f * 1.4426950408889634f), 80.f);
        const float e = __builtin_amdgcn_exp2f(t);
        float sgm = __builtin_amdgcn_rcpf(1.0f + e), omv = e * sgm;
        if (DIAG) { const int srow_i = (i & 3) + 8 * (i >> 2) + 4 * hh; const bool masked = srow_i >= r; sgm = masked ? 0.f : sgm; omv = masked ? 1.f : omv; }
        sg[i] = sgm; om[i] = omv;
    }
    float sfx[16], pg[4], pp[4], both[4];
#pragma unroll
    for (int g = 0; g < 4; ++g) { sfx[4 * g + 3] = 1.f; sfx[4 * g + 2] = om[4 * g + 3]; sfx[4 * g + 1] = sfx[4 * g + 2] * om[4 * g + 2]; sfx[4 * g] = sfx[4 * g + 1] * om[4 * g + 1]; pg[g] = sfx[4 * g] * om[4 * g]; }
#pragma unroll
    for (int g = 0; g < 4; ++g) { pp[g] = shx32(pg[g], lane); both[g] = pg[g] * pp[g]; }
    float outer[4];
    outer[3] = 1.f; outer[2] = both[3]; outer[1] = both[3] * both[2]; outer[0] = outer[1] * both[1];
    const float total = outer[0] * both[0];
#pragma unroll
    for (int g = 0; g < 4; ++g) { if (hh == 0) outer[g] *= pp[g]; outer[g] *= carry; }
    carry *= total;
#pragma unroll
    for (int s2 = 0; s2 < 2; ++s2) { u32x4 pk;
#pragma unroll
        for (int x = 0; x < 4; ++x) { const int i0 = 8 * s2 + 2 * x; pk[x] = cvt_pk_bf16(sg[i0] * (sfx[i0] * outer[i0 >> 2]), sg[i0 + 1] * (sfx[i0 + 1] * outer[(i0 + 1) >> 2])); }
        pf[s2] = __builtin_bit_cast(bf16x8, pk); }
}
__device__ __forceinline__ void sb_unit(const Params& P, const Ctx& C, int l, int b, int h, int qb) {
    const bf16_t* base = WSP(bf16_t, WS_U16) + (size_t)b * SEQ * NU;
    int tid_ = C.tid; asm volatile("" : "+v"(tid_));
    const int w = __builtin_amdgcn_readfirstlane(tid_ >> 6), lane = tid_ & 63, r = lane & 31, hh = lane >> 5;
    const int q0 = qb * 256 + 32 * w;
    bf16x8 qf[4];
#pragma unroll
    for (int kk = 0; kk < 4; ++kk) qf[kk] = *(const bf16x8*)(base + (size_t)(q0 + r) * NU + U_SQ + h * 64 + 16 * kk + 8 * hh);
    f32x16 oacc[2];
#pragma unroll
    for (int i = 0; i < 16; ++i) { oacc[0][i] = 0.f; oacc[1][i] = 0.f; }
    float carry = 1.f;
    const int nst = 4 * (qb + 1);
    const int srow = tid_ >> 3, scol = (tid_ & 7) * 8;
    LAS unsigned* alive = (LAS unsigned*)(C.lds + 2 * SB_BUF);
    u32x4 kreg, vreg;
    { const bf16_t* rowp = base + (size_t)(64 * (nst - 1) + srow) * NU + h * 64 + scol; kreg = *(const u32x4*)(rowp + U_SK); vreg = *(const u32x4*)(rowp + U_SV); }
    for (int st = nst - 1; st >= 0; --st) {
        LAS unsigned char* buf = C.lds + (st & 1) * SB_BUF;
        *(LAS u32x4*)(buf + (srow * SB_KSTR + scol) * 2) = kreg;
        { LAS bf16_t* vt = (LAS bf16_t*)(buf + SB_KBYTES);
#pragma unroll
          for (int j = 0; j < 4; ++j) { vt[(scol + 2 * j) * SB_VSTR + srow] = (bf16_t)(vreg[j] & 0xffffu); vt[(scol + 2 * j + 1) * SB_VSTR + srow] = (bf16_t)(vreg[j] >> 16); } }
        const bool wave_alive = __any(carry != 0.f) != 0;
        if (lane == 0) alive[(st & 1) * 8 + w] = wave_alive ? 1u : 0u;
        __syncthreads();
        { unsigned any_alive = 0u;
#pragma unroll
          for (int i = 0; i < 8; ++i) any_alive |= alive[(st & 1) * 8 + i];
          if (any_alive == 0u) break; }
        if (st > 0) { const bf16_t* rowp = base + (size_t)(64 * (st - 1) + srow) * NU + h * 64 + scol; kreg = *(const u32x4*)(rowp + U_SK); vreg = *(const u32x4*)(rowp + U_SV); }
        const LAS bf16_t* vt = (const LAS bf16_t*)(buf + SB_KBYTES);
#pragma unroll
        for (int half = 1; half >= 0; --half) {
            const int kb = 64 * st + 32 * half;
            if (kb >= q0 + 32 || !wave_alive) continue;
            const bool diag = (kb == q0);
            f32x16 sacc;
#pragma unroll
            for (int i = 0; i < 16; ++i) sacc[i] = 0.f;
#pragma unroll
            for (int kk = 0; kk < 4; ++kk) { const bf16x8 kf = *(const LAS bf16x8*)(buf + ((32 * half + r) * SB_KSTR + 16 * kk + 8 * hh) * 2); sacc = MFMA32(kf, qf[kk], sacc); }
            bf16x8 pf[2];
            if (diag) sb_tile_math<true>(sacc, carry, pf, r, hh, lane); else sb_tile_math<false>(sacc, carry, pf, r, hh, lane);
#pragma unroll
            for (int dt = 0; dt < 2; ++dt)
#pragma unroll
                for (int s2 = 0; s2 < 2; ++s2) { const LAS bf16_t* vrow = vt + (32 * dt + r) * SB_VSTR + 32 * half + 16 * s2 + 4 * hh;
                    const u32x2 lo = *(const LAS u32x2*)vrow, hi = *(const LAS u32x2*)(vrow + 8);
                    u32x4 vv; vv.x = lo.x; vv.y = lo.y; vv.z = hi.x; vv.w = hi.y;
                    oacc[dt] = MFMA32(__builtin_bit_cast(bf16x8, vv), pf[s2], oacc[dt]); }
        }
    }
    float ss = 0.f;
#pragma unroll
    for (int i = 0; i < 16; ++i) ss += oacc[0][i] * oacc[0][i] + oacc[1][i] * oacc[1][i];
    ss += shx32(ss, lane);
    const float sc = rsqrtf(ss * (1.f / 64.f) + NORM_EPS);
    const float* nw = P.in[8] + l * 256 + h * 64;
    bf16_t* yrow = WSP(bf16_t, WS_Y) + (size_t)(b * SEQ + q0 + r) * D + 256 + h * 64;
#pragma unroll
    for (int dt = 0; dt < 2; ++dt)
#pragma unroll
        for (int g = 0; g < 4; ++g) { const int d0 = 32 * dt + 8 * g + 4 * hh; const f32x4 n4 = *(const f32x4*)(nw + d0);
            u32x2 o2; o2.x = cvt_pk_bf16(oacc[dt][4 * g] * sc * n4[0], oacc[dt][4 * g + 1] * sc * n4[1]); o2.y = cvt_pk_bf16(oacc[dt][4 * g + 2] * sc * n4[2], oacc[dt][4 * g + 3] * sc * n4[3]);
            *(u32x2*)(yrow + d0) = o2; }
    __syncthreads();
}

constexpr int ML_STR = 72;
constexpr int ML_MAT = 64 * ML_STR * 2;
constexpr int ML_STAGE = 4 * ML_MAT;
constexpr int ML_K = 0, ML_Q = ML_MAT, ML_VT = 2 * ML_MAT, ML_KWT = 3 * ML_MAT;
constexpr int ML_CT = 2 * ML_STAGE  , ML_N = ML_CT + 2 * ML_MAT  , ML_SSQ = ML_N + 512  ,
              ML_GB = ML_SSQ + 1024  , ML_GWL = ML_GB + 8192, ML_GEB = ML_GWL + 8192, ML_GWG = ML_GEB + 8192  , ML_GG = ML_GWG + 8192  , ML_END = ML_GG + 128;
static_assert(ML_END <= LDS_TAB, "mLSTM LDS map");
__device__ __forceinline__ float shup(float v, int o, int lane) { return __uint_as_float((unsigned)__builtin_amdgcn_ds_bpermute((lane - o) << 2, (int)__float_as_uint(v))); }
__device__ __forceinline__ float shidx(float v, int src) { return __uint_as_float((unsigned)__builtin_amdgcn_ds_bpermute(src << 2, (int)__float_as_uint(v))); }
__device__ __forceinline__ void mlstm_unit(const Params& P, const Ctx& C, int l, int b, int h, int par) {
    const bf16_t* U = WSP(bf16_t, WS_U16) + (size_t)b * SEQ * NU; const float* GT = WSP(float, WS_GT) + (size_t)b * SEQ * 16;
    LAS unsigned char* lds = C.lds;
    const int w = C.wave, lane = C.lane, r = lane & 31, hh = lane >> 5, tid = C.tid;
    const float ib = P.in[5][l * 4 + h], fb = P.in[6][l * 4 + h];
    for (int i = tid; i < (2 * ML_MAT + 512 + 1024) / 4; i += NTHREADS) ((LAS unsigned*)(lds + ML_CT))[i] = 0u;
    for (int n = w; n < SEQ / 64; n += NWAVES) {
        const size_t tk = (size_t)64 * n + lane;
        float bcs = -softplusf_(-(GT[tk * 16 + 4 + h] + fb));
#pragma unroll
        for (int o = 1; o < 64; o <<= 1) { const float t = shup(bcs, o, lane); if (lane >= o) bcs += t; }
        const float wl = (GT[tk * 16 + h] + ib) - bcs, bL = shidx(bcs, 63);
        ((LAS float*)(lds + ML_GB))[tk] = bcs; ((LAS float*)(lds + ML_GWL))[tk] = wl; ((LAS float*)(lds + ML_GEB))[tk] = __expf(bcs); ((LAS float*)(lds + ML_GWG))[tk] = __expf(bL + wl);
        if (lane == 0) ((LAS float*)(lds + ML_GG))[n] = __expf(bL);
    }
    const int srow = tid >> 3, c0 = (tid & 7) * 8;
    u32x4 qreg, kreg, vreg;
    { const bf16_t* rowp = U + (size_t)srow * NU + h * 64 + c0; qreg = *(const u32x4*)(rowp + U_MQ); kreg = *(const u32x4*)(rowp + U_MK); vreg = *(const u32x4*)(rowp + U_MV); }
    f32x16 cacc;
#pragma unroll
    for (int i = 0; i < 16; ++i) cacc[i] = 0.f;
    float n_d = 0.f;
    const int ti = w & 1, ei = (w >> 1) & 1;
    f32x16 hv; float rs_part = 0.f; u32x2 opre[4];
#pragma unroll
    for (int i = 0; i < 16; ++i) hv[i] = 0.f;
#pragma unroll
    for (int g = 0; g < 4; ++g) opre[g] = (u32x2){0u, 0u};
    const float* nw = P.in[7] + l * 256 + h * 64;
    __syncthreads();
    for (int n = 0; n <= SEQ / 64; ++n) {
        const int cb = n & 1;
        LAS unsigned char* sb = lds + cb * ML_STAGE;
        if (n < SEQ / 64) {
            const float wgt_row = ((const LAS float*)(lds + ML_GWG))[64 * n + srow];
            u32x4 ks; float kf[8];
#pragma unroll
            for (int x = 0; x < 4; ++x) { kf[2 * x] = __uint_as_float(kreg[x] << 16) * 0.125f; kf[2 * x + 1] = __uint_as_float(kreg[x] & 0xffff0000u) * 0.125f; ks[x] = (__float_as_uint(kf[2 * x]) >> 16) | (__float_as_uint(kf[2 * x + 1]) & 0xffff0000u); }
            *(LAS u32x4*)(sb + ML_K + (srow * ML_STR + c0) * 2) = ks;
            if ((n & 1) == par) *(LAS u32x4*)(sb + ML_Q + (srow * ML_STR + c0) * 2) = qreg;
            LAS bf16_t* vt = (LAS bf16_t*)(sb + ML_VT); LAS bf16_t* kwt = (LAS bf16_t*)(sb + ML_KWT);
#pragma unroll
            for (int x = 0; x < 4; ++x) { vt[(c0 + 2 * x) * ML_STR + srow] = (bf16_t)(vreg[x] & 0xffffu); vt[(c0 + 2 * x + 1) * ML_STR + srow] = (bf16_t)(vreg[x] >> 16);
                kwt[(c0 + 2 * x) * ML_STR + srow] = (bf16_t)f2bf(kf[2 * x] * wgt_row); kwt[(c0 + 2 * x + 1) * ML_STR + srow] = (bf16_t)f2bf(kf[2 * x + 1] * wgt_row); }
        }
        __syncthreads();
        if (n + 1 < SEQ / 64) { const bf16_t* rowp = U + (size_t)(64 * (n + 1) + srow) * NU + h * 64 + c0; qreg = *(const u32x4*)(rowp + U_MQ); kreg = *(const u32x4*)(rowp + U_MK); vreg = *(const u32x4*)(rowp + U_MV); }
        if (w < 4 && n > 0 && ((n - 1) & 1) == par) {
            const float tot = rs_part + ((const LAS float*)(lds + ML_SSQ))[(cb ^ 1) * 128 + (ti * 2 + (ei ^ 1)) * 32 + r];
            const float rs = rsqrtf(tot * (1.f / 64.f) + NORM_EPS);
            const size_t tok = (size_t)64 * (n - 1) + 32 * ti + r;
            bf16_t* yrow = WSP(bf16_t, WS_Y) + ((size_t)b * SEQ + tok) * D + h * 64;
#pragma unroll
            for (int g = 0; g < 4; ++g) { const int e0 = 32 * ei + 8 * g + 4 * hh; const f32x4 n4 = *(const f32x4*)(nw + e0); const u32x2 op = opre[g];
                const float o0 = sigmoidf_(__uint_as_float(op.x << 16)), o1 = sigmoidf_(__uint_as_float(op.x & 0xffff0000u)), o2 = sigmoidf_(__uint_as_float(op.y << 16)), o3 = sigmoidf_(__uint_as_float(op.y & 0xffff0000u));
                u32x2 y2; y2.x = cvt_pk_bf16(hv[4 * g] * rs * n4[0] * o0, hv[4 * g + 1] * rs * n4[1] * o1); y2.y = cvt_pk_bf16(hv[4 * g + 2] * rs * n4[2] * o2, hv[4 * g + 3] * rs * n4[3] * o3);
                *(u32x2*)(yrow + e0) = y2; }
        }
        if (n == SEQ / 64) break;
        if (w < 4) { if ((n & 1) == par) {
            { const size_t tokp = (size_t)64 * n + 32 * ti + r;
#pragma unroll
              for (int g = 0; g < 4; ++g) opre[g] = *(const u32x2*)(U + tokp * NU + U_MO + h * 64 + 32 * ei + 8 * g + 4 * hh); }
            const LAS float* gwl = (const LAS float*)(lds + ML_GWL) + 64 * n;
            const float bt = ((const LAS float*)(lds + ML_GB))[64 * n + 32 * ti + r], ebt = ((const LAS float*)(lds + ML_GEB))[64 * n + 32 * ti + r];
            bf16x8 qf[4];
#pragma unroll
            for (int kk = 0; kk < 4; ++kk) qf[kk] = *(const LAS bf16x8*)(sb + ML_Q + ((32 * ti + r) * ML_STR + 16 * kk + 8 * hh) * 2);
            f32x16 acc1, acc2;
#pragma unroll
            for (int i = 0; i < 16; ++i) { acc1[i] = 0.f; acc2[i] = 0.f; }
            float den = 0.f;
#pragma unroll
            for (int si = 0; si < 2; ++si) {
                if (si > ti) continue;
                f32x16 sacc;
#pragma unroll
                for (int i = 0; i < 16; ++i) sacc[i] = 0.f;
#pragma unroll
                for (int kk = 0; kk < 4; ++kk) { const bf16x8 kf = *(const LAS bf16x8*)(sb + ML_K + ((32 * si + r) * ML_STR + 16 * kk + 8 * hh) * 2); sacc = MFMA32(kf, qf[kk], sacc); }
                float pv[16];
#pragma unroll
                for (int g = 0; g < 4; ++g) { const f32x4 wl4 = *(const LAS f32x4*)(gwl + 32 * si + 8 * g + 4 * hh);
#pragma unroll
                    for (int x = 0; x < 4; ++x) { const int srow_i = 8 * g + 4 * hh + x; const bool keep = (si < ti) || (srow_i <= r);
                        const float pvv = keep ? sacc[4 * g + x] * __expf(bt + wl4[x]) : 0.f; pv[4 * g + x] = pvv; den += pvv; } }
#pragma unroll
                for (int s2 = 0; s2 < 2; ++s2) { u32x4 pk;
#pragma unroll
                    for (int x = 0; x < 4; ++x) pk[x] = cvt_pk_bf16(pv[8 * s2 + 2 * x], pv[8 * s2 + 2 * x + 1]);
                    const LAS bf16_t* vrow = (const LAS bf16_t*)(sb + ML_VT) + (32 * ei + r) * ML_STR + 32 * si + 16 * s2 + 4 * hh;
                    const u32x2 lo = *(const LAS u32x2*)vrow, hi = *(const LAS u32x2*)(vrow + 8);
                    u32x4 vv; vv.x = lo.x; vv.y = lo.y; vv.z = hi.x; vv.w = hi.y;
                    acc1 = MFMA32(__builtin_bit_cast(bf16x8, vv), __builtin_bit_cast(bf16x8, pk), acc1); }
            }
#pragma unroll
            for (int kk = 0; kk < 4; ++kk) { const bf16x8 cf = *(const LAS bf16x8*)(lds + ML_CT + cb * ML_MAT + ((32 * ei + r) * ML_STR + 16 * kk + 8 * hh) * 2); acc2 = MFMA32(cf, qf[kk], acc2); }
            float qn = 0.f;
            { const LAS float* nv = (const LAS float*)(lds + ML_N + cb * 256);
#pragma unroll
              for (int kk = 0; kk < 4; ++kk) { const u32x4 qq = *(const LAS u32x4*)(sb + ML_Q + ((32 * ti + r) * ML_STR + 32 * hh + 8 * kk) * 2);
                  const f32x4 n0 = *(const LAS f32x4*)(nv + 32 * hh + 8 * kk), n1 = *(const LAS f32x4*)(nv + 32 * hh + 8 * kk + 4);
                  qn += __uint_as_float(qq[0] << 16) * n0[0] + __uint_as_float(qq[0] & 0xffff0000u) * n0[1] + __uint_as_float(qq[1] << 16) * n0[2] + __uint_as_float(qq[1] & 0xffff0000u) * n0[3]
                      + __uint_as_float(qq[2] << 16) * n1[0] + __uint_as_float(qq[2] & 0xffff0000u) * n1[1] + __uint_as_float(qq[3] << 16) * n1[2] + __uint_as_float(qq[3] & 0xffff0000u) * n1[3]; } }
            den += ebt * qn;
            den += shx32(den, lane);
            const float dinv = __builtin_amdgcn_rcpf(fmaxf(fabsf(den), 1.0f));
            rs_part = 0.f;
#pragma unroll
            for (int i = 0; i < 16; ++i) { hv[i] = (acc1[i] + ebt * acc2[i]) * dinv; rs_part += hv[i] * hv[i]; }
            rs_part += shx32(rs_part, lane);
            if (hh == 0) ((LAS float*)(lds + ML_SSQ))[cb * 128 + (ti * 2 + ei) * 32 + r] = rs_part;
        } } else {
            const int di = w & 1; const float G = ((const LAS float*)(lds + ML_GG))[n];
#pragma unroll
            for (int i = 0; i < 16; ++i) cacc[i] *= G;
#pragma unroll
            for (int kk = 0; kk < 4; ++kk) { const bf16x8 vf = *(const LAS bf16x8*)(sb + ML_VT + ((32 * ei + r) * ML_STR + 16 * kk + 8 * hh) * 2);
                const bf16x8 kf = *(const LAS bf16x8*)(sb + ML_KWT + ((32 * di + r) * ML_STR + 16 * kk + 8 * hh) * 2); cacc = MFMA32(vf, kf, cacc); }
            LAS bf16_t* ct = (LAS bf16_t*)(lds + ML_CT + (cb ^ 1) * ML_MAT);
#pragma unroll
            for (int i = 0; i < 16; ++i) ct[(32 * ei + (i & 3) + 8 * (i >> 2) + 4 * hh) * ML_STR + 32 * di + r] = (bf16_t)f2bf(cacc[i]);
            if (w == 4) { float sum = 0.f;
#pragma unroll
                for (int kk = 0; kk < 8; ++kk) { const u32x4 kk4 = *(const LAS u32x4*)(sb + ML_KWT + (lane * ML_STR + 8 * kk) * 2);
#pragma unroll
                    for (int x = 0; x < 4; ++x) sum += __uint_as_float(kk4[x] << 16) + __uint_as_float(kk4[x] & 0xffff0000u); }
                n_d = G * n_d + sum; ((LAS float*)(lds + ML_N + (cb ^ 1) * 256))[lane] = n_d; }
        }
    }
    __syncthreads();
}
constexpr int GP_W = 0, GP_QD = 16384, GP_KDT = 32768, GP_QK = 49152, GP_U = 57344, GP_CD = 73728, GP_CHUNK = 74752;
constexpr size_t WS_GP = WS_GQ;
static_assert((size_t)1024 * GP_CHUNK <= 96 * MiB, "GDN prep buffer");
constexpr int PL_KSTR = 136, PL_KN = 0, PL_QN = 17408, PL_RHS = 34816, PL_RSTR = 260, PL_M = 101376, PL_MSTR = 72  , PL_QK = 118784, PL_QKSTR = 72, PL_WC = 128000, PL_GATE = 134144, PL_UWSTR = 264;
__device__ __forceinline__ unsigned bfmul2(unsigned pk, float a) { return cvt_pk_bf16(__uint_as_float(pk << 16) * a, __uint_as_float(pk & 0xffff0000u) * a); }
__device__ __forceinline__ void gdn_prep_unit(const Params& P, const Ctx& C, int l, int b, int h, int n) {
    LAS unsigned char* lds = C.lds;
    int tid_ = C.tid; asm volatile("" : "+v"(tid_));
    const int tid = tid_, w = __builtin_amdgcn_readfirstlane(tid >> 6), lane = tid & 63, r = lane & 31, hh = lane >> 5;
    const bf16_t* U = WSP(bf16_t, WS_U16) + (size_t)b * SEQ * NU; const float* GT = WSP(float, WS_GT) + (size_t)b * SEQ * 16;
    unsigned char* outp = P.ws + WS_GP + (size_t)((b * 4 + h) * 32 + n) * GP_CHUNK;
    const int t0 = 64 * n;
    { const float* cw = P.in[9] + (size_t)l * 4 * 1536; LAS float* wc = (LAS float*)(lds + PL_WC);
      for (int idx = tid; idx < 1536; idx += NTHREADS) { const int j = idx / 384, rem = idx - j * 384, p = rem >> 7, cc = rem & 127; wc[idx] = cw[j * 1536 + p * 512 + h * 128 + cc]; } }
    float beta_l, gam_l, gamL;
    { const float A = __expf(P.in[10][l * 4 + h]), dtb = P.in[11][l * 4 + h];
      const float ga = GT[(size_t)(t0 + lane) * 16 + 8 + h], gb = GT[(size_t)(t0 + lane) * 16 + 12 + h];
      float g = -A * softplusf_(ga + dtb);
#pragma unroll
      for (int o = 1; o < 64; o <<= 1) { const float t = shup(g, o, lane); if (lane >= o) g += t; }
      gam_l = g; beta_l = sigmoidf_(gb); gamL = shidx(g, 63);
      if (w == 0) { LAS float* gt = (LAS float*)(lds + PL_GATE); gt[lane] = gam_l; gt[64 + lane] = beta_l; gt[128 + lane] = __expf(gam_l); gt[192 + lane] = __expf(gamL - gam_l); } }
    __syncthreads();
    { const int t = tid >> 3, cg = tid & 7;
      const float beta_t = shidx(beta_l, t), gam_t = shidx(gam_l, t);
      float acc[3][16];
#pragma unroll
      for (int p = 0; p < 3; ++p)
#pragma unroll
          for (int c = 0; c < 16; ++c) acc[p][c] = 0.f;
      const LAS float* wc = (const LAS float*)(lds + PL_WC);
#pragma unroll
      for (int j = 0; j < 4; ++j) { const int ts = t0 + t - 3 + j;
          if (ts >= 0) {
#pragma unroll
              for (int p = 0; p < 3; ++p) { const bf16_t* src = U + (size_t)ts * NU + U_GQ + p * 512 + h * 128 + 16 * cg; const u32x4 x0 = *(const u32x4*)src, x1 = *(const u32x4*)(src + 8);
                  const LAS float* wp = wc + j * 384 + p * 128 + 16 * cg;
#pragma unroll
                  for (int c4 = 0; c4 < 4; ++c4) { const f32x4 w4 = *(const LAS f32x4*)(wp + 4 * c4); const unsigned xa = c4 < 2 ? x0[2 * c4] : x1[2 * c4 - 4], xb = c4 < 2 ? x0[2 * c4 + 1] : x1[2 * c4 - 3];
                      acc[p][4 * c4] += w4[0] * __uint_as_float(xa << 16); acc[p][4 * c4 + 1] += w4[1] * __uint_as_float(xa & 0xffff0000u);
                      acc[p][4 * c4 + 2] += w4[2] * __uint_as_float(xb << 16); acc[p][4 * c4 + 3] += w4[3] * __uint_as_float(xb & 0xffff0000u); } } } }
      float ssq = 0.f, ssk = 0.f;
#pragma unroll
      for (int c = 0; c < 16; ++c) { acc[0][c] = siluf_(acc[0][c]); acc[1][c] = siluf_(acc[1][c]); acc[2][c] = siluf_(acc[2][c]); ssq += acc[0][c] * acc[0][c]; ssk += acc[1][c] * acc[1][c]; }
      { const int ln = lane_id_opaque();
#pragma unroll
        for (int o = 1; o < 8; o <<= 1) { ssq += shx(ssq, o, ln); ssk += shx(ssk, o, ln); } }
      const float scq = rsqrtf(ssq + NORM_EPS) * 0.08838834764831845f, sck = rsqrtf(ssk + NORM_EPS), bw = beta_t * __expf(gam_t);
      u32x4 qa, qb, ka, kb;
#pragma unroll
      for (int x = 0; x < 4; ++x) { qa[x] = cvt_pk_bf16(acc[0][2 * x] * scq, acc[0][2 * x + 1] * scq); qb[x] = cvt_pk_bf16(acc[0][8 + 2 * x] * scq, acc[0][9 + 2 * x] * scq);
                                     ka[x] = cvt_pk_bf16(acc[1][2 * x] * sck, acc[1][2 * x + 1] * sck); kb[x] = cvt_pk_bf16(acc[1][8 + 2 * x] * sck, acc[1][9 + 2 * x] * sck); }
      *(LAS u32x4*)(lds + PL_QN + (t * PL_KSTR + 16 * cg) * 2) = qa; *(LAS u32x4*)(lds + PL_QN + (t * PL_KSTR + 16 * cg + 8) * 2) = qb;
      *(LAS u32x4*)(lds + PL_KN + (t * PL_KSTR + 16 * cg) * 2) = ka; *(LAS u32x4*)(lds + PL_KN + (t * PL_KSTR + 16 * cg + 8) * 2) = kb;
      LAS float* rhs = (LAS float*)(lds + PL_RHS) + t * PL_RSTR;
#pragma unroll
      for (int c4 = 0; c4 < 4; ++c4) { f32x4 rv, rk;
#pragma unroll
          for (int x = 0; x < 4; ++x) { rv[x] = beta_t * acc[2][4 * c4 + x]; rk[x] = bw * sck * acc[1][4 * c4 + x]; }
          *(LAS f32x4*)(rhs + 16 * cg + 4 * c4) = rv; *(LAS f32x4*)(rhs + 128 + 16 * cg + 4 * c4) = rk; } }
    __syncthreads();
    { const int p = w >> 2, ti = (w >> 1) & 1, si = w & 1;
      const LAS float* gt = (const LAS float*)(lds + PL_GATE);
      if (si <= ti) {
          f32x16 acc;
#pragma unroll
          for (int i = 0; i < 16; ++i) acc[i] = 0.f;
#pragma unroll
          for (int kk = 0; kk < 8; ++kk) { const bf16x8 af = *(const LAS bf16x8*)(lds + (p ? PL_QN : PL_KN) + ((32 * ti + r) * PL_KSTR + 16 * kk + 8 * hh) * 2);
              const bf16x8 bf = *(const LAS bf16x8*)(lds + PL_KN + ((32 * si + r) * PL_KSTR + 16 * kk + 8 * hh) * 2); acc = MFMA32(af, bf, acc); }
          const float gam_s = gt[32 * si + r];
#pragma unroll
          for (int g = 0; g < 4; ++g) { const f32x4 gt4 = *(const LAS f32x4*)(gt + 32 * ti + 8 * g + 4 * hh), bt4 = *(const LAS f32x4*)(gt + 64 + 32 * ti + 8 * g + 4 * hh);
#pragma unroll
              for (int x = 0; x < 4; ++x) { const int trow = 8 * g + 4 * hh + x; const float dec = __expf(fminf(gt4[x] - gam_s, 0.f)) * acc[4 * g + x];
                  if (p == 0) { const bool keep = (si < ti) || (r < trow); ((LAS _Float16*)(lds + PL_M))[(32 * ti + trow) * PL_MSTR + 32 * si + r] = (_Float16)(keep ? bt4[x] * dec : 0.f); }
                  else { const bool keep = (si < ti) || (r <= trow); ((LAS bf16_t*)(lds + PL_QK))[(32 * ti + trow) * PL_QKSTR + 32 * si + r] = (bf16_t)f2bf(keep ? dec : 0.f); } } }
      } else if (p == 1) {
#pragma unroll
          for (int i = 0; i < 16; ++i) ((LAS bf16_t*)(lds + PL_QK))[(32 * ti + (i & 3) + 8 * (i >> 2) + 4 * hh) * PL_QKSTR + 32 * si + r] = (bf16_t)0;
      } }
    __syncthreads();
    float xs[64];
    if (w < 4) {
        int vz = 0; asm volatile("" : "+v"(vz));
        typedef _Float16 f16x8 __attribute__((ext_vector_type(8)));
        const LAS float* rhs = (const LAS float*)(lds + PL_RHS) + tid; const LAS _Float16* Mh = (const LAS _Float16*)(lds + PL_M) + vz;
#pragma clang loop unroll(full)
        for (int t = 0; t < 64; ++t) { float a = rhs[t * PL_RSTR];
            const LAS _Float16* Mrow = Mh + t * PL_MSTR;
#pragma clang loop unroll(full)
            for (int s8 = 0; s8 < (t + 7) / 8; ++s8) { const f16x8 m8 = *(const LAS f16x8*)(Mrow + 8 * s8);
#pragma unroll
                for (int x = 0; x < 8; ++x) if (8 * s8 + x < t) a -= (float)m8[x] * xs[8 * s8 + x]; }
            xs[t] = a; }
    } else {
        const LAS float* gt = (const LAS float*)(lds + PL_GATE);
        for (int it = w - 4; it < 40; it += 4) {
            u32x4 o;
            if (it < 16) { const int ti = it >> 3, kk = it & 7; const u32x4 q = *(const LAS u32x4*)(lds + PL_QN + ((32 * ti + r) * PL_KSTR + 16 * kk + 8 * hh) * 2); const float eg = gt[128 + 32 * ti + r];
#pragma unroll
                for (int x = 0; x < 4; ++x) o[x] = bfmul2(q[x], eg);
                *(u32x4*)(outp + GP_QD + (size_t)((ti * 8 + kk) * 64 + lane) * 16) = o;
            } else if (it < 32) { const int dt = (it - 16) >> 2, ks = (it - 16) & 3; const LAS bf16_t* kn = (const LAS bf16_t*)(lds + PL_KN) + 32 * dt + r;
#pragma unroll
                for (int x = 0; x < 4; ++x) { const int ta = 16 * ks + 8 * ((2 * x) >> 2) + 4 * hh + ((2 * x) & 3), tb = ta + 1;
                    o[x] = cvt_pk_bf16(bf2f(kn[ta * PL_KSTR]) * gt[192 + ta], bf2f(kn[tb * PL_KSTR]) * gt[192 + tb]); }
                *(u32x4*)(outp + GP_KDT + (size_t)((dt * 4 + ks) * 64 + lane) * 16) = o;
            } else { const int ti = (it - 32) >> 2, ks = (it - 32) & 3; const LAS bf16_t* qrow = (const LAS bf16_t*)(lds + PL_QK) + (32 * ti + r) * PL_QKSTR + 16 * ks + 4 * hh;
                const u32x2 lo = *(const LAS u32x2*)qrow, hi = *(const LAS u32x2*)(qrow + 8); o.x = lo.x; o.y = lo.y; o.z = hi.x; o.w = hi.y;
                *(u32x4*)(outp + GP_QK + (size_t)((ti * 4 + ks) * 64 + lane) * 16) = o; }
        }
    }
    __syncthreads();
    if (w < 4) { LAS bf16_t* uw = (LAS bf16_t*)(lds + PL_RHS) + tid;
#pragma unroll
        for (int t = 0; t < 64; ++t) uw[t * PL_UWSTR] = (bf16_t)f2bf(xs[t]); }
    __syncthreads();
    { const LAS bf16_t* uw = (const LAS bf16_t*)(lds + PL_RHS);
      for (int it = w; it < 24; it += 8) {
          if (it < 16) { const int ti = it >> 3, kk = it & 7; const u32x4 o = *(const LAS u32x4*)(uw + (32 * ti + r) * PL_UWSTR + 128 + 16 * kk + 8 * hh);
              *(u32x4*)(outp + GP_W + (size_t)((ti * 8 + kk) * 64 + lane) * 16) = o;
          } else { const int ti = (it - 16) >> 2, es = (it - 16) & 3; u32x4 o0, o1;
#pragma unroll
              for (int x = 0; x < 8; ++x) { const int ia = 2 * x, ib = 2 * x + 1; const int ta = 32 * ti + (ia & 3) + 8 * (ia >> 2) + 4 * hh, tb = 32 * ti + (ib & 3) + 8 * (ib >> 2) + 4 * hh;
                  const unsigned v = (unsigned)uw[ta * PL_UWSTR + 32 * es + r] | ((unsigned)uw[tb * PL_UWSTR + 32 * es + r] << 16); if (x < 4) o0[x] = v; else o1[x - 4] = v; }
              unsigned char* dst = outp + GP_U + (size_t)((ti * 4 + es) * 64 + lane) * 32; *(u32x4*)dst = o0; *(u32x4*)(dst + 16) = o1; }
      }
      if (tid == 0) *(float*)(outp + GP_CD) = __expf(gamL); }
    __syncthreads();
}
__device__ __forceinline__ void phase_gprep2(const Params& P, const Ctx& C, int l) {
    { int* slot_tok = (int*)(P.ws + WS_RT + RT_SLOTTOK); for (int i = C.bid * NTHREADS + C.tid; i < PSLOTS; i += C.G * NTHREADS) slot_tok[i] = -1; }
    for (int u = C.bid; u < 1024; u += C.G) gdn_prep_unit(P, C, l, u >> 7, (u >> 5) & 3, u & 31);
}
constexpr int GS_SLOT = 61440, GS_ST = 2 * GS_SLOT, GS_STSTR = 136, GS_STBYTES = 32 * GS_STSTR * 2;
__device__ __forceinline__ void gdn_scan_unit(const Params& P, const Ctx& C, int l, int b, int h, int es) {
    LAS unsigned char* lds = C.lds;
    const int tid = C.tid, w = C.wave, lane = C.lane, r = lane & 31, hh = lane >> 5;
    const unsigned char* gp = P.ws + WS_GP + (size_t)((b * 4 + h) * 32) * GP_CHUNK;
    float* O = WSP(float, WS_GO) + (size_t)b * SEQ * 512 + h * 128 + 32 * es;
    for (int i = tid; i < 2 * GS_STBYTES / 4; i += NTHREADS) ((LAS unsigned*)(lds + GS_ST))[i] = 0u;
#define GS_ISSUE(nn) do { const unsigned char* src = gp + (size_t)(nn) * GP_CHUNK; LAS unsigned char* dst = lds + ((nn) & 1) * GS_SLOT; \
        for (int p = w; p < 60; p += 8) { const size_t go = p < 56 ? (size_t)p * 1024 : (size_t)GP_U + (size_t)(((p - 56) >> 1) * 4 + es) * 2048 + (size_t)((p - 56) & 1) * 1024; \
            __builtin_amdgcn_global_load_lds((const unsigned*)(src + go + lane * 16), (LAS unsigned*)(dst + p * 1024), 16, 0, 0); } } while (0)
    GS_ISSUE(0);
    float cd_next = *(const float*)(gp + GP_CD);
    f32x16 sacc;
#pragma unroll
    for (int i = 0; i < 16; ++i) sacc[i] = 0.f;
    asm volatile("s_waitcnt vmcnt(0)" ::: "memory");
    __syncthreads();
    for (int n = 0; n < 32; ++n) {
        const float cd = cd_next;
        if (n + 1 < 32) { GS_ISSUE(n + 1); cd_next = *(const float*)(gp + (size_t)(n + 1) * GP_CHUNK + GP_CD); }
        const LAS unsigned char* slot = lds + (n & 1) * GS_SLOT;
        const LAS unsigned char* stc = lds + GS_ST + (n & 1) * GS_STBYTES;
        if (w < 6) {
            f32x16 xa[2];
#pragma unroll
            for (int i = 0; i < 16; ++i) { xa[0][i] = 0.f; xa[1][i] = 0.f; }
            bf16x8 sf[8];
#pragma unroll
            for (int kk = 0; kk < 8; ++kk) sf[kk] = *(const LAS bf16x8*)(stc + (r * GS_STSTR + 16 * kk + 8 * hh) * 2);
#pragma unroll
            for (int ti = 0; ti < 2; ++ti)
#pragma unroll
                for (int kk = 0; kk < 8; ++kk) { const bf16x8 wf = *(const LAS bf16x8*)(slot + GP_W + ((ti * 8 + kk) * 64 + lane) * 16); xa[ti] = MFMA32(wf, sf[kk], xa[ti]); }
            bf16x8 pf[2][2];
#pragma unroll
            for (int ti = 0; ti < 2; ++ti) { const u32x4 u0 = *(const LAS u32x4*)(slot + GP_U + ti * 2048 + lane * 32), u1 = *(const LAS u32x4*)(slot + GP_U + ti * 2048 + lane * 32 + 16);
#pragma unroll
                for (int s2 = 0; s2 < 2; ++s2) { const u32x4 uu = s2 ? u1 : u0; u32x4 pk;
#pragma unroll
                    for (int x = 0; x < 4; ++x) pk[x] = cvt_pk_bf16(__uint_as_float(uu[x] << 16) - xa[ti][8 * s2 + 2 * x], __uint_as_float(uu[x] & 0xffff0000u) - xa[ti][8 * s2 + 2 * x + 1]);
                    pf[ti][s2] = __builtin_bit_cast(bf16x8, pk); } }
            if (w < 4) {
#pragma unroll
                for (int i = 0; i < 16; ++i) sacc[i] *= cd;
#pragma unroll
                for (int ks = 0; ks < 4; ++ks) { const bf16x8 kf = *(const LAS bf16x8*)(slot + GP_KDT + ((w * 4 + ks) * 64 + lane) * 16); sacc = MFMA32(kf, pf[ks >> 1][ks & 1], sacc); }
                LAS unsigned char* stn = lds + GS_ST + ((n + 1) & 1) * GS_STBYTES;
#pragma unroll
                for (int g = 0; g < 4; ++g) { u32x2 o2; o2.x = cvt_pk_bf16(sacc[4 * g], sacc[4 * g + 1]); o2.y = cvt_pk_bf16(sacc[4 * g + 2], sacc[4 * g + 3]);
                    *(LAS u32x2*)(stn + (r * GS_STSTR + 32 * w + 8 * g + 4 * hh) * 2) = o2; }
            } else {
                const int ti = w - 4;
                f32x16 oa;
#pragma unroll
                for (int i = 0; i < 16; ++i) oa[i] = 0.f;
#pragma unroll
                for (int kk = 0; kk < 8; ++kk) { const bf16x8 qf = *(const LAS bf16x8*)(slot + GP_QD + ((ti * 8 + kk) * 64 + lane) * 16); oa = MFMA32(qf, sf[kk], oa); }
#pragma unroll
                for (int ks = 0; ks < 4; ++ks) { if ((ks >> 1) > ti) continue; const bf16x8 qf = *(const LAS bf16x8*)(slot + GP_QK + ((ti * 4 + ks) * 64 + lane) * 16); oa = MFMA32(qf, pf[ks >> 1][ks & 1], oa); }
                float* orow = O + (size_t)(64 * n + 32 * ti) * 512 + r;
#pragma unroll
                for (int i = 0; i < 16; ++i) orow[(size_t)((i & 3) + 8 * (i >> 2) + 4 * hh) * 512] = oa[i];
            }
        }
        asm volatile("s_waitcnt vmcnt(0)" ::: "memory");
        __syncthreads();
    }
#undef GS_ISSUE
}
__device__ __forceinline__ void phase_mix(const Params& P, const Ctx& C, int l, int rep) {
#ifndef MIX_SEL
#define MIX_SEL 7
#endif
    const int sel = rep ? MIX_SEL : 7;
    if (C.bid < 128) { if (sel & 1) { const int j = C.bid >> 3, bh = (j >> 2) * 8 + (C.bid & 7); gdn_scan_unit(P, C, l, bh >> 2, bh & 3, j & 3); } }
    else if (C.bid < 192) { if (sel & 2) { const int q = C.bid - 128, j = q >> 3, bh = (j >> 1) * 8 + (q & 7); mlstm_unit(P, C, l, bh >> 2, bh & 3, j & 1); } }
    if (!(sel & 4)) return;
    LAS int* qslot = (LAS int*)(C.lds + LDS_MISC + 32);
    for (;;) {
        if (C.tid == 0) *qslot = (int)atomicAdd(ctl_words(P) + CW_SBQ + (l + 4 * rep) * 64, 1u);
        __syncthreads();
        const int u = *qslot;
        __syncthreads();
        if (u >= 256) break;
        sb_unit(P, C, l, (u & 31) >> 2, u & 3, 7 - (u >> 5));
    }
}
__device__ __forceinline__ void phase_gpost(const Params& P, const Ctx& C, int l) {
    const float* O = WSP(float, WS_GO); const bf16_t* U = WSP(bf16_t, WS_U16); bf16_t* Y = WSP(bf16_t, WS_Y); const float* nw = P.in[12] + l * 128 + (C.lane & 15) * 8;
    const int gw = C.bid * NWAVES + C.wave, NGW = C.G * NWAVES, lane = C.lane;
    const f32x4 n0 = *(const f32x4*)nw, n1 = *(const f32x4*)(nw + 4);
    for (int tok0 = gw; tok0 < T; tok0 += 4 * NGW) {
        f32x4 a[4], b[4]; u32x4 z[4];
#pragma unroll
        for (int k = 0; k < 4; ++k) { const int tok = tok0 + k * NGW; if (tok < T) { a[k] = *(const f32x4*)(O + (size_t)tok * 512 + lane * 8); b[k] = *(const f32x4*)(O + (size_t)tok * 512 + lane * 8 + 4); z[k] = *(const u32x4*)(U + (size_t)tok * NU + U_GZ + lane * 8); } }
#pragma unroll
        for (int k = 0; k < 4; ++k) { const int tok = tok0 + k * NGW; if (tok < T) {
            float ss = (a[k][0] * a[k][0] + a[k][1] * a[k][1]) + (a[k][2] * a[k][2] + a[k][3] * a[k][3]) + (b[k][0] * b[k][0] + b[k][1] * b[k][1]) + (b[k][2] * b[k][2] + b[k][3] * b[k][3]);
            { const int ln = lane_id_opaque();
#pragma unroll
              for (int o = 1; o < 16; o <<= 1) ss += shx(ss, o, ln); }
            const float sc = rsqrtf(ss * (1.f / 128.f) + NORM_EPS);
            u32x4 o;
            o.x = cvt_pk_bf16(a[k][0] * sc * n0[0] * siluf_(__uint_as_float(z[k].x << 16)), a[k][1] * sc * n0[1] * siluf_(__uint_as_float(z[k].x & 0xffff0000u)));
            o.y = cvt_pk_bf16(a[k][2] * sc * n0[2] * siluf_(__uint_as_float(z[k].y << 16)), a[k][3] * sc * n0[3] * siluf_(__uint_as_float(z[k].y & 0xffff0000u)));
            o.z = cvt_pk_bf16(b[k][0] * sc * n1[0] * siluf_(__uint_as_float(z[k].z << 16)), b[k][1] * sc * n1[1] * siluf_(__uint_as_float(z[k].z & 0xffff0000u)));
            o.w = cvt_pk_bf16(b[k][2] * sc * n1[2] * siluf_(__uint_as_float(z[k].w << 16)), b[k][3] * sc * n1[3] * siluf_(__uint_as_float(z[k].w & 0xffff0000u)));
            *(u32x4*)(Y + (size_t)tok * D + 512 + lane * 8) = o; } }
    }
}
__device__ __forceinline__ void phase_outproj(const Params& P, const Ctx& C, int l) {
    DenseOrder S; S.init(T, D, D, P.ws + WS_W + (size_t)l * W_LAYER + W_OUT, C.G, C.bid);
    EpiB16<0> E{WSP(bf16_t, WS_TMP), D, nullptr};
    gemm_phase(C.lds, C.tid, (const char*)(P.ws + WS_Y), D, S, E);
}
__device__ __forceinline__ void phase_ln1(const Params& P, const Ctx& C, int l, int rep) {
    const int gw = C.bid * NWAVES + C.wave, NGW = C.G * NWAVES, lane = C.lane;
    const bf16_t* HB = WSP(bf16_t, WS_HB); const bf16_t* TMP = WSP(bf16_t, WS_TMP);
    const float* wr = P.in[16] + (size_t)l * D * NE; const float* br = P.in[17] + l * NE;
    const float* g = P.in[14] + l * D; const float* bb = P.in[15] + l * D;
    int* top_idx = (int*)(P.ws + WS_RT + RT_TOPIDX); float* top_gate = (float*)(P.ws + WS_RT + RT_TOPGATE);
    LAS float* xs = (LAS float*)(C.lds + C.wave * 16384);
    const int e_me = lane & 31, half = lane >> 5;
    LAS unsigned* hist = (LAS unsigned*)(C.lds + LDS_TAB);
    if (C.tid < NE) hist[C.tid] = 0u;
    __syncthreads();
    for (int gi = gw; gi < T / 4; gi += NGW) {
        u32x2 hbr[4][4], tbr[4][4];
#pragma unroll
        for (int rr = 0; rr < 4; ++rr)
#pragma unroll
            for (int j = 0; j < 4; ++j) { hbr[rr][j] = *(const u32x2*)(HB + (size_t)(4 * gi + rr) * D + 4 * lane + 256 * j); tbr[rr][j] = *(const u32x2*)(TMP + (size_t)(4 * gi + rr) * D + 4 * lane + 256 * j); }
#pragma unroll
        for (int rr = 0; rr < 4; ++rr) {
            const int row = 4 * gi + rr;
            float v[16]; float s = 0.f;
#pragma unroll
            for (int j = 0; j < 4; ++j) { const u32x2 hb = hbr[rr][j]; const u32x2 tb = tbr[rr][j]; const float t[4] = {__uint_as_float(tb.x << 16), __uint_as_float(tb.x & 0xffff0000u), __uint_as_float(tb.y << 16), __uint_as_float(tb.y & 0xffff0000u)};
                const float a[4] = {__uint_as_float(hb.x << 16), __uint_as_float(hb.x & 0xffff0000u), __uint_as_float(hb.y << 16), __uint_as_float(hb.y & 0xffff0000u)};
#pragma unroll
                for (int x = 0; x < 4; ++x) { v[4 * j + x] = ALPHA * a[x] + t[x]; s += v[4 * j + x]; } }
            const float mean = wave_sum(s) * (1.f / D); float q = 0.f;
#pragma unroll
            for (int i = 0; i < 16; ++i) { v[i] -= mean; q += v[i] * v[i]; }
            const float rstd = rsqrtf(wave_sum(q) * (1.f / D) + LN_EPS);
#pragma unroll
            for (int j = 0; j < 4; ++j) { const int c = 4 * lane + 256 * j; const f32x4 gg = *(const f32x4*)(g + c), b4 = *(const f32x4*)(bb + c);
                f32x4 o;
#pragma unroll
                for (int x = 0; x < 4; ++x) o[x] = v[4 * j + x] * rstd * gg[x] + b4[x];
                u32x2 w; w.x = pk2(o[0], o[1]); w.y = pk2(o[2], o[3]); *(u32x2*)(WSP(bf16_t, WS_H1B) + (size_t)row * D + c) = w;
                *(LAS f32x4*)(xs + rr * 1024 + c) = o; }
        }
        float acc[4] = {0.f, 0.f, 0.f, 0.f};
        { const float* wp = wr + (size_t)(half * 512) * NE + e_me; const LAS float* xp = xs + half * 512;
#pragma unroll 8
          for (int k = 0; k < 512; k += 4) { const float w0 = wp[(size_t)k * NE], w1 = wp[(size_t)(k + 1) * NE], w2 = wp[(size_t)(k + 2) * NE], w3 = wp[(size_t)(k + 3) * NE];
#pragma unroll
              for (int rr = 0; rr < 4; ++rr) { const f32x4 x4 = *(const LAS f32x4*)(xp + rr * 1024 + k); acc[rr] += (x4[0] * w0 + x4[1] * w1) + (x4[2] * w2 + x4[3] * w3); } } }
        const float bias = br[e_me];
#pragma unroll
        for (int rr = 0; rr < 4; ++rr) {
            const int row = 4 * gi + rr;
            float logit = acc[rr] + shx(acc[rr], 32, lane) + bias;
            float vals[4]; int ids[4];
#pragma unroll
            for (int r = 0; r < 4; ++r) {
                float bv = logit; int bi = e_me;
#pragma unroll
                for (int o = 16; o >= 1; o >>= 1) { const float ov = shx(bv, o, lane); const int oi = shxi(bi, o, lane); if (ov > bv || (ov == bv && oi < bi)) { bv = ov; bi = oi; } }
                vals[r] = bv; ids[r] = bi; if (e_me == bi) logit = -INFINITY;
            }
            float ex[4], se = 0.f;
#pragma unroll
            for (int r = 0; r < 4; ++r) { ex[r] = __expf(vals[r] - vals[0]); se += ex[r]; }
            if (lane == 0) {
#pragma unroll
                for (int r = 0; r < 4; ++r) { top_idx[row * 4 + r] = ids[r]; top_gate[row * 4 + r] = ex[r] * __builtin_amdgcn_rcpf(se); __hip_atomic_fetch_add(&hist[ids[r]], 1u, __ATOMIC_RELAXED, __HIP_MEMORY_SCOPE_WORKGROUP); }
            }
        }
    }
    __syncthreads();
    if (C.tid < NE) ((unsigned*)(P.ws + WS_RT + RT_WGCNT))[(size_t)rep * 256 * NE + C.bid * NE + C.tid] = hist[C.tid];
}
__device__ __forceinline__ void phase_scatter(const Params& P, const Ctx& C, int l, int rep) {
    LAS int* pad_start = (LAS int*)(C.lds + LDS_TAB);
    LAS unsigned* cur = (LAS unsigned*)(C.lds + LDS_TAB + 256);
    LAS unsigned* ptot = (LAS unsigned*)(C.lds + LDS_TAB + 512);
    LAS unsigned* ppre = (LAS unsigned*)(C.lds + LDS_TAB + 512 + 2048);
    const unsigned* wgcnt = (const unsigned*)(P.ws + WS_RT + RT_WGCNT);
    { const int e = C.tid & 31, part = C.tid >> 5; unsigned st = 0, sp = 0;
      unsigned cv[16];
#pragma unroll
      for (int i = 0; i < 16; ++i) { const int wb = part * 16 + i; cv[i] = wb < C.G ? wgcnt[wb * NE + e] : 0u; }
#pragma unroll
      for (int i = 0; i < 16; ++i) { const int wb = part * 16 + i; st += cv[i]; if (wb < C.bid) sp += cv[i]; }
      ptot[part * 32 + e] = st; ppre[part * 32 + e] = sp; }
    __syncthreads();
    if (C.tid < NE) { unsigned st = 0, sp = 0; for (int p = 0; p < 16; ++p) { st += ptot[p * 32 + C.tid]; sp += ppre[p * 32 + C.tid]; } ptot[C.tid] = st; ppre[C.tid] = sp; }
    __syncthreads();
    if (C.tid == 0) { int acc = 0; for (int e = 0; e < NE; ++e) { pad_start[e] = acc; cur[e] = (unsigned)acc + ppre[e]; acc += ((int)ptot[e] + MOEB - 1) / MOEB * MOEB; } pad_start[NE] = acc; }
    __syncthreads();
    const int* top_idx = (const int*)(P.ws + WS_RT + RT_TOPIDX); const float* top_gate = (const float*)(P.ws + WS_RT + RT_TOPGATE);
    int* tok_slot = (int*)(P.ws + WS_RT + RT_TOKSLOT); int* slot_tok = (int*)(P.ws + WS_RT + RT_SLOTTOK); float* slot_gate = (float*)(P.ws + WS_RT + RT_SLOTGATE);
    { const int gw = C.bid * NWAVES + C.wave, NGW = C.G * NWAVES;
      for (int gi = gw; gi < T / 4; gi += NGW) if (C.lane < 16) { const int a = 16 * gi + C.lane;
          const int e = top_idx[a]; const int slot = (int)__hip_atomic_fetch_add(&cur[e], 1u, __ATOMIC_RELAXED, __HIP_MEMORY_SCOPE_WORKGROUP);
          slot_tok[slot] = a >> 2; slot_gate[slot] = top_gate[a]; tok_slot[a] = slot; } }
    if (C.bid == 0) { int* block_e = (int*)(P.ws + WS_RT + RT_BLOCKE);
        for (int nb = C.tid; nb < NBLK; nb += NTHREADS) { int c = 0; for (int e = 0; e < NE; ++e) c += (pad_start[e + 1] <= nb * MOEB) ? 1 : 0; block_e[nb] = c < NE - 1 ? c : NE - 1; }
        if (C.tid == 0) block_e[NBLK] = pad_start[NE] / MOEB; }
    __syncthreads();
    DenseOrder S; S.init(T, D, 256, P.ws + WS_W + (size_t)l * W_LAYER + W_PP, C.G, C.bid);
    EpiB16<0> E{WSP(bf16_t, WS_PLE), D, nullptr};
    gemm_phase(C.lds, C.tid, (const char*)(P.ws + WS_PB + (size_t)l * T * 256 * 2), 256, S, E);
}
template <bool GATHER> __device__ __forceinline__ void moe_order_init(MoeOrder<GATHER>& S, const Params& P, const Ctx& C, int nN, int K, const void* Wt, size_t estride, bool mirror = false) {
    const int* block_e = (const int*)(P.ws + WS_RT + RT_BLOCKE); const int* slot_tok = (const int*)(P.ws + WS_RT + RT_SLOTTOK);
    LAS int* tab = (LAS int*)(C.lds + LDS_TAB); LAS int* ue = (LAS int*)(C.lds + LDS_UE);
    const int nblk = block_e[NBLK];
    S.nN = nN; S.nunits = nblk * nN; S.G = C.G; S.cm = (C.G % 8 == 0) ? (C.bid % 8) * (C.G / 8) + C.bid / 8 : C.bid; if (mirror) S.cm = C.G - 1 - S.cm; S.K = K; S.Wt = (const char*)Wt; S.estride = estride; S.tab = tab; S.ue = ue;
    { int ev[12], tk[12];
#pragma unroll
      for (int i = 0; i < 12; ++i) { const int L = i * S.G + S.cm; const bool ok = L < S.nunits; const int rb = ok ? L / nN : 0;
          ev[i] = (ok && C.tid < 64) ? block_e[rb] : 0; tk[i] = (GATHER && ok && C.tid < 256) ? slot_tok[rb * 256 + C.tid] : 0; }
#pragma unroll
      for (int i = 0; i < 12; ++i) { if (C.tid == 0) ue[i] = ev[i]; if (GATHER && C.tid < 256) tab[i * 256 + C.tid] = tk[i] < 0 ? 0 : tk[i]; } }
    __syncthreads();
}
__device__ __forceinline__ void phase_moe1(const Params& P, const Ctx& C, int l) {
    { DenseOrder S; S.init(T, D, D, P.ws + WS_W + (size_t)l * W_LAYER + W_PG, C.G, C.bid);
      EpiB16<1> E{WSP(bf16_t, WS_TMP), D, WSP(bf16_t, WS_PLE)};
      gemm_phase(C.lds, C.tid, (const char*)(P.ws + WS_H1B), D, S, E); }
    unsigned* ready = ctl_words(P) + CW_MOEC + l * NBLK * 16;
    { MoeOrder<true> S; moe_order_init<true>(S, P, C, 8, D, P.ws + WS_W + (size_t)l * W_LAYER + W_GU, (size_t)2048 * D * 2); S.ready = ready;
      EpiMoe1 E{P, l + 1, C.G, S.nunits, WSP(bf16_t, WS_HM), P.in[19] + (size_t)l * NE * 2048, ready};
      gemm_phase(C.lds, C.tid, (const char*)(P.ws + WS_H1B), D, S, E); }
    { MoeOrder<false> S; moe_order_init<false>(S, P, C, 4, DFF, P.ws + WS_W + (size_t)l * W_LAYER + W_DN, (size_t)D * DFF * 2, true); S.ready = ready;
      EpiMoe2 E{WSP(bf16_t, WS_YB), P.in[21] + (size_t)l * NE * D, (const float*)(P.ws + WS_RT + RT_SLOTGATE)};
      gemm_phase(C.lds, C.tid, (const char*)(P.ws + WS_HM), DFF, S, E); }
}
__device__ __forceinline__ void phase_moe2(const Params& P, const Ctx& C, int l) {}
__device__ __forceinline__ void phase_ln2(const Params& P, const Ctx& C, int l) {
    const int gw = C.bid * NWAVES + C.wave, NGW = C.G * NWAVES, lane = C.lane;
    const bf16_t* H1B = WSP(bf16_t, WS_H1B); const bf16_t* PLE = WSP(bf16_t, WS_TMP); const bf16_t* Yb = WSP(bf16_t, WS_YB); const int* tok_slot = (const int*)(P.ws + WS_RT + RT_TOKSLOT);
    for (int row0 = gw; row0 < T; row0 += 2 * NGW) {
        int sl[2][4];
#pragma unroll
        for (int k = 0; k < 2; ++k) { const int row = row0 + k * NGW < T ? row0 + k * NGW : row0;
#pragma unroll
            for (int r = 0; r < 4; ++r) sl[k][r] = tok_slot[row * 4 + r]; }
        float v[2][16]; float s[2] = {0.f, 0.f};
#pragma unroll
        for (int k = 0; k < 2; ++k) { const int row = row0 + k * NGW < T ? row0 + k * NGW : row0;
#pragma unroll
            for (int j = 0; j < 4; ++j) { const int c = 4 * lane + 256 * j; const u32x2 hb = *(const u32x2*)(H1B + (size_t)row * D + c); const u32x2 plb = *(const u32x2*)(PLE + (size_t)row * D + c);
                float f[4] = {__uint_as_float(plb.x << 16), __uint_as_float(plb.x & 0xffff0000u), __uint_as_float(plb.y << 16), __uint_as_float(plb.y & 0xffff0000u)};
#pragma unroll
                for (int r = 0; r < 4; ++r) { const u32x2 y = *(const u32x2*)(Yb + (size_t)sl[k][r] * D + c); f[0] += __uint_as_float(y.x << 16); f[1] += __uint_as_float(y.x & 0xffff0000u); f[2] += __uint_as_float(y.y << 16); f[3] += __uint_as_float(y.y & 0xffff0000u); }
                v[k][4 * j] = ALPHA * __uint_as_float(hb.x << 16) + f[0]; v[k][4 * j + 1] = ALPHA * __uint_as_float(hb.x & 0xffff0000u) + f[1];
                v[k][4 * j + 2] = ALPHA * __uint_as_float(hb.y << 16) + f[2]; v[k][4 * j + 3] = ALPHA * __uint_as_float(hb.y & 0xffff0000u) + f[3];
                s[k] += (v[k][4 * j] + v[k][4 * j + 1]) + (v[k][4 * j + 2] + v[k][4 * j + 3]); } }
#pragma unroll
        for (int k = 0; k < 2; ++k) { const int row = row0 + k * NGW; if (row < T) {
            const float mean = wave_sum(s[k]) * (1.f / D); float q = 0.f;
#pragma unroll
            for (int i = 0; i < 16; ++i) { v[k][i] -= mean; q += v[k][i] * v[k][i]; }
            const float rstd = rsqrtf(wave_sum(q) * (1.f / D) + LN_EPS);
            float* of = (l == DEPTH - 1) ? P.out + (size_t)row * D : nullptr;
            ln_store_row(v[k], rstd, P.in[24] + l * D, P.in[25] + l * D, of, (l == DEPTH - 1) ? nullptr : WSP(bf16_t, WS_HB) + (size_t)row * D, lane); } }
    }
}

enum { PH_PRO = 0, PH_INPROJ, PH_GPREP, PH_MIX, PH_GPOST, PH_OUTPROJ, PH_LN1, PH_SCAT, PH_MOE1, PH_MOE2, PH_LN2 };
__device__ __forceinline__ Ctx make_ctx(unsigned char* lds) {
    Ctx C; C.lds = (LAS unsigned char*)lds; C.tid = threadIdx.x; C.lane = C.tid & 63; C.wave = __builtin_amdgcn_readfirstlane(C.tid >> 6); C.G = gridDim.x; C.bid = blockIdx.x; return C;
}
template <int PH> __device__ __forceinline__ void run_phase(const Params& P, const Ctx& C, int l, int rep = 0) {
    if (PH == PH_PRO) phase_prologue(P, C);
    if (PH == PH_INPROJ) phase_inproj(P, C, l);
    if (PH == PH_GPREP) phase_gprep2(P, C, l);
    if (PH == PH_MIX) phase_mix(P, C, l, rep);
    if (PH == PH_GPOST) phase_gpost(P, C, l);
    if (PH == PH_OUTPROJ) phase_outproj(P, C, l);
    if (PH == PH_LN1) phase_ln1(P, C, l, rep);
    if (PH == PH_SCAT) phase_scatter(P, C, l, rep);
    if (PH == PH_MOE1) phase_moe1(P, C, l);
    if (PH == PH_MOE2) phase_moe2(P, C, l);
    if (PH == PH_LN2) phase_ln2(P, C, l);
}
#if MK_MULTI
template <int PH> __global__ void __launch_bounds__(NTHREADS, 2) kphase(Params P, int l) {
    extern __shared__ __attribute__((aligned(16))) unsigned char lds[];
    const Ctx C = make_ctx(lds);
    run_phase<PH>(P, C, l);
}
#else
__device__ __forceinline__ Params load_params() {
    Params r{};
#if defined(__HIP_DEVICE_COMPILE__)
    const __attribute__((address_space(4))) unsigned long long* p = (const __attribute__((address_space(4))) unsigned long long*)__builtin_amdgcn_kernarg_segment_ptr();
    asm volatile("" : "+s"(p));
#pragma unroll
    for (int i = 0; i < 26; ++i) r.in[i] = (const float*)(const __attribute__((address_space(1))) float*)p[i];
    r.out = (float*)(__attribute__((address_space(1))) float*)p[26]; r.ws = (unsigned char*)(__attribute__((address_space(1))) unsigned char*)p[27];
#endif
    return r;
}
__device__ __forceinline__ Ctx make_ctx_opaque(unsigned char* lds) {
    int t = threadIdx.x, b = blockIdx.x, g = gridDim.x; asm volatile("" : "+v"(t)); asm volatile("" : "+s"(b), "+s"(g));
    LAS unsigned char* lp = (LAS unsigned char*)lds; asm volatile("" : "+s"(lp));
    Ctx C; C.lds = lp; C.tid = t; C.lane = t & 63; C.wave = __builtin_amdgcn_readfirstlane(t >> 6); C.G = g; C.bid = b; return C;
}
#define GRID_BAR() do { XcdBarrier b2 = bar; asm volatile("" : "+s"(b2.bar), "+s"(b2.x)); xcd_barrier(b2); } while (0)
#ifndef PROBE_MASK
#define PROBE_MASK 0
#endif
#define PHASE1(PH, l, rep) do { asm volatile("; PHASE_BEGIN " #PH); const Params Pl = load_params(); const Ctx Cl = make_ctx_opaque(lds); run_phase<PH>(Pl, Cl, (l), (rep)); asm volatile("; PHASE_END " #PH); } while (0)
#define PHASE(PH, l) do { PHASE1(PH, l, 0); if ((PROBE_MASK >> PH) & 1) { GRID_BAR(); PHASE1(PH, l, 1); } } while (0)
__global__ void __launch_bounds__(NTHREADS, 2) mega(Params Pk) {
    extern __shared__ __attribute__((aligned(16))) unsigned char lds[];
    const Ctx C = make_ctx(lds);
    if (C.tid < 4) ((LAS unsigned*)(C.lds + LDS_MISC))[C.tid] = 0u;
    __syncthreads();
    XcdBarrier bar;
    { const Params Pl = load_params(); bar = xcd_barrier_post(ctl_words(Pl) + CW_BAR, (volatile LAS unsigned*)(C.lds + LDS_MISC)); }
    PHASE(PH_PRO, 0); GRID_BAR();
#define LAYER(l) do { PHASE(PH_INPROJ, l); GRID_BAR(); PHASE(PH_GPREP, l); GRID_BAR(); PHASE(PH_MIX, l); GRID_BAR(); PHASE(PH_GPOST, l); GRID_BAR(); \
        PHASE(PH_OUTPROJ, l); GRID_BAR(); PHASE(PH_LN1, l); GRID_BAR(); PHASE(PH_SCAT, l); GRID_BAR(); PHASE(PH_MOE1, l); GRID_BAR(); \
        PHASE(PH_LN2, l); if ((l) + 1 < DEPTH) GRID_BAR(); } while (0)
    LAYER(0); LAYER(1); LAYER(2); LAYER(3);
}
#endif
}

extern "C" void kernel_launch(void* const* d_in, const int* in_sizes, int n_in, void* d_out, int out_size, void* d_ws, size_t ws_size, hipStream_t stream) {
    static int grid = 0;
    if (grid == 0) {
        if (n_in != 26 || out_size != T * D || ws_size < WS_END) { fprintf(stderr, "kernel_launch: unexpected shapes (n_in %d out %d ws %zu need %zu)\n", n_in, out_size, ws_size, (size_t)WS_END); grid = -1; return; }
        int dev = 0, cus = 0; hipGetDevice(&dev); hipDeviceGetAttribute(&cus, hipDeviceAttributeMultiprocessorCount, dev);
#if MK_MULTI
#define SETATTR(PH) hipFuncSetAttribute((const void*)kphase<PH>, hipFuncAttributeMaxDynamicSharedMemorySize, LDS_BYTES)
        SETATTR(PH_PRO); SETATTR(PH_INPROJ); SETATTR(PH_GPREP); SETATTR(PH_MIX); SETATTR(PH_GPOST); SETATTR(PH_OUTPROJ); SETATTR(PH_LN1); SETATTR(PH_SCAT); SETATTR(PH_MOE1); SETATTR(PH_MOE2); SETATTR(PH_LN2);
#else
        hipFuncSetAttribute((const void*)mega, hipFuncAttributeMaxDynamicSharedMemorySize, LDS_BYTES);
        int per_cu = 0; hipOccupancyMaxActiveBlocksPerMultiprocessor(&per_cu, (const void*)mega, NTHREADS, LDS_BYTES);
        if (per_cu < 1) fprintf(stderr, "kernel_launch: occupancy query reports %d blocks per CU\n", per_cu);
#endif
        (void)hipGetLastError();
        grid = cus > 0 ? cus : 256;
    }
    if (grid < 0) return;
    hipMemsetAsync((char*)d_ws + WS_CTL, 0, CTL_BYTES, stream);
    Params P{};
    for (int i = 0; i < 26; ++i) P.in[i] = (const float*)d_in[i];
    P.out = (float*)d_out; P.ws = (unsigned char*)d_ws;
#if MK_MULTI
#define LAUNCH(PH, l) hipLaunchKernelGGL(kphase<PH>, dim3(grid), dim3(NTHREADS), LDS_BYTES, stream, P, l)
    LAUNCH(PH_PRO, 0);
    for (int l = 0; l < DEPTH; ++l) {
        LAUNCH(PH_INPROJ, l); LAUNCH(PH_GPREP, l); LAUNCH(PH_MIX, l); LAUNCH(PH_GPOST, l); LAUNCH(PH_OUTPROJ, l);
        LAUNCH(PH_LN1, l); LAUNCH(PH_SCAT, l); LAUNCH(PH_MOE1, l); LAUNCH(PH_MOE2, l); LAUNCH(PH_LN2, l);
    }
#else
    hipLaunchKernelGGL(mega, dim3(grid), dim3(NTHREADS), LDS_BYTES, stream, P);
#endif
}
```

```cpp
#include <hip/hip_runtime.h>
#include <cstdio>
#include <cstdint>

#ifndef MK_MULTI
#define MK_MULTI 0
#endif

namespace {
#define LAS __attribute__((address_space(3)))
typedef unsigned short bf16_t;
typedef short bf16x8 __attribute__((ext_vector_type(8)));
typedef float f32x4 __attribute__((ext_vector_type(4)));
typedef unsigned u32x4 __attribute__((ext_vector_type(4)));
typedef unsigned u32x2 __attribute__((ext_vector_type(2)));
#define ST16_NT(p, v) (*(u32x4*)(p) = (v))
__device__ __forceinline__ void st16_wt(void* p, u32x4 v) { asm volatile("global_store_dwordx4 %0, %1, off sc1\n\ts_nop 2" :: "v"(p), "v"(v) : "memory"); }

constexpr int D = 1024, BATCH = 8, SEQ = 2048, DEPTH = 4, T = BATCH * SEQ;
constexpr int DIN = 3856, NU = 3840, NINP = 4096;
constexpr int U_MQ = 0, U_MK = 256, U_MV = 512, U_MO = 768, U_SQ = 1024, U_SK = 1280, U_SV = 1536, U_GQ = 1792, U_GZ = 3328;
constexpr int NE = 32, DFF = 1024, MOEB = 256;
constexpr int NBLK = (T * 4) / MOEB + NE;
constexpr int PSLOTS = NBLK * MOEB;
constexpr float ALPHA = 1.6817928305074290f;
constexpr float LN_EPS = 1e-5f, NORM_EPS = 1e-6f;
constexpr int NTHREADS = 512, NWAVES = 8;

constexpr size_t MiB = 1u << 20;
constexpr size_t WS_CTL = 0;
constexpr size_t WS_HF = 1 * MiB;
constexpr size_t WS_HB = WS_HF + 64 * MiB;
constexpr size_t WS_H1F = WS_HB + 32 * MiB;
constexpr size_t WS_H1B = WS_H1F + 64 * MiB;
constexpr size_t WS_U16 = WS_H1B + 32 * MiB;
constexpr size_t WS_GT = WS_U16 + 120 * MiB;
constexpr size_t WS_Y = WS_GT + 1 * MiB;
constexpr size_t WS_TMP = WS_Y + 32 * MiB;
constexpr size_t WS_PLE = WS_TMP + 64 * MiB;
constexpr size_t WS_PB = WS_PLE + 64 * MiB;
constexpr size_t WS_GQ = WS_PB + 32 * MiB;
constexpr size_t WS_GK = WS_GQ + 32 * MiB;
constexpr size_t WS_GV = WS_GK + 32 * MiB;
constexpr size_t WS_GO = WS_GV + 32 * MiB;
constexpr size_t WS_HM = WS_GO + 32 * MiB;
constexpr size_t WS_YB = WS_HM + 144 * MiB;
constexpr size_t WS_RT = WS_YB + 144 * MiB;
constexpr size_t RT_TOPIDX = 0, RT_TOPGATE = 256 * 1024, RT_TOKSLOT = 512 * 1024, RT_SLOTTOK = 768 * 1024, RT_SLOTGATE = 1088 * 1024, RT_BLOCKE = 1408 * 1024, RT_WGCNT = 1536 * 1024  ;
constexpr size_t WS_W = WS_RT + 4 * MiB;
constexpr size_t W_IN = 0, W_OUT = 8 * MiB, W_PG = 10 * MiB, W_PP = 12 * MiB, W_GU = 13 * MiB, W_DN = 141 * MiB, W_LAYER = 205 * MiB;
constexpr size_t WS_END = WS_W + 4 * W_LAYER;
constexpr int CW_BAR = 4096;
constexpr int CW_SBQ = 8192;
constexpr int CW_MOEC = 16384;
constexpr size_t CTL_BYTES = 192 * 1024;
static_assert((CW_MOEC + DEPTH * NBLK * 16) * 4 <= (int)CTL_BYTES, "control words inside the per-call memset");

struct Params { const float* in[26]; float* out; unsigned char* ws; };

__device__ __forceinline__ float bf2f(bf16_t b) { return __uint_as_float(((unsigned)b) << 16); }
typedef __bf16 bf16x2_t __attribute__((ext_vector_type(2)));
typedef float f32x2_t __attribute__((ext_vector_type(2)));
__device__ __forceinline__ unsigned cvt_pk_bf16(float lo, float hi) { const f32x2_t v = {lo, hi}; const bf16x2_t b = __builtin_convertvector(v, bf16x2_t); return __builtin_bit_cast(unsigned, b); }
__device__ __forceinline__ unsigned f2bf(float f) { unsigned u = __float_as_uint(f); return (u + 0x7fffu + ((u >> 16) & 1u)) >> 16; }
__device__ __forceinline__ unsigned pk2(float lo, float hi) { return cvt_pk_bf16(lo, hi); }
__device__ __forceinline__ int lane_id_opaque() { int l = (int)__builtin_amdgcn_mbcnt_hi(~0u, __builtin_amdgcn_mbcnt_lo(~0u, 0u)); asm volatile("" : "+v"(l)); return l; }
__device__ __forceinline__ float shx(float v, int o, int lane) { return __uint_as_float((unsigned)__builtin_amdgcn_ds_bpermute((lane ^ o) << 2, (int)__float_as_uint(v))); }
__device__ __forceinline__ int shxi(int v, int o, int lane) { return __builtin_amdgcn_ds_bpermute((lane ^ o) << 2, v); }
__device__ __forceinline__ float wave_sum(float v) {
    const int lane = lane_id_opaque();
#pragma unroll
    for (int o = 32; o >= 1; o >>= 1) v += shx(v, o, lane);
    return v;
}
__device__ __forceinline__ float rl(float x, int d) { return __uint_as_float((unsigned)__builtin_amdgcn_readlane((int)__float_as_uint(x), d)); }
__device__ __forceinline__ float sigmoidf_(float x) { return __builtin_amdgcn_rcpf(1.0f + __expf(-x)); }
__device__ __forceinline__ float softplusf_(float x) { return fmaxf(x, 0.f) + log1pf(__expf(-fabsf(x))); }
__device__ __forceinline__ float siluf_(float x) { return x * sigmoidf_(x); }

#define XB_TMO      128
#define XB_XCNT(j)  (256  + 64 * (j))
#define XB_XSUB(j)  (1280 + 64 * (j))
#define XB_XGEN(j)  (2304 + 64 * (j))
#define XB_TOP      3328
#define XB_TOPGEN   3392
#define XCD_BAR_WORDS 3456
#define XB_SPIN_CAP (1u << 18)
__device__ __forceinline__ unsigned xb_ld(unsigned* p)              { return __hip_atomic_load(p, __ATOMIC_RELAXED, __HIP_MEMORY_SCOPE_AGENT); }
__device__ __forceinline__ unsigned xb_add(unsigned* p, unsigned v) { return __hip_atomic_fetch_add(p, v, __ATOMIC_RELAXED, __HIP_MEMORY_SCOPE_AGENT); }
__device__ __forceinline__ unsigned xb_xcc_id() { return (unsigned)__builtin_amdgcn_s_getreg((3 << 11) | 20) & 0xFu; }
#define XB_SPIN(cond, bar) do { unsigned _sp = 0; while (cond) { __builtin_amdgcn_s_sleep(1); \
    if ((++_sp & 255u) == 0u) { if (xb_ld(&(bar)[XB_TMO])) break; if (_sp > XB_SPIN_CAP) { atomicAdd(&(bar)[XB_TMO], 1u); break; } } } } while (0)
struct XcdBarrier { unsigned* bar; unsigned x; volatile LAS unsigned* st; };
__device__ __forceinline__ XcdBarrier xcd_barrier_post(unsigned* bar, volatile LAS unsigned* st) {
    XcdBarrier b; b.bar = bar; b.x = xb_xcc_id(); b.st = st;
    if (threadIdx.x == 0) (void)xb_add(&bar[XB_XCNT(b.x)], 1u);
    return b;
}
__device__ __forceinline__ void xcd_barrier_complete(unsigned* bar, unsigned x, unsigned& nloc, unsigned& nx) {
    const unsigned G = gridDim.x * gridDim.y * gridDim.z;
    unsigned sum, cnt, mine, sp = 0u;
    for (;;) {
        sum = 0u; cnt = 0u; mine = 0u;
#pragma unroll
        for (unsigned j = 0; j < 16; ++j) { const unsigned c = xb_ld(&bar[XB_XCNT(j)]); sum += c; cnt += (c > 0u) ? 1u : 0u; mine = (j == x) ? c : mine; }
        if (sum == G) break;
        __builtin_amdgcn_s_sleep(1);
        if ((++sp & 255u) == 0u) { if (xb_ld(&bar[XB_TMO])) break; if (sp > XB_SPIN_CAP) { atomicAdd(&bar[XB_TMO], 1u); break; } }
    }
    nloc = mine > 0u ? mine : 1u; nx = cnt > 0u ? cnt : 1u;
}
__device__ __forceinline__ void xcd_barrier(const XcdBarrier& b) {
    asm volatile("s_waitcnt vmcnt(0)" ::: "memory");
    __syncthreads();
    if (threadIdx.x == 0) {
        unsigned* bar = b.bar;
        __builtin_amdgcn_s_waitcnt(0);
        unsigned nloc = b.st[0], nx = b.st[1];
        if (nloc == 0u) { xcd_barrier_complete(bar, b.x, nloc, nx); b.st[0] = nloc; b.st[1] = nx; }
        const unsigned old = xb_add(&bar[XB_XSUB(b.x)], 1u);
        const unsigned gen = old / nloc;
        if (old + 1u == (gen + 1u) * nloc) {
            __builtin_amdgcn_fence(__ATOMIC_RELEASE, "agent");
            asm volatile("s_waitcnt vmcnt(0)" ::: "memory");
            const unsigned og = xb_add(&bar[XB_TOP], 1u);
            const unsigned tg = og / nx;
            if (og + 1u == (tg + 1u) * nx) xb_add(&bar[XB_TOPGEN], 1u);
            else XB_SPIN(xb_ld(&bar[XB_TOPGEN]) == tg, bar);
            __builtin_amdgcn_fence(__ATOMIC_ACQUIRE, "agent");
            xb_add(&bar[XB_XGEN(b.x)], 1u);
            asm volatile("s_waitcnt vmcnt(0)" ::: "memory");
        } else {
            XB_SPIN(xb_ld(&bar[XB_XGEN(b.x)]) == gen, bar);
            __builtin_amdgcn_fence(__ATOMIC_ACQUIRE, "agent");
            asm volatile("s_waitcnt vmcnt(0)" ::: "memory");
        }
    }
    __syncthreads();
}

constexpr int BM = 256, BK = 64, HALF = 128, HTB = HALF * BK * 2, STAGE_BYTES = 8 * HTB, NXCD = 8, WGM = 8;
constexpr int LDS_TAB = STAGE_BYTES;
constexpr int LDS_UE = LDS_TAB + 12288;
constexpr int LDS_MISC = LDS_UE + 64;
constexpr int LDS_BYTES = 147456;
__host__ __device__ __forceinline__ int lds_byte(int r, int c) { const int st = (r >> 4) * 2 + (c >> 5), rr = r & 15, cc = c & 31, ob = rr * 64 + cc * 2; return st * 1024 + (ob ^ (((ob >> 9) & 1) << 5)); }
__host__ __device__ __forceinline__ void stage_rc(int b, int& R, int& C) { const int st = b / 1024, sb = b % 1024, swz = sb ^ (((sb >> 9) & 1) << 5); R = (st >> 1) * 16 + swz / 64; C = (st & 1) * 32 + (swz % 64) / 2; }
__host__ __device__ __forceinline__ int perm32(int rho) { const int n = rho >> 4, i = rho & 15; return 8 * (i >> 2) + 4 * n + (i & 3); }

constexpr int CV_IN = 16 * 31, CV_OUT = 16 * 8, CV_PG = 16 * 8, CV_PP = 4 * 8, CV_GU1 = 16 * 16, CV_DN1 = 16 * 8;
constexpr int CV_LAYER = CV_IN + CV_OUT + CV_PG + CV_PP + NE * CV_GU1 + NE * CV_DN1;
struct Unit { int pm, pn, e, L; };
__device__ __forceinline__ void convert_item(const Params& P, int l, int r, int lane);

struct DenseOrder {
    int nM, nN, nwg, G, c, K; const char* Bt;
    __device__ void init(int M, int N, int K_, const void* Bt_, int G_, int c_) { nM = M / BM; nN = N / BM; nwg = nM * nN; G = G_; c = c_; K = K_; Bt = (const char*)Bt_; }
    __device__ __forceinline__ bool next(int i, Unit& u) const {
        const long L = (long)i * G + c; if (L >= nwg) return false;
        int wgid = (int)L; { const int q = nwg / NXCD, r = nwg % NXCD, xcd = wgid % NXCD, off = wgid / NXCD; wgid = (xcd < r ? xcd * (q + 1) : r * (q + 1) + (xcd - r) * q) + off; }
        const int nig = WGM * nN, gid = wgid / nig, fm = gid * WGM, gsz = (nM - fm) < WGM ? (nM - fm) : WGM;
        u.pm = fm + ((wgid % nig) % gsz); u.pn = (wgid % nig) / gsz; u.e = 0; u.L = (int)L; return true;
    }
    __device__ __forceinline__ const char* b_base(const Unit& u) const { return Bt + (size_t)u.pn * BM * K * 2; }
    __device__ __forceinline__ void a_ready(const Unit&) const {}
    __device__ __forceinline__ unsigned a_off(int, const Unit& u, int row) const { return (unsigned)(u.pm * BM + row) * (unsigned)(K * 2); }
};
template <bool GATHER> struct MoeOrder {
    int nN, nunits, G, cm, K; const char* Wt; size_t estride; const LAS int* tab; const LAS int* ue;
    unsigned* ready;
    __device__ __forceinline__ void a_ready(const Unit& u) const {
        if (GATHER) return;
        if (threadIdx.x < 64) {
            unsigned sp = 0;
            while ((unsigned)__builtin_amdgcn_readfirstlane(__hip_atomic_load(ready + 16 * u.pm, __ATOMIC_RELAXED, __HIP_MEMORY_SCOPE_AGENT)) < 64u) { __builtin_amdgcn_s_sleep(2); if (++sp > (1u << 21)) break; }
            __builtin_amdgcn_fence(__ATOMIC_ACQUIRE, "agent");
            asm volatile("s_waitcnt vmcnt(0)" ::: "memory");
        }
        asm volatile("" ::: "memory"); __builtin_amdgcn_s_barrier(); asm volatile("" ::: "memory");
    }
    __device__ __forceinline__ bool next(int i, Unit& u) const {
        const int L = i * G + cm; if (L >= nunits) return false;
        u.pm = L / nN; u.pn = L - u.pm * nN; u.e = ue[i]; u.L = L; return true;
    }
    __device__ __forceinline__ const char* b_base(const Unit& u) const { return Wt + (size_t)u.e * estride + (size_t)u.pn * BM * K * 2; }
    __device__ __forceinline__ unsigned a_off(int i, const Unit& u, int row) const {
        if (GATHER) return (unsigned)tab[i * 256 + row] * (unsigned)(K * 2);
        return (unsigned)(u.pm * BM + row) * (unsigned)(K * 2);
    }
};

template <class Epi, class Sched>
__device__ __forceinline__ void gemm_phase(LAS unsigned char* lds, const int tid, const char* Abase, const int K, const Sched& S, const Epi& E) {
    const int wid = __builtin_amdgcn_readfirstlane(tid >> 6), lane = tid & 63, wr = wid >> 2, wc = wid & 3, fr = lane & 15, fq = lane >> 4;
    const int nt = K / BK;
    int Rr[2]; unsigned cb[2], voffB[2];
#pragma unroll
    for (int i = 0; i < 2; ++i) { int R, C; stage_rc(tid * 16 + i * 8192, R, C); const int Rb = Epi::PERM ? ((R & ~31) + perm32(R & 31)) : R;
        Rr[i] = R; cb[i] = (unsigned)C * 2u; voffB[i] = (unsigned)(Rb * K + C) * 2u; }
    const size_t kstep = (size_t)(BK * 2);
    const size_t hstep = (size_t)HALF * K * 2;
    const unsigned ldsw = (unsigned)wid * 1024u;
    const int aoff = lds_byte(wr * 64 + fr, fq * 8), boff = lds_byte(wc * 32 + fr, fq * 8);
#define G_SA(b, h) (((b) * 2 + (h)) * HTB)
#define G_SB(b, h) ((4 + (b) * 2 + (h)) * HTB)
#define G_STAGE_B(bufoff, gbase) do { _Pragma("unroll") for (int _i = 0; _i < 2; ++_i) \
        __builtin_amdgcn_global_load_lds((const unsigned*)((const char*)(gbase) + voffB[_i]), (LAS unsigned*)(lds + (bufoff) + ldsw + _i * 8192), 16, 0, 0); } while (0)
#define G_STAGE_A(bufoff, kbyte, ao) do { _Pragma("unroll") for (int _i = 0; _i < 2; ++_i) \
        __builtin_amdgcn_global_load_lds((const unsigned*)(Abase + (size_t)(kbyte) + (ao)[_i]), (LAS unsigned*)(lds + (bufoff) + ldsw + _i * 8192), 16, 0, 0); } while (0)
#define G_LDA(dst, b, h) do { _Pragma("unroll") for (int m = 0; m < 4; ++m) _Pragma("unroll") for (int k = 0; k < 2; ++k) dst[m][k] = *(const LAS bf16x8*)(lds + G_SA(b, h) + aoff + m * 2048 + k * 1024); } while (0)
#define G_LDB(dst, b, h) do { _Pragma("unroll") for (int n = 0; n < 2; ++n) _Pragma("unroll") for (int k = 0; k < 2; ++k) dst[n][k] = *(const LAS bf16x8*)(lds + G_SB(b, h) + boff + n * 2048 + k * 1024); } while (0)
#define G_MMA(ai, bj, At, Bt) do { __builtin_amdgcn_s_setprio(1); _Pragma("unroll") for (int m = 0; m < 4; ++m) _Pragma("unroll") for (int n = 0; n < 2; ++n) _Pragma("unroll") for (int k = 0; k < 2; ++k) \
        acc[ai][bj][m][n] = __builtin_amdgcn_mfma_f32_16x16x32_bf16(Bt[n][k], At[m][k], acc[ai][bj][m][n], 0, 0, 0); __builtin_amdgcn_s_setprio(0); } while (0)
#define G_WAIT_V(n) asm volatile("s_waitcnt vmcnt(" #n ")" ::: "memory")
#define G_WAIT_L(n) asm volatile("s_waitcnt lgkmcnt(" #n ")" ::: "memory")
#define G_BAR __builtin_amdgcn_s_barrier()
#define G_SCHED __builtin_amdgcn_sched_barrier(0)
    Unit cur, nxt; int ui = 0;
    if (!S.next(0, cur)) return;
    f32x4 acc[2][2][4][2];
#pragma unroll
    for (int a = 0; a < 2; ++a)
#pragma unroll
        for (int b = 0; b < 2; ++b)
#pragma unroll
            for (int m = 0; m < 4; ++m)
#pragma unroll
                for (int n = 0; n < 2; ++n) acc[a][b][m][n] = (f32x4){0.f, 0.f, 0.f, 0.f};
    bf16x8 At[4][2], B0[2][2], B1[2][2];
    unsigned aoc[2][2], aon[2][2];
#pragma unroll
    for (int h = 0; h < 2; ++h)
#pragma unroll
        for (int i = 0; i < 2; ++i) aoc[h][i] = S.a_off(0, cur, h * HALF + Rr[i]) + cb[i];
    const char* cB = S.b_base(cur);
    S.a_ready(cur);
    Unit prv = cur; bool have_prv = false;
    G_STAGE_B(G_SB(0, 0), cB); G_STAGE_A(G_SA(0, 0), 0, aoc[0]); G_STAGE_B(G_SB(0, 1), cB + hstep); G_STAGE_A(G_SA(0, 1), 0, aoc[1]);
    if (wr == 1) G_BAR;
    G_WAIT_V(4); G_BAR;
    G_STAGE_B(G_SB(1, 0), cB + kstep); G_STAGE_A(G_SA(1, 0), kstep, aoc[0]); G_STAGE_B(G_SB(1, 1), cB + hstep + kstep);
    G_WAIT_V(6); G_BAR;
    for (;;) {
        const bool has_next = S.next(ui + 1, nxt);
        const char* nB = has_next ? S.b_base(nxt) : cB;
#pragma unroll
        for (int h = 0; h < 2; ++h)
#pragma unroll
            for (int i = 0; i < 2; ++i) aon[h][i] = has_next ? (S.a_off(ui + 1, nxt, h * HALF + Rr[i]) + cb[i]) : aoc[h][i];
        for (int t = 0; t < nt; t += 2) {
            const bool last = (t == nt - 2);
            if (last) { if (have_prv) { E.publish(prv, lane); have_prv = false; } if (has_next) S.a_ready(nxt); }
            const size_t k1 = (size_t)(t + 1) * kstep;
            const size_t k2 = last ? (size_t)0 : (size_t)(t + 2) * kstep;
            const char* b2 = last ? nB : cB + (size_t)(t + 2) * kstep;
            const char* b3 = b2 + kstep;
            unsigned a2o[2][2];
#pragma unroll
            for (int h = 0; h < 2; ++h)
#pragma unroll
                for (int i = 0; i < 2; ++i) a2o[h][i] = last ? aon[h][i] : aoc[h][i];
            G_LDB(B0, 0, 0); G_SCHED; G_LDA(At, 0, 0); G_STAGE_A(G_SA(1, 1), k1, aoc[1]);
            G_WAIT_L(8); G_BAR; G_WAIT_L(0); G_MMA(0, 0, At, B0); G_BAR; G_SCHED;
            G_LDB(B1, 0, 1); G_STAGE_B(G_SB(0, 0), b2);
            G_BAR; G_WAIT_L(0); G_MMA(0, 1, At, B1); G_BAR;
            G_LDA(At, 0, 1); G_STAGE_A(G_SA(0, 0), k2, a2o[0]);
            G_BAR; G_WAIT_L(0); G_MMA(1, 0, At, B0); G_BAR; G_SCHED;
            G_STAGE_B(G_SB(0, 1), b2 + hstep);
            G_WAIT_V(6); G_BAR; G_MMA(1, 1, At, B1); G_BAR;
            G_LDB(B0, 1, 0); G_SCHED; G_LDA(At, 1, 0); G_STAGE_A(G_SA(0, 1), k2, a2o[1]);
            G_WAIT_L(8); G_BAR; G_WAIT_L(0); G_MMA(0, 0, At, B0); G_BAR; G_SCHED;
            G_LDB(B1, 1, 1); G_STAGE_B(G_SB(1, 0), b3);
            G_BAR; G_WAIT_L(0); G_MMA(0, 1, At, B1); G_BAR;
            G_LDA(At, 1, 1); G_STAGE_A(G_SA(1, 0), k2 + kstep, a2o[0]);
            G_BAR; G_WAIT_L(0); G_MMA(1, 0, At, B0); G_BAR; G_SCHED;
            G_STAGE_B(G_SB(1, 1), b3 + hstep);
            G_WAIT_V(6); G_BAR; G_MMA(1, 1, At, B1); G_BAR;
        }
        E(acc, cur, wr, wc, fr, fq);
        prv = cur; have_prv = true;
        E.after_unit(cur, wid, lane);
        if (!has_next) break;
#pragma unroll
        for (int a = 0; a < 2; ++a)
#pragma unroll
            for (int b = 0; b < 2; ++b)
#pragma unroll
                for (int m = 0; m < 4; ++m)
#pragma unroll
                    for (int n = 0; n < 2; ++n) acc[a][b][m][n] = (f32x4){0.f, 0.f, 0.f, 0.f};
        cur = nxt; cB = nB; ++ui;
#pragma unroll
        for (int h = 0; h < 2; ++h)
#pragma unroll
            for (int i = 0; i < 2; ++i) aoc[h][i] = aon[h][i];
    }
    G_WAIT_V(0);
    if (have_prv) E.publish(prv, lane);
    if (wr == 0) G_BAR;
    G_BAR;
#undef G_SA
#undef G_SB
#undef G_STAGE_A
#undef G_STAGE_B
#undef G_LDA
#undef G_LDB
#undef G_MMA
#undef G_WAIT_V
#undef G_WAIT_L
#undef G_BAR
#undef G_SCHED
}

struct EpiU {
    static constexpr bool PERM = true;
    __device__ __forceinline__ void after_unit(const Unit&, int, int) const {}
    __device__ __forceinline__ void publish(const Unit&, int) const {}
    bf16_t* U; float* GT;
    __device__ __forceinline__ void operator()(const f32x4 (&acc)[2][2][4][2], const Unit& u, int wr, int wc, int fr, int fq) const {
        const int row0 = u.pm * BM + wr * 64 + fr;
        if (u.pn < 15) {
            const int col0 = u.pn * BM + wc * 32 + 8 * fq;
#pragma unroll
            for (int ai = 0; ai < 2; ++ai)
#pragma unroll
                for (int m = 0; m < 4; ++m) { bf16_t* rowp = U + (size_t)(row0 + ai * HALF + m * 16) * NU + col0;
#pragma unroll
                    for (int bj = 0; bj < 2; ++bj) { const f32x4 v0 = acc[ai][bj][m][0], v1 = acc[ai][bj][m][1];
                        u32x4 w; w.x = cvt_pk_bf16(v0[0], v0[1]); w.y = cvt_pk_bf16(v0[2], v0[3]); w.z = cvt_pk_bf16(v1[0], v1[1]); w.w = cvt_pk_bf16(v1[2], v1[3]);
                        ST16_NT(rowp + bj * HALF, w); } }
        } else if (wc == 0 && fq < 2) {
#pragma unroll
            for (int ai = 0; ai < 2; ++ai)
#pragma unroll
                for (int m = 0; m < 4; ++m) { float* rowp = GT + (size_t)(row0 + ai * HALF + m * 16) * 16 + 8 * fq;
#pragma unroll
                    for (int n = 0; n < 2; ++n) *(f32x4*)(rowp + 4 * n) = acc[ai][0][m][n]; }
        }
    }
};
template <int MODE  > struct EpiF32 {
    static constexpr bool PERM = false;
    __device__ __forceinline__ void after_unit(const Unit&, int, int) const {}
    __device__ __forceinline__ void publish(const Unit&, int) const {}
    float* C; int ldc; const float* Src;
    __device__ __forceinline__ void operator()(const f32x4 (&acc)[2][2][4][2], const Unit& u, int wr, int wc, int fr, int fq) const {
        const int row0 = u.pm * BM + wr * 64 + fr, col0 = u.pn * BM + wc * 32 + 4 * fq;
#pragma unroll
        for (int ai = 0; ai < 2; ++ai)
#pragma unroll
            for (int m = 0; m < 4; ++m) { float* rowp = C + (size_t)(row0 + ai * HALF + m * 16) * ldc + col0;
#pragma unroll
                for (int bj = 0; bj < 2; ++bj)
#pragma unroll
                    for (int n = 0; n < 2; ++n) { f32x4 v = acc[ai][bj][m][n];
                        if (MODE == 1) { const f32x4 o = *(const f32x4*)(Src + (size_t)(row0 + ai * HALF + m * 16) * ldc + col0 + bj * HALF + n * 16);
#pragma unroll
                            for (int j = 0; j < 4; ++j) v[j] = sigmoidf_(v[j]) * o[j]; }
                        *(f32x4*)(rowp + bj * HALF + n * 16) = v; } }
    }
};
template <int MODE  > struct EpiB16 {
    static constexpr bool PERM = true;
    __device__ __forceinline__ void after_unit(const Unit&, int, int) const {}
    __device__ __forceinline__ void publish(const Unit&, int) const {}
    bf16_t* O; int ldc; const bf16_t* Src;
    __device__ __forceinline__ void operator()(const f32x4 (&acc)[2][2][4][2], const Unit& u, int wr, int wc, int fr, int fq) const {
        const int row0 = u.pm * BM + wr * 64 + fr, col0 = u.pn * BM + wc * 32 + 8 * fq;
#pragma unroll
        for (int ai = 0; ai < 2; ++ai)
#pragma unroll
            for (int m = 0; m < 4; ++m) { const size_t off = (size_t)(row0 + ai * HALF + m * 16) * ldc + col0;
#pragma unroll
                for (int bj = 0; bj < 2; ++bj) { f32x4 v0 = acc[ai][bj][m][0], v1 = acc[ai][bj][m][1];
                    if (MODE == 1) { const u32x4 g = *(const u32x4*)(Src + off + bj * HALF);
                        v0[0] = sigmoidf_(v0[0]) * __uint_as_float(g.x << 16); v0[1] = sigmoidf_(v0[1]) * __uint_as_float(g.x & 0xffff0000u); v0[2] = sigmoidf_(v0[2]) * __uint_as_float(g.y << 16); v0[3] = sigmoidf_(v0[3]) * __uint_as_float(g.y & 0xffff0000u);
                        v1[0] = sigmoidf_(v1[0]) * __uint_as_float(g.z << 16); v1[1] = sigmoidf_(v1[1]) * __uint_as_float(g.z & 0xffff0000u); v1[2] = sigmoidf_(v1[2]) * __uint_as_float(g.w << 16); v1[3] = sigmoidf_(v1[3]) * __uint_as_float(g.w & 0xffff0000u); }
                    u32x4 w; w.x = cvt_pk_bf16(v0[0], v0[1]); w.y = cvt_pk_bf16(v0[2], v0[3]); w.z = cvt_pk_bf16(v1[0], v1[1]); w.w = cvt_pk_bf16(v1[2], v1[3]);
                    *(u32x4*)(O + off + bj * HALF) = w; } }
    }
};
struct EpiMoe1 {
    static constexpr bool PERM = true;
    Params Pc; int lnext, G, nunits;
    __device__ __forceinline__ void after_unit(const Unit& u, int wid, int lane) const {
        if (lnext >= DEPTH) return;
        const int i = u.L / G, c = u.L - i * G;
        if (i != (c & 7)) return;
        const int n9 = nunits - 8 * G > 0 ? (nunits - 8 * G < G ? nunits - 8 * G : G) : 0, n8 = G - n9;
        int x = (CV_LAYER / NWAVES - 3 * n8 + G - 1) / G; if (x < 0) x = 0;
        const int cnt = c < n9 ? x : x + 3, start = c < n9 ? c * NWAVES * x : n9 * NWAVES * x + (c - n9) * NWAVES * (x + 3);
        for (int k = 0; k < cnt; ++k) { const int idx = start + wid * cnt + k; if (idx < CV_LAYER) convert_item(Pc, lnext, idx, lane); }
    }
    bf16_t* H; const float* b_gu;
    unsigned* ready;
    __device__ __forceinline__ void publish(const Unit& u, int lane) const { if (lane == 0) __hip_atomic_fetch_add(ready + 16 * u.pm, 1u, __ATOMIC_RELAXED, __HIP_MEMORY_SCOPE_AGENT); }
    __device__ __forceinline__ void operator()(const f32x4 (&acc)[2][2][4][2], const Unit& u, int wr, int wc, int fr, int fq) const {
        const int row0 = u.pm * BM + wr * 64 + fr, col0 = u.pn * HALF + wc * 32 + 8 * fq;
        f32x4 bg[2], bu[2];
#pragma unroll
        for (int n = 0; n < 2; ++n) { bg[n] = *(const f32x4*)(b_gu + (size_t)u.e * 2048 + col0 + 4 * n); bu[n] = *(const f32x4*)(b_gu + (size_t)u.e * 2048 + 1024 + col0 + 4 * n); }
#pragma unroll
        for (int ai = 0; ai < 2; ++ai)
#pragma unroll
            for (int m = 0; m < 4; ++m) { float o[8];
#pragma unroll
                for (int n = 0; n < 2; ++n)
#pragma unroll
                    for (int j = 0; j < 4; ++j) { float g = acc[ai][0][m][n][j] + bg[n][j], up = acc[ai][1][m][n][j] + bu[n][j];
                        g = fminf(g, 7.0f); up = fminf(fmaxf(up, -7.0f), 7.0f);
                        o[n * 4 + j] = (up + 1.0f) * g * sigmoidf_(1.702f * g); }
                u32x4 w; w.x = cvt_pk_bf16(o[0], o[1]); w.y = cvt_pk_bf16(o[2], o[3]); w.z = cvt_pk_bf16(o[4], o[5]); w.w = cvt_pk_bf16(o[6], o[7]);
                st16_wt(H + (size_t)(row0 + ai * HALF + m * 16) * DFF + col0, w); }
    }
};
struct EpiMoe2 {
    static constexpr bool PERM = true;
    __device__ __forceinline__ void after_unit(const Unit&, int, int) const {}
    __device__ __forceinline__ void publish(const Unit&, int) const {}
    bf16_t* Yb; const float* b_down; const float* slot_gate;
    __device__ __forceinline__ void operator()(const f32x4 (&acc)[2][2][4][2], const Unit& u, int wr, int wc, int fr, int fq) const {
        const int row0 = u.pm * BM + wr * 64 + fr, col0 = u.pn * BM + wc * 32 + 8 * fq;
        f32x4 bv[2][2];
#pragma unroll
        for (int bj = 0; bj < 2; ++bj)
#pragma unroll
            for (int n = 0; n < 2; ++n) bv[bj][n] = *(const f32x4*)(b_down + (size_t)u.e * D + col0 + bj * HALF + 4 * n);
#pragma unroll
        for (int ai = 0; ai < 2; ++ai)
#pragma unroll
            for (int m = 0; m < 4; ++m) { const int row = row0 + ai * HALF + m * 16; const float gt = slot_gate[row];
#pragma unroll
                for (int bj = 0; bj < 2; ++bj) { const f32x4 v0 = (acc[ai][bj][m][0] + bv[bj][0]) * gt, v1 = (acc[ai][bj][m][1] + bv[bj][1]) * gt;
                    u32x4 w; w.x = cvt_pk_bf16(v0[0], v0[1]); w.y = cvt_pk_bf16(v0[2], v0[3]); w.z = cvt_pk_bf16(v1[0], v1[1]); w.w = cvt_pk_bf16(v1[2], v1[3]);
                    ST16_NT(Yb + (size_t)row * D + col0 + bj * HALF, w); } }
    }
};

struct Ctx {
    LAS unsigned char* lds; int tid, lane, wave, G, bid;
};
#define WSP(T_, off) ((T_*)(P.ws + (off)))
__device__ __forceinline__ unsigned* ctl_words(const Params& P) { return (unsigned*)(P.ws + WS_CTL); }

__device__ __forceinline__ int map_win(int n) { return n < 1024 ? n : (n < 1032 ? n + 2816 : (n < 3848 ? n - 8 : n)); }
__device__ __forceinline__ int map_wgu(int n) { return n < 1024 ? ((n >> 7) * 256 + (n & 127)) : ((((n - 1024) >> 7) * 256) + 128 + ((n - 1024) & 127)); }
__device__ __forceinline__ void transpose_item(const float* W, int K, int N, bf16_t* WT, int map, int item, int lane) {
    const int nblk = (N + 127) / 128, kb = item / nblk, nb = item - kb * nblk;
    const int kg = lane & 7, ng = lane >> 3, k0 = kb * 64 + 8 * kg, n0 = nb * 128 + 4 * ng;
    f32x4 v[4][8];
#pragma unroll
    for (int q = 0; q < 4; ++q) { const int n = n0 + 32 * q, nn = n < N ? n : 0;
#pragma unroll
        for (int i = 0; i < 8; ++i) v[q][i] = *(const f32x4*)(W + (size_t)(k0 + i) * N + nn); }
#pragma unroll
    for (int q = 0; q < 4; ++q) { const int n = n0 + 32 * q;
        if (n < N) {
#pragma unroll
            for (int j = 0; j < 4; ++j) { const int ngl = n + j; const int nr = map == 1 ? map_win(ngl) : (map == 2 ? map_wgu(ngl) : ngl);
                u32x4 o;
#pragma unroll
                for (int x = 0; x < 4; ++x) o[x] = cvt_pk_bf16(v[q][2 * x][j], v[q][2 * x + 1][j]);
                *(u32x4*)(WT + (size_t)nr * K + k0) = o; } } }
}
__device__ __forceinline__ void convert_item(const Params& P, int l, int r, int lane) {
    unsigned char* wl = P.ws + WS_W + (size_t)l * W_LAYER;
    const float* W; bf16_t* WT; int K = D, N = D, map = 0;
    if (r < CV_IN) { W = P.in[4] + (size_t)l * D * DIN; N = DIN; WT = (bf16_t*)(wl + W_IN); map = 1; }
    else if ((r -= CV_IN) < CV_OUT) { W = P.in[13] + (size_t)l * D * D; WT = (bf16_t*)(wl + W_OUT); }
    else if ((r -= CV_OUT) < CV_PG) { W = P.in[22] + (size_t)l * D * D; WT = (bf16_t*)(wl + W_PG); }
    else if ((r -= CV_PG) < CV_PP) { W = P.in[23] + (size_t)l * 256 * D; K = 256; WT = (bf16_t*)(wl + W_PP); }
    else if ((r -= CV_PP) < NE * CV_GU1) { const int e = r / CV_GU1; r -= e * CV_GU1; W = P.in[18] + ((size_t)l * NE + e) * D * 2048; N = 2048; WT = (bf16_t*)(wl + W_GU) + (size_t)e * 2048 * D; map = 2; }
    else { r -= NE * CV_GU1; const int e = r / CV_DN1; r -= e * CV_DN1; W = P.in[20] + ((size_t)l * NE + e) * DFF * D; WT = (bf16_t*)(wl + W_DN) + (size_t)e * D * DFF; }
    transpose_item(W, K, N, WT, map, r, lane);
}
__device__ __forceinline__ void ln_store_row(const float (&v)[16], float rstd, const float* g, const float* b, float* of, bf16_t* ob, int lane) {
#pragma unroll
    for (int j = 0; j < 4; ++j) { const int c = 4 * lane + 256 * j; const f32x4 gg = *(const f32x4*)(g + c), bb = *(const f32x4*)(b + c);
        f32x4 o; o[0] = v[4 * j] * rstd * gg[0] + bb[0]; o[1] = v[4 * j + 1] * rstd * gg[1] + bb[1]; o[2] = v[4 * j + 2] * rstd * gg[2] + bb[2]; o[3] = v[4 * j + 3] * rstd * gg[3] + bb[3];
        if (of) *(f32x4*)(of + c) = o;
        if (ob) { u32x2 w; w.x = pk2(o[0], o[1]); w.y = pk2(o[2], o[3]); *(u32x2*)(ob + c) = w; } }
}
__device__ __forceinline__ void phase_prologue(const Params& P, const Ctx& C) {
    const int gw = C.bid * NWAVES + C.wave, NGW = C.G * NWAVES;
    for (int it = gw; it < CV_LAYER; it += NGW) convert_item(P, 0, it, C.lane);
    { const float* p = P.in[1]; bf16_t* pb = WSP(bf16_t, WS_PB); const size_t n4 = (size_t)DEPTH * T * 256 / 4;
      const size_t stride = (size_t)C.G * NTHREADS;
      for (size_t i0 = (size_t)C.bid * NTHREADS + C.tid; i0 < n4; i0 += 8 * stride) {
          f32x4 v[8];
#pragma unroll
          for (int k = 0; k < 8; ++k) { const size_t i = i0 + k * stride; if (i < n4) v[k] = *(const f32x4*)(p + 4 * i); }
#pragma unroll
          for (int k = 0; k < 8; ++k) { const size_t i = i0 + k * stride; if (i < n4) { u32x2 w; w.x = pk2(v[k][0], v[k][1]); w.y = pk2(v[k][2], v[k][3]); *(u32x2*)(pb + 4 * i) = w; } } } }
    for (int row0 = gw; row0 < T; row0 += 2 * NGW) {
        float v[2][16]; float s[2] = {0.f, 0.f};
#pragma unroll
        for (int k = 0; k < 2; ++k) { const int row = row0 + k * NGW < T ? row0 + k * NGW : row0; const float* x = P.in[0] + (size_t)row * D;
#pragma unroll
            for (int j = 0; j < 4; ++j) { const f32x4 t = *(const f32x4*)(x + 4 * C.lane + 256 * j); v[k][4 * j] = t[0]; v[k][4 * j + 1] = t[1]; v[k][4 * j + 2] = t[2]; v[k][4 * j + 3] = t[3]; s[k] += (t[0] + t[1]) + (t[2] + t[3]); } }
#pragma unroll
        for (int k = 0; k < 2; ++k) { const int row = row0 + k * NGW; if (row < T) {
            const float mean = wave_sum(s[k]) * (1.f / D); float q = 0.f;
#pragma unroll
            for (int i = 0; i < 16; ++i) { v[k][i] -= mean; q += v[k][i] * v[k][i]; }
            const float rstd = rsqrtf(wave_sum(q) * (1.f / D) + LN_EPS);
            ln_store_row(v[k], rstd, P.in[2], P.in[3], nullptr, WSP(bf16_t, WS_HB) + (size_t)row * D, C.lane); } }
    }
}

__device__ __forceinline__ void phase_inproj(const Params& P, const Ctx& C, int l) {
    DenseOrder S; S.init(T, NINP, D, P.ws + WS_W + (size_t)l * W_LAYER + W_IN, C.G, C.bid);
    EpiU E{WSP(bf16_t, WS_U16), WSP(float, WS_GT)};
    gemm_phase(C.lds, C.tid, (const char*)(P.ws + WS_HB), D, S, E);
}

typedef float f32x16 __attribute__((ext_vector_type(16)));
#define MFMA32(a, b, c) __builtin_amdgcn_mfma_f32_32x32x16_bf16((a), (b), (c), 0, 0, 0)
constexpr int SB_KSTR = 72, SB_VSTR = 68, SB_KBYTES = 64 * SB_KSTR * 2, SB_BUF = SB_KBYTES + 64 * SB_VSTR * 2;
__device__ __forceinline__ float shx32(float v, int lane) { return __uint_as_float((unsigned)__builtin_amdgcn_ds_bpermute((lane ^ 32) << 2, (int)__float_as_uint(v))); }
template <bool DIAG> __device__ __forceinline__ void sb_tile_math(const f32x16& sacc, float& carry, bf16x8 (&pf)[2], int r, int hh, int lane) {
    float sg[16], om[16];
#pragma unroll
    for (int i = 0; i < 16; ++i) {
        const float t = fminf(sacc[i] * (-0.125f * 1.4426950408889634f), 80.f);
        const float e = __builtin_amdgcn_exp2f(t);
        float sgm = __builtin_amdgcn_rcpf(1.0f + e), omv = e * sgm;
        if (DIAG) { const int srow_i = (i & 3) + 8 * (i >> 2) + 4 * hh; const bool masked = srow_i >= r; sgm = masked ? 0.f : sgm; omv = masked ? 1.f : omv; }
        sg[i] = sgm; om[i] = omv;
    }
    float sfx[16], pg[4], pp[4], both[4];
#pragma unroll
    for (int g = 0; g < 4; ++g) { sfx[4 * g + 3] = 1.f; sfx[4 * g + 2] = om[4 * g + 3]; sfx[4 * g + 1] = sfx[4 * g + 2] * om[4 * g + 2]; sfx[4 * g] = sfx[4 * g + 1] * om[4 * g + 1]; pg[g] = sfx[4 * g] * om[4 * g]; }
#pragma unroll
    for (int g = 0; g < 4; ++g) { pp[g] = shx32(pg[g], lane); both[g] = pg[g] * pp[g]; }
    float outer[4];
    outer[3] = 1.f; outer[2] = both[3]; outer[1] = both[3] * both[2]; outer[0] = outer[1] * both[1];
    const float total = outer[0] * both[0];
#pragma unroll
    for (int g = 0; g < 4; ++g) { if (hh == 0) outer[g] *= pp[g]; outer[g] *= carry; }
    carry *= total;
#pragma unroll
    for (int s2 = 0; s2 < 2; ++s2) { u32x4 pk;
#pragma unroll
        for (int x = 0; x < 4; ++x) { const int i0 = 8 * s2 + 2 * x; pk[x] = cvt_pk_bf16(sg[i0] * (sfx[i0] * outer[i0 >> 2]), sg[i0 + 1] * (sfx[i0 + 1] * outer[(i0 + 1) >> 2])); }
        pf[s2] = __builtin_bit_cast(bf16x8, pk); }
}
__device__ __forceinline__ void sb_unit(const Params& P, const Ctx& C, int l, int b, int h, int qb) {
    const bf16_t* base = WSP(bf16_t, WS_U16) + (size_t)b * SEQ * NU;
    int tid_ = C.tid; asm volatile("" : "+v"(tid_));
    const int w = __builtin_amdgcn_readfirstlane(tid_ >> 6), lane = tid_ & 63, r = lane & 31, hh = lane >> 5;
    const int q0 = qb * 256 + 32 * w;
    bf16x8 qf[4];
#pragma unroll
    for (int kk = 0; kk < 4; ++kk) qf[kk] = *(const bf16x8*)(base + (size_t)(q0 + r) * NU + U_SQ + h * 64 + 16 * kk + 8 * hh);
    f32x16 oacc[2];
#pragma unroll
    for (int i = 0; i < 16; ++i) { oacc[0][i] = 0.f; oacc[1][i] = 0.f; }
    float carry = 1.f;
    const int nst = 4 * (qb + 1);
    const int srow = tid_ >> 3, scol = (tid_ & 7) * 8;
    LAS unsigned* alive = (LAS unsigned*)(C.lds + 2 * SB_BUF);
    u32x4 kreg, vreg;
    { const bf16_t* rowp = base + (size_t)(64 * (nst - 1) + srow) * NU + h * 64 + scol; kreg = *(const u32x4*)(rowp + U_SK); vreg = *(const u32x4*)(rowp + U_SV); }
    for (int st = nst - 1; st >= 0; --st) {
        LAS unsigned char* buf = C.lds + (st & 1) * SB_BUF;
        *(LAS u32x4*)(buf + (srow * SB_KSTR + scol) * 2) = kreg;
        { LAS bf16_t* vt = (LAS bf16_t*)(buf + SB_KBYTES);
#pragma unroll
          for (int j = 0; j < 4; ++j) { vt[(scol + 2 * j) * SB_VSTR + srow] = (bf16_t)(vreg[j] & 0xffffu); vt[(scol + 2 * j + 1) * SB_VSTR + srow] = (bf16_t)(vreg[j] >> 16); } }
        const bool wave_alive = __any(carry != 0.f) != 0;
        if (lane == 0) alive[(st & 1) * 8 + w] = wave_alive ? 1u : 0u;
        __syncthreads();
        { unsigned any_alive = 0u;
#pragma unroll
          for (int i = 0; i < 8; ++i) any_alive |= alive[(st & 1) * 8 + i];
          if (any_alive == 0u) break; }
        if (st > 0) { const bf16_t* rowp = base + (size_t)(64 * (st - 1) + srow) * NU + h * 64 + scol; kreg = *(const u32x4*)(rowp + U_SK); vreg = *(const u32x4*)(rowp + U_SV); }
        const LAS bf16_t* vt = (const LAS bf16_t*)(buf + SB_KBYTES);
#pragma unroll
        for (int half = 1; half >= 0; --half) {
            const int kb = 64 * st + 32 * half;
            if (kb >= q0 + 32 || !wave_alive) continue;
            const bool diag = (kb == q0);
            f32x16 sacc;
#pragma unroll
            for (int i = 0; i < 16; ++i) sacc[i] = 0.f;
#pragma unroll
            for (int kk = 0; kk < 4; ++kk) { const bf16x8 kf = *(const LAS bf16x8*)(buf + ((32 * half + r) * SB_KSTR + 16 * kk + 8 * hh) * 2); sacc = MFMA32(kf, qf[kk], sacc); }
            bf16x8 pf[2];
            if (diag) sb_tile_math<true>(sacc, carry, pf, r, hh, lane); else sb_tile_math<false>(sacc, carry, pf, r, hh, lane);
#pragma unroll
            for (int dt = 0; dt < 2; ++dt)
#pragma unroll
                for (int s2 = 0; s2 < 2; ++s2) { const LAS bf16_t* vrow = vt + (32 * dt + r) * SB_VSTR + 32 * half + 16 * s2 + 4 * hh;
                    const u32x2 lo = *(const LAS u32x2*)vrow, hi = *(const LAS u32x2*)(vrow + 8);
                    u32x4 vv; vv.x = lo.x; vv.y = lo.y; vv.z = hi.x; vv.w = hi.y;
                    oacc[dt] = MFMA32(__builtin_bit_cast(bf16x8, vv), pf[s2], oacc[dt]); }
        }
    }
    float ss = 0.f;
#pragma unroll
    for (int i = 0; i < 16; ++i) ss += oacc[0][i] * oacc[0][i] + oacc[1][i] * oacc[1][i];
    ss += shx32(ss, lane);
    const float sc = rsqrtf(ss * (1.f / 64.f) + NORM_EPS);
    const float* nw = P.in[8] + l * 256 + h * 64;
    bf16_t* yrow = WSP(bf16_t, WS_Y) + (size_t)(b * SEQ + q0 + r) * D + 256 + h * 64;
#pragma unroll
    for (int dt = 0; dt < 2; ++dt)
#pragma unroll
        for (int g = 0; g < 4; ++g) { const int d0 = 32 * dt + 8 * g + 4 * hh; const f32x4 n4 = *(const f32x4*)(nw + d0);
            u32x2 o2; o2.x = cvt_pk_bf16(oacc[dt][4 * g] * sc * n4[0], oacc[dt][4 * g + 1] * sc * n4[1]); o2.y = cvt_pk_bf16(oacc[dt][4 * g + 2] * sc * n4[2], oacc[dt][4 * g + 3] * sc * n4[3]);
            *(u32x2*)(yrow + d0) = o2; }
    __syncthreads();
}

constexpr int ML_STR = 72;
constexpr int ML_MAT = 64 * ML_STR * 2;
constexpr int ML_STAGE = 4 * ML_MAT;
constexpr int ML_K = 0, ML_Q = ML_MAT, ML_VT = 2 * ML_MAT, ML_KWT = 3 * ML_MAT;
constexpr int ML_CT = 2 * ML_STAGE  , ML_N = ML_CT + 2 * ML_MAT  , ML_SSQ = ML_N + 512  ,
              ML_GB = ML_SSQ + 1024  , ML_GWL = ML_GB + 8192, ML_GEB = ML_GWL + 8192, ML_GWG = ML_GEB + 8192  , ML_GG = ML_GWG + 8192  , ML_END = ML_GG + 128;
static_assert(ML_END <= LDS_TAB, "mLSTM LDS map");
__device__ __forceinline__ float shup(float v, int o, int lane) { return __uint_as_float((unsigned)__builtin_amdgcn_ds_bpermute((lane - o) << 2, (int)__float_as_uint(v))); }
__device__ __forceinline__ float shidx(float v, int src) { return __uint_as_float((unsigned)__builtin_amdgcn_ds_bpermute(src << 2, (int)__float_as_uint(v))); }
__device__ __forceinline__ void mlstm_unit(const Params& P, const Ctx& C, int l, int b, int h, int par) {
    const bf16_t* U = WSP(bf16_t, WS_U16) + (size_t)b * SEQ * NU; const float* GT = WSP(float, WS_GT) + (size_t)b * SEQ * 16;
    LAS unsigned char* lds = C.lds;
    const int w = C.wave, lane = C.lane, r = lane & 31, hh = lane >> 5, tid = C.tid;
    const float ib = P.in[5][l * 4 + h], fb = P.in[6][l * 4 + h];
    for (int i = tid; i < (2 * ML_MAT + 512 + 1024) / 4; i += NTHREADS) ((LAS unsigned*)(lds + ML_CT))[i] = 0u;
    for (int n = w; n < SEQ / 64; n += NWAVES) {
        const size_t tk = (size_t)64 * n + lane;
        float bcs = -softplusf_(-(GT[tk * 16 + 4 + h] + fb));
#pragma unroll
        for (int o = 1; o < 64; o <<= 1) { const float t = shup(bcs, o, lane); if (lane >= o) bcs += t; }
        const float wl = (GT[tk * 16 + h] + ib) - bcs, bL = shidx(bcs, 63);
        ((LAS float*)(lds + ML_GB))[tk] = bcs; ((LAS float*)(lds + ML_GWL))[tk] = wl; ((LAS float*)(lds + ML_GEB))[tk] = __expf(bcs); ((LAS float*)(lds + ML_GWG))[tk] = __expf(bL + wl);
        if (lane == 0) ((LAS float*)(lds + ML_GG))[n] = __expf(bL);
    }
    const int srow = tid >> 3, c0 = (tid & 7) * 8;
    u32x4 qreg, kreg, vreg;
    { const bf16_t* rowp = U + (size_t)srow * NU + h * 64 + c0; qreg = *(const u32x4*)(rowp + U_MQ); kreg = *(const u32x4*)(rowp + U_MK); vreg = *(const u32x4*)(rowp + U_MV); }
    f32x16 cacc;
#pragma unroll
    for (int i = 0; i < 16; ++i) cacc[i] = 0.f;
    float n_d = 0.f;
    const int ti = w & 1, ei = (w >> 1) & 1;
    f32x16 hv; float rs_part = 0.f; u32x2 opre[4];
#pragma unroll
    for (int i = 0; i < 16; ++i) hv[i] = 0.f;
#pragma unroll
    for (int g = 0; g < 4; ++g) opre[g] = (u32x2){0u, 0u};
    const float* nw = P.in[7] + l * 256 + h * 64;
    __syncthreads();
    for (int n = 0; n <= SEQ / 64; ++n) {
        const int cb = n & 1;
        LAS unsigned char* sb = lds + cb * ML_STAGE;
        if (n < SEQ / 64) {
            const float wgt_row = ((const LAS float*)(lds + ML_GWG))[64 * n + srow];
            u32x4 ks; float kf[8];
#pragma unroll
            for (int x = 0; x < 4; ++x) { kf[2 * x] = __uint_as_float(kreg[x] << 16) * 0.125f; kf[2 * x + 1] = __uint_as_float(kreg[x] & 0xffff0000u) * 0.125f; ks[x] = (__float_as_uint(kf[2 * x]) >> 16) | (__float_as_uint(kf[2 * x + 1]) & 0xffff0000u); }
            *(LAS u32x4*)(sb + ML_K + (srow * ML_STR + c0) * 2) = ks;
            if ((n & 1) == par) *(LAS u32x4*)(sb + ML_Q + (srow * ML_STR + c0) * 2) = qreg;
            LAS bf16_t* vt = (LAS bf16_t*)(sb + ML_VT); LAS bf16_t* kwt = (LAS bf16_t*)(sb + ML_KWT);
#pragma unroll
            for (int x = 0; x < 4; ++x) { vt[(c0 + 2 * x) * ML_STR + srow] = (bf16_t)(vreg[x] & 0xffffu); vt[(c0 + 2 * x + 1) * ML_STR + srow] = (bf16_t)(vreg[x] >> 16);
                kwt[(c0 + 2 * x) * ML_STR + srow] = (bf16_t)f2bf(kf[2 * x] * wgt_row); kwt[(c0 + 2 * x + 1) * ML_STR + srow] = (bf16_t)f2bf(kf[2 * x + 1] * wgt_row); }
        }
        __syncthreads();
        if (n + 1 < SEQ / 64) { const bf16_t* rowp = U + (size_t)(64 * (n + 1) + srow) * NU + h * 64 + c0; qreg = *(const u32x4*)(rowp + U_MQ); kreg = *(const u32x4*)(rowp + U_MK); vreg = *(const u32x4*)(rowp + U_MV); }
        if (w < 4 && n > 0 && ((n - 1) & 1) == par) {
            const float tot = rs_part + ((const LAS float*)(lds + ML_SSQ))[(cb ^ 1) * 128 + (ti * 2 + (ei ^ 1)) * 32 + r];
            const float rs = rsqrtf(tot * (1.f / 64.f) + NORM_EPS);
            const size_t tok = (size_t)64 * (n - 1) + 32 * ti + r;
            bf16_t* yrow = WSP(bf16_t, WS_Y) + ((size_t)b * SEQ + tok) * D + h * 64;
#pragma unroll
            for (int g = 0; g < 4; ++g) { const int e0 = 32 * ei + 8 * g + 4 * hh; const f32x4 n4 = *(const f32x4*)(nw + e0); const u32x2 op = opre[g];
                const float o0 = sigmoidf_(__uint_as_float(op.x << 16)), o1 = sigmoidf_(__uint_as_float(op.x & 0xffff0000u)), o2 = sigmoidf_(__uint_as_float(op.y << 16)), o3 = sigmoidf_(__uint_as_float(op.y & 0xffff0000u));
                u32x2 y2; y2.x = cvt_pk_bf16(hv[4 * g] * rs * n4[0] * o0, hv[4 * g + 1] * rs * n4[1] * o1); y2.y = cvt_pk_bf16(hv[4 * g + 2] * rs * n4[2] * o2, hv[4 * g + 3] * rs * n4[3] * o3);
                *(u32x2*)(yrow + e0) = y2; }
        }
        if (n == SEQ / 64) break;
        if (w < 4) { if ((n & 1) == par) {
            { const size_t tokp = (size_t)64 * n + 32 * ti + r;
#pragma unroll
              for (int g = 0; g < 4; ++g) opre[g] = *(const u32x2*)(U + tokp * NU + U_MO + h * 64 + 32 * ei + 8 * g + 4 * hh); }
            const LAS float* gwl = (const LAS float*)(lds + ML_GWL) + 64 * n;
            const float bt = ((const LAS float*)(lds + ML_GB))[64 * n + 32 * ti + r], ebt = ((const LAS float*)(lds + ML_GEB))[64 * n + 32 * ti + r];
            bf16x8 qf[4];
#pragma unroll
            for (int kk = 0; kk < 4; ++kk) qf[kk] = *(const LAS bf16x8*)(sb + ML_Q + ((32 * ti + r) * ML_STR + 16 * kk + 8 * hh) * 2);
            f32x16 acc1, acc2;
#pragma unroll
            for (int i = 0; i < 16; ++i) { acc1[i] = 0.f; acc2[i] = 0.f; }
            float den = 0.f;
#pragma unroll
            for (int si = 0; si < 2; ++si) {
                if (si > ti) continue;
                f32x16 sacc;
#pragma unroll
                for (int i = 0; i < 16; ++i) sacc[i] = 0.f;
#pragma unroll
                for (int kk = 0; kk < 4; ++kk) { const bf16x8 kf = *(const LAS bf16x8*)(sb + ML_K + ((32 * si + r) * ML_STR + 16 * kk + 8 * hh) * 2); sacc = MFMA32(kf, qf[kk], sacc); }
                float pv[16];
#pragma unroll
                for (int g = 0; g < 4; ++g) { const f32x4 wl4 = *(const LAS f32x4*)(gwl + 32 * si + 8 * g + 4 * hh);
#pragma unroll
                    for (int x = 0; x < 4; ++x) { const int srow_i = 8 * g + 4 * hh + x; const bool keep = (si < ti) || (srow_i <= r);
                        const float pvv = keep ? sacc[4 * g + x] * __expf(bt + wl4[x]) : 0.f; pv[4 * g + x] = pvv; den += pvv; } }
#pragma unroll
                for (int s2 = 0; s2 < 2; ++s2) { u32x4 pk;
#pragma unroll
                    for (int x = 0; x < 4; ++x) pk[x] = cvt_pk_bf16(pv[8 * s2 + 2 * x], pv[8 * s2 + 2 * x + 1]);
                    const LAS bf16_t* vrow = (const LAS bf16_t*)(sb + ML_VT) + (32 * ei + r) * ML_STR + 32 * si + 16 * s2 + 4 * hh;
                    const u32x2 lo = *(const LAS u32x2*)vrow, hi = *(const LAS u32x2*)(vrow + 8);
                    u32x4 vv; vv.x = lo.x; vv.y = lo.y; vv.z = hi.x; vv.w = hi.y;
                    acc1 = MFMA32(__builtin_bit_cast(bf16x8, vv), __builtin_bit_cast(bf16x8, pk), acc1); }
            }
#pragma unroll
            for (int kk = 0; kk < 4; ++kk) { const bf16x8 cf = *(const LAS bf16x8*)(lds + ML_CT + cb * ML_MAT + ((32 * ei + r) * ML_STR + 16 * kk + 8 * hh) * 2); acc2 = MFMA32(cf, qf[kk], acc2); }
            float qn = 0.f;
            { const LAS float* nv = (const LAS float*)(lds + ML_N + cb * 256);
#pragma unroll
              for (int kk = 0; kk < 4; ++kk) { const u32x4 qq = *(const LAS u32x4*)(sb + ML_Q + ((32 * ti + r) * ML_STR + 32 * hh + 8 * kk) * 2);
                  const f32x4 n0 = *(const LAS f32x4*)(nv + 32 * hh + 8 * kk), n1 = *(const LAS f32x4*)(nv + 32 * hh + 8 * kk + 4);
                  qn += __uint_as_float(qq[0] << 16) * n0[0] + __uint_as_float(qq[0] & 0xffff0000u) * n0[1] + __uint_as_float(qq[1] << 16) * n0[2] + __uint_as_float(qq[1] & 0xffff0000u) * n0[3]
                      + __uint_as_float(qq[2] << 16) * n1[0] + __uint_as_float(qq[2] & 0xffff0000u) * n1[1] + __uint_as_float(qq[3] << 16) * n1[2] + __uint_as_float(qq[3] & 0xffff0000u) * n1[3]; } }
            den += ebt * qn;
            den += shx32(den, lane);
            const float dinv = __builtin_amdgcn_rcpf(fmaxf(fabsf(den), 1.0f));
            rs_part = 0.f;
#pragma unroll
            for (int i = 0; i < 16; ++i) { hv[i] = (acc1[i] + ebt * acc2[i]) * dinv; rs_part += hv[i] * hv[i]; }
            rs_part += shx32(rs_part, lane);
            if (hh == 0) ((LAS float*)(lds + ML_SSQ))[cb * 128 + (ti * 2 + ei) * 32 + r] = rs_part;
        } } else {
            const int di = w & 1; const float G = ((const LAS float*)(lds + ML_GG))[n];
#pragma unroll
            for (int i = 0; i < 16; ++i) cacc[i] *= G;
#pragma unroll
            for (int kk = 0; kk < 4; ++kk) { const bf16x8 vf = *(const LAS bf16x8*)(sb + ML_VT + ((32 * ei + r) * ML_STR + 16 * kk + 8 * hh) * 2);
                const bf16x8 kf = *(const LAS bf16x8*)(sb + ML_KWT + ((32 * di + r) * ML_STR + 16 * kk + 8 * hh) * 2); cacc = MFMA32(vf, kf, cacc); }
            LAS bf16_t* ct = (LAS bf16_t*)(lds + ML_CT + (cb ^ 1) * ML_MAT);
#pragma unroll
            for (int i = 0; i < 16; ++i) ct[(32 * ei + (i & 3) + 8 * (i >> 2) + 4 * hh) * ML_STR + 32 * di + r] = (bf16_t)f2bf(cacc[i]);
            if (w == 4) { float sum = 0.f;
#pragma unroll
                for (int kk = 0; kk < 8; ++kk) { const u32x4 kk4 = *(const LAS u32x4*)(sb + ML_KWT + (lane * ML_STR + 8 * kk) * 2);
#pragma unroll
                    for (int x = 0; x < 4; ++x) sum += __uint_as_float(kk4[x] << 16) + __uint_as_float(kk4[x] & 0xffff0000u); }
                n_d = G * n_d + sum; ((LAS float*)(lds + ML_N + (cb ^ 1) * 256))[lane] = n_d; }
        }
    }
    __syncthreads();
}
constexpr int GP_W = 0, GP_QD = 16384, GP_KDT = 32768, GP_QK = 49152, GP_U = 57344, GP_CD = 73728, GP_CHUNK = 74752;
constexpr size_t WS_GP = WS_GQ;
static_assert((size_t)1024 * GP_CHUNK <= 96 * MiB, "GDN prep buffer");
constexpr int PL_KSTR = 136, PL_KN = 0, PL_QN = 17408, PL_RHS = 34816, PL_RSTR = 260, PL_M = 101376, PL_MSTR = 72  , PL_QK = 118784, PL_QKSTR = 72, PL_WC = 128000, PL_GATE = 134144, PL_UWSTR = 264;
__device__ __forceinline__ unsigned bfmul2(unsigned pk, float a) { return cvt_pk_bf16(__uint_as_float(pk << 16) * a, __uint_as_float(pk & 0xffff0000u) * a); }
__device__ __forceinline__ void gdn_prep_unit(const Params& P, const Ctx& C, int l, int b, int h, int n) {
    LAS unsigned char* lds = C.lds;
    int tid_ = C.tid; asm volatile("" : "+v"(tid_));
    const int tid = tid_, w = __builtin_amdgcn_readfirstlane(tid >> 6), lane = tid & 63, r = lane & 31, hh = lane >> 5;
    const bf16_t* U = WSP(bf16_t, WS_U16) + (size_t)b * SEQ * NU; const float* GT = WSP(float, WS_GT) + (size_t)b * SEQ * 16;
    unsigned char* outp = P.ws + WS_GP + (size_t)((b * 4 + h) * 32 + n) * GP_CHUNK;
    const int t0 = 64 * n;
    { const float* cw = P.in[9] + (size_t)l * 4 * 1536; LAS float* wc = (LAS float*)(lds + PL_WC);
      for (int idx = tid; idx < 1536; idx += NTHREADS) { const int j = idx / 384, rem = idx - j * 384, p = rem >> 7, cc = rem & 127; wc[idx] = cw[j * 1536 + p * 512 + h * 128 + cc]; } }
    float beta_l, gam_l, gamL;
    { const float A = __expf(P.in[10][l * 4 + h]), dtb = P.in[11][l * 4 + h];
      const float ga = GT[(size_t)(t0 + lane) * 16 + 8 + h], gb = GT[(size_t)(t0 + lane) * 16 + 12 + h];
      float g = -A * softplusf_(ga + dtb);
#pragma unroll
      for (int o = 1; o < 64; o <<= 1) { const float t = shup(g, o, lane); if (lane >= o) g += t; }
      gam_l = g; beta_l = sigmoidf_(gb); gamL = shidx(g, 63);
      if (w == 0) { LAS float* gt = (LAS float*)(lds + PL_GATE); gt[lane] = gam_l; gt[64 + lane] = beta_l; gt[128 + lane] = __expf(gam_l); gt[192 + lane] = __expf(gamL - gam_l); } }
    __syncthreads();
    { const int t = tid >> 3, cg = tid & 7;
      const float beta_t = shidx(beta_l, t), gam_t = shidx(gam_l, t);
      float acc[3][16];
#pragma unroll
      for (int p = 0; p < 3; ++p)
#pragma unroll
          for (int c = 0; c < 16; ++c) acc[p][c] = 0.f;
      const LAS float* wc = (const LAS float*)(lds + PL_WC);
#pragma unroll
      for (int j = 0; j < 4; ++j) { const int ts = t0 + t - 3 + j;
          if (ts >= 0) {
#pragma unroll
              for (int p = 0; p < 3; ++p) { const bf16_t* src = U + (size_t)ts * NU + U_GQ + p * 512 + h * 128 + 16 * cg; const u32x4 x0 = *(const u32x4*)src, x1 = *(const u32x4*)(src + 8);
                  const LAS float* wp = wc + j * 384 + p * 128 + 16 * cg;
#pragma unroll
                  for (int c4 = 0; c4 < 4; ++c4) { const f32x4 w4 = *(const LAS f32x4*)(wp + 4 * c4); const unsigned xa = c4 < 2 ? x0[2 * c4] : x1[2 * c4 - 4], xb = c4 < 2 ? x0[2 * c4 + 1] : x1[2 * c4 - 3];
                      acc[p][4 * c4] += w4[0] * __uint_as_float(xa << 16); acc[p][4 * c4 + 1] += w4[1] * __uint_as_float(xa & 0xffff0000u);
                      acc[p][4 * c4 + 2] += w4[2] * __uint_as_float(xb << 16); acc[p][4 * c4 + 3] += w4[3] * __uint_as_float(xb & 0xffff0000u); } } } }
      float ssq = 0.f, ssk = 0.f;
#pragma unroll
      for (int c = 0; c < 16; ++c) { acc[0][c] = siluf_(acc[0][c]); acc[1][c] = siluf_(acc[1][c]); acc[2][c] = siluf_(acc[2][c]); ssq += acc[0][c] * acc[0][c]; ssk += acc[1][c] * acc[1][c]; }
      { const int ln = lane_id_opaque();
#pragma unroll
        for (int o = 1; o < 8; o <<= 1) { ssq += shx(ssq, o, ln); ssk += shx(ssk, o, ln); } }
      const float scq = rsqrtf(ssq + NORM_EPS) * 0.08838834764831845f, sck = rsqrtf(ssk + NORM_EPS), bw = beta_t * __expf(gam_t);
      u32x4 qa, qb, ka, kb;
#pragma unroll
      for (int x = 0; x < 4; ++x) { qa[x] = cvt_pk_bf16(acc[0][2 * x] * scq, acc[0][2 * x + 1] * scq); qb[x] = cvt_pk_bf16(acc[0][8 + 2 * x] * scq, acc[0][9 + 2 * x] * scq);
                                     ka[x] = cvt_pk_bf16(acc[1][2 * x] * sck, acc[1][2 * x + 1] * sck); kb[x] = cvt_pk_bf16(acc[1][8 + 2 * x] * sck, acc[1][9 + 2 * x] * sck); }
      *(LAS u32x4*)(lds + PL_QN + (t * PL_KSTR + 16 * cg) * 2) = qa; *(LAS u32x4*)(lds + PL_QN + (t * PL_KSTR + 16 * cg + 8) * 2) = qb;
      *(LAS u32x4*)(lds + PL_KN + (t * PL_KSTR + 16 * cg) * 2) = ka; *(LAS u32x4*)(lds + PL_KN + (t * PL_KSTR + 16 * cg + 8) * 2) = kb;
      LAS float* rhs = (LAS float*)(lds + PL_RHS) + t * PL_RSTR;
#pragma unroll
      for (int c4 = 0; c4 < 4; ++c4) { f32x4 rv, rk;
#pragma unroll
          for (int x = 0; x < 4; ++x) { rv[x] = beta_t * acc[2][4 * c4 + x]; rk[x] = bw * sck * acc[1][4 * c4 + x]; }
          *(LAS f32x4*)(rhs + 16 * cg + 4 * c4) = rv; *(LAS f32x4*)(rhs + 128 + 16 * cg + 4 * c4) = rk; } }
    __syncthreads();
    { const int p = w >> 2, ti = (w >> 1) & 1, si = w & 1;
      const LAS float* gt = (const LAS float*)(lds + PL_GATE);
      if (si <= ti) {
          f32x16 acc;
#pragma unroll
          for (int i = 0; i < 16; ++i) acc[i] = 0.f;
#pragma unroll
          for (int kk = 0; kk < 8; ++kk) { const bf16x8 af = *(const LAS bf16x8*)(lds + (p ? PL_QN : PL_KN) + ((32 * ti + r) * PL_KSTR + 16 * kk + 8 * hh) * 2);
              const bf16x8 bf = *(const LAS bf16x8*)(lds + PL_KN + ((32 * si + r) * PL_KSTR + 16 * kk + 8 * hh) * 2); acc = MFMA32(af, bf, acc); }
          const float gam_s = gt[32 * si + r];
#pragma unroll
          for (int g = 0; g < 4; ++g) { const f32x4 gt4 = *(const LAS f32x4*)(gt + 32 * ti + 8 * g + 4 * hh), bt4 = *(const LAS f32x4*)(gt + 64 + 32 * ti + 8 * g + 4 * hh);
#pragma unroll
              for (int x = 0; x < 4; ++x) { const int trow = 8 * g + 4 * hh + x; const float dec = __expf(fminf(gt4[x] - gam_s, 0.f)) * acc[4 * g + x];
                  if (p == 0) { const bool keep = (si < ti) || (r < trow); ((LAS _Float16*)(lds + PL_M))[(32 * ti + trow) * PL_MSTR + 32 * si + r] = (_Float16)(keep ? bt4[x] * dec : 0.f); }
                  else { const bool keep = (si < ti) || (r <= trow); ((LAS bf16_t*)(lds + PL_QK))[(32 * ti + trow) * PL_QKSTR + 32 * si + r] = (bf16_t)f2bf(keep ? dec : 0.f); } } }
      } else if (p == 1) {
#pragma unroll
          for (int i = 0; i < 16; ++i) ((LAS bf16_t*)(lds + PL_QK))[(32 * ti + (i & 3) + 8 * (i >> 2) + 4 * hh) * PL_QKSTR + 32 * si + r] = (bf16_t)0;
      } }
    __syncthreads();
    float xs[64];
    if (w < 4) {
        int vz = 0; asm volatile("" : "+v"(vz));
        typedef _Float16 f16x8 __attribute__((ext_vector_type(8)));
        const LAS float* rhs = (const LAS float*)(lds + PL_RHS) + tid; const LAS _Float16* Mh = (const LAS _Float16*)(lds + PL_M) + vz;
#pragma clang loop unroll(full)
        for (int t = 0; t < 64; ++t) { float a = rhs[t * PL_RSTR];
            const LAS _Float16* Mrow = Mh + t * PL_MSTR;
#pragma clang loop unroll(full)
            for (int s8 = 0; s8 < (t + 7) / 8; ++s8) { const f16x8 m8 = *(const LAS f16x8*)(Mrow + 8 * s8);
#pragma unroll
                for (int x = 0; x < 8; ++x) if (8 * s8 + x < t) a -= (float)m8[x] * xs[8 * s8 + x]; }
            xs[t] = a; }
    } else {
        const LAS float* gt = (const LAS float*)(lds + PL_GATE);
        for (int it = w - 4; it < 40; it += 4) {
            u32x4 o;
            if (it < 16) { const int ti = it >> 3, kk = it & 7; const u32x4 q = *(const LAS u32x4*)(lds + PL_QN + ((32 * ti + r) * PL_KSTR + 16 * kk + 8 * hh) * 2); const float eg = gt[128 + 32 * ti + r];
#pragma unroll
                for (int x = 0; x < 4; ++x) o[x] = bfmul2(q[x], eg);
                *(u32x4*)(outp + GP_QD + (size_t)((ti * 8 + kk) * 64 + lane) * 16) = o;
            } else if (it < 32) { const int dt = (it - 16) >> 2, ks = (it - 16) & 3; const LAS bf16_t* kn = (const LAS bf16_t*)(lds + PL_KN) + 32 * dt + r;
#pragma unroll
                for (int x = 0; x < 4; ++x) { const int ta = 16 * ks + 8 * ((2 * x) >> 2) + 4 * hh + ((2 * x) & 3), tb = ta + 1;
                    o[x] = cvt_pk_bf16(bf2f(kn[ta * PL_KSTR]) * gt[192 + ta], bf2f(kn[tb * PL_KSTR]) * gt[192 + tb]); }
                *(u32x4*)(outp + GP_KDT + (size_t)((dt * 4 + ks) * 64 + lane) * 16) = o;
            } else { const int ti = (it - 32) >> 2, ks = (it - 32) & 3; const LAS bf16_t* qrow = (const LAS bf16_t*)(lds + PL_QK) + (32 * ti + r) * PL_QKSTR + 16 * ks + 4 * hh;
                const u32x2 lo = *(const LAS u32x2*)qrow, hi = *(const LAS u32x2*)(qrow + 8); o.x = lo.x; o.y = lo.y; o.z = hi.x; o.w = hi.y;
                *(u32x4*)(outp + GP_QK + (size_t)((ti * 4 + ks) * 64 + lane) * 16) = o; }
        }
    }
    __syncthreads();
    if (w < 4) { LAS bf16_t* uw = (LAS bf16_t*)(lds + PL_RHS) + tid;
#pragma unroll
        for (int t = 0; t < 64; ++t) uw[t * PL_UWSTR] = (bf16_t)f2bf(xs[t]); }
    __syncthreads();
    { const LAS bf16_t* uw = (const LAS bf16_t*)(lds + PL_RHS);
      for (int it = w; it < 24; it += 8) {
          if (it < 16) { const int ti = it >> 3, kk = it & 7; const u32x4 o = *(const LAS u32x4*)(uw + (32 * ti + r) * PL_UWSTR + 128 + 16 * kk + 8 * hh);
              *(u32x4*)(outp + GP_W + (size_t)((ti * 8 + kk) * 64 + lane) * 16) = o;
          } else { const int ti = (it - 16) >> 2, es = (it - 16) & 3; u32x4 o0, o1;
#pragma unroll
              for (int x = 0; x < 8; ++x) { const int ia = 2 * x, ib = 2 * x + 1; const int ta = 32 * ti + (ia & 3) + 8 * (ia >> 2) + 4 * hh, tb = 32 * ti + (ib & 3) + 8 * (ib >> 2) + 4 * hh;
                  const unsigned v = (unsigned)uw[ta * PL_UWSTR + 32 * es + r] | ((unsigned)uw[tb * PL_UWSTR + 32 * es + r] << 16); if (x < 4) o0[x] = v; else o1[x - 4] = v; }
              unsigned char* dst = outp + GP_U + (size_t)((ti * 4 + es) * 64 + lane) * 32; *(u32x4*)dst = o0; *(u32x4*)(dst + 16) = o1; }
      }
      if (tid == 0) *(float*)(outp + GP_CD) = __expf(gamL); }
    __syncthreads();
}
__device__ __forceinline__ void phase_gprep2(const Params& P, const Ctx& C, int l) {
    { int* slot_tok = (int*)(P.ws + WS_RT + RT_SLOTTOK); for (int i = C.bid * NTHREADS + C.tid; i < PSLOTS; i += C.G * NTHREADS) slot_tok[i] = -1; }
    for (int u = C.bid; u < 1024; u += C.G) gdn_prep_unit(P, C, l, u >> 7, (u >> 5) & 3, u & 31);
}
constexpr int GS_SLOT = 61440, GS_ST = 2 * GS_SLOT, GS_STSTR = 136, GS_STBYTES = 32 * GS_STSTR * 2;
__device__ __forceinline__ void gdn_scan_unit(const Params& P, const Ctx& C, int l, int b, int h, int es) {
    LAS unsigned char* lds = C.lds;
    const int tid = C.tid, w = C.wave, lane = C.lane, r = lane & 31, hh = lane >> 5;
    const unsigned char* gp = P.ws + WS_GP + (size_t)((b * 4 + h) * 32) * GP_CHUNK;
    float* O = WSP(float, WS_GO) + (size_t)b * SEQ * 512 + h * 128 + 32 * es;
    for (int i = tid; i < 2 * GS_STBYTES / 4; i += NTHREADS) ((LAS unsigned*)(lds + GS_ST))[i] = 0u;
#define GS_ISSUE(nn) do { const unsigned char* src = gp + (size_t)(nn) * GP_CHUNK; LAS unsigned char* dst = lds + ((nn) & 1) * GS_SLOT; \
        for (int p = w; p < 60; p += 8) { const size_t go = p < 56 ? (size_t)p * 1024 : (size_t)GP_U + (size_t)(((p - 56) >> 1) * 4 + es) * 2048 + (size_t)((p - 56) & 1) * 1024; \
            __builtin_amdgcn_global_load_lds((const unsigned*)(src + go + lane * 16), (LAS unsigned*)(dst + p * 1024), 16, 0, 0); } } while (0)
    GS_ISSUE(0);
    float cd_next = *(const float*)(gp + GP_CD);
    f32x16 sacc;
#pragma unroll
    for (int i = 0; i < 16; ++i) sacc[i] = 0.f;
    asm volatile("s_waitcnt vmcnt(0)" ::: "memory");
    __syncthreads();
    for (int n = 0; n < 32; ++n) {
        const float cd = cd_next;
        if (n + 1 < 32) { GS_ISSUE(n + 1); cd_next = *(const float*)(gp + (size_t)(n + 1) * GP_CHUNK + GP_CD); }
        const LAS unsigned char* slot = lds + (n & 1) * GS_SLOT;
        const LAS unsigned char* stc = lds + GS_ST + (n & 1) * GS_STBYTES;
        if (w < 6) {
            f32x16 xa[2];
#pragma unroll
            for (int i = 0; i < 16; ++i) { xa[0][i] = 0.f; xa[1][i] = 0.f; }
            bf16x8 sf[8];
#pragma unroll
            for (int kk = 0; kk < 8; ++kk) sf[kk] = *(const LAS bf16x8*)(stc + (r * GS_STSTR + 16 * kk + 8 * hh) * 2);
#pragma unroll
            for (int ti = 0; ti < 2; ++ti)
#pragma unroll
                for (int kk = 0; kk < 8; ++kk) { const bf16x8 wf = *(const LAS bf16x8*)(slot + GP_W + ((ti * 8 + kk) * 64 + lane) * 16); xa[ti] = MFMA32(wf, sf[kk], xa[ti]); }
            bf16x8 pf[2][2];
#pragma unroll
            for (int ti = 0; ti < 2; ++ti) { const u32x4 u0 = *(const LAS u32x4*)(slot + GP_U + ti * 2048 + lane * 32), u1 = *(const LAS u32x4*)(slot + GP_U + ti * 2048 + lane * 32 + 16);
#pragma unroll
                for (int s2 = 0; s2 < 2; ++s2) { const u32x4 uu = s2 ? u1 : u0; u32x4 pk;
#pragma unroll
                    for (int x = 0; x < 4; ++x) pk[x] = cvt_pk_bf16(__uint_as_float(uu[x] << 16) - xa[ti][8 * s2 + 2 * x], __uint_as_float(uu[x] & 0xffff0000u) - xa[ti][8 * s2 + 2 * x + 1]);
                    pf[ti][s2] = __builtin_bit_cast(bf16x8, pk); } }
            if (w < 4) {
#pragma unroll
                for (int i = 0; i < 16; ++i) sacc[i] *= cd;
#pragma unroll
                for (int ks = 0; ks < 4; ++ks) { const bf16x8 kf = *(const LAS bf16x8*)(slot + GP_KDT + ((w * 4 + ks) * 64 + lane) * 16); sacc = MFMA32(kf, pf[ks >> 1][ks & 1], sacc); }
                LAS unsigned char* stn = lds + GS_ST + ((n + 1) & 1) * GS_STBYTES;
#pragma unroll
                for (int g = 0; g < 4; ++g) { u32x2 o2; o2.x = cvt_pk_bf16(sacc[4 * g], sacc[4 * g + 1]); o2.y = cvt_pk_bf16(sacc[4 * g + 2], sacc[4 * g + 3]);
                    *(LAS u32x2*)(stn + (r * GS_STSTR + 32 * w + 8 * g + 4 * hh) * 2) = o2; }
            } else {
                const int ti = w - 4;
                f32x16 oa;
#pragma unroll
                for (int i = 0; i < 16; ++i) oa[i] = 0.f;
#pragma unroll
                for (int kk = 0; kk < 8; ++kk) { const bf16x8 qf = *(const LAS bf16x8*)(slot + GP_QD + ((ti * 8 + kk) * 64 + lane) * 16); oa = MFMA32(qf, sf[kk], oa); }
#pragma unroll
                for (int ks = 0; ks < 4; ++ks) { if ((ks >> 1) > ti) continue; const bf16x8 qf = *(const LAS bf16x8*)(slot + GP_QK + ((ti * 4 + ks) * 64 + lane) * 16); oa = MFMA32(qf, pf[ks >> 1][ks & 1], oa); }
                float* orow = O + (size_t)(64 * n + 32 * ti) * 512 + r;
#pragma unroll
                for (int i = 0; i < 16; ++i) orow[(size_t)((i & 3) + 8 * (i >> 2) + 4 * hh) * 512] = oa[i];
            }
        }
        asm volatile("s_waitcnt vmcnt(0)" ::: "memory");
        __syncthreads();
    }
#undef GS_ISSUE
}
__device__ __forceinline__ void phase_mix(const Params& P, const Ctx& C, int l, int rep) {
#ifndef MIX_SEL
#define MIX_SEL 7
#endif
    const int sel = rep ? MIX_SEL : 7;
    if (C.bid < 128) { if (sel & 1) { const int j = C.bid >> 3, bh = (j >> 2) * 8 + (C.bid & 7); gdn_scan_unit(P, C, l, bh >> 2, bh & 3, j & 3); } }
    else if (C.bid < 192) { if (sel & 2) { const int q = C.bid - 128, j = q >> 3, bh = (j >> 1) * 8 + (q & 7); mlstm_unit(P, C, l, bh >> 2, bh & 3, j & 1); } }
    if (!(sel & 4)) return;
    LAS int* qslot = (LAS int*)(C.lds + LDS_MISC + 32);
    for (;;) {
        if (C.tid == 0) *qslot = (int)atomicAdd(ctl_words(P) + CW_SBQ + (l + 4 * rep) * 64, 1u);
        __syncthreads();
        const int u = *qslot;
        __syncthreads();
        if (u >= 256) break;
        sb_unit(P, C, l, (u & 31) >> 2, u & 3, 7 - (u >> 5));
    }
}
__device__ __forceinline__ void phase_gpost(const Params& P, const Ctx& C, int l) {
    const float* O = WSP(float, WS_GO); const bf16_t* U = WSP(bf16_t, WS_U16); bf16_t* Y = WSP(bf16_t, WS_Y); const float* nw = P.in[12] + l * 128 + (C.lane & 15) * 8;
    const int gw = C.bid * NWAVES + C.wave, NGW = C.G * NWAVES, lane = C.lane;
    const f32x4 n0 = *(const f32x4*)nw, n1 = *(const f32x4*)(nw + 4);
    for (int tok0 = gw; tok0 < T; tok0 += 4 * NGW) {
        f32x4 a[4], b[4]; u32x4 z[4];
#pragma unroll
        for (int k = 0; k < 4; ++k) { const int tok = tok0 + k * NGW; if (tok < T) { a[k] = *(const f32x4*)(O + (size_t)tok * 512 + lane * 8); b[k] = *(const f32x4*)(O + (size_t)tok * 512 + lane * 8 + 4); z[k] = *(const u32x4*)(U + (size_t)tok * NU + U_GZ + lane * 8); } }
#pragma unroll
        for (int k = 0; k < 4; ++k) { const int tok = tok0 + k * NGW; if (tok < T) {
            float ss = (a[k][0] * a[k][0] + a[k][1] * a[k][1]) + (a[k][2] * a[k][2] + a[k][3] * a[k][3]) + (b[k][0] * b[k][0] + b[k][1] * b[k][1]) + (b[k][2] * b[k][2] + b[k][3] * b[k][3]);
            { const int ln = lane_id_opaque();
#pragma unroll
              for (int o = 1; o < 16; o <<= 1) ss += shx(ss, o, ln); }
            const float sc = rsqrtf(ss * (1.f / 128.f) + NORM_EPS);
            u32x4 o;
            o.x = cvt_pk_bf16(a[k][0] * sc * n0[0] * siluf_(__uint_as_float(z[k].x << 16)), a[k][1] * sc * n0[1] * siluf_(__uint_as_float(z[k].x & 0xffff0000u)));
            o.y = cvt_pk_bf16(a[k][2] * sc * n0[2] * siluf_(__uint_as_float(z[k].y << 16)), a[k][3] * sc * n0[3] * siluf_(__uint_as_float(z[k].y & 0xffff0000u)));
            o.z = cvt_pk_bf16(b[k][0] * sc * n1[0] * siluf_(__uint_as_float(z[k].z << 16)), b[k][1] * sc * n1[1] * siluf_(__uint_as_float(z[k].z & 0xffff0000u)));
            o.w = cvt_pk_bf16(b[k][2] * sc * n1[2] * siluf_(__uint_as_float(z[k].w << 16)), b[k][3] * sc * n1[3] * siluf_(__uint_as_float(z[k].w & 0xffff0000u)));
            *(u32x4*)(Y + (size_t)tok * D + 512 + lane * 8) = o; } }
    }
}
__device__ __forceinline__ void phase_outproj(const Params& P, const Ctx& C, int l) {
    DenseOrder S; S.init(T, D, D, P.ws + WS_W + (size_t)l * W_LAYER + W_OUT, C.G, C.bid);
    EpiB16<0> E{WSP(bf16_t, WS_TMP), D, nullptr};
    gemm_phase(C.lds, C.tid, (const char*)(P.ws + WS_Y), D, S, E);
}
__device__ __forceinline__ void phase_ln1(const Params& P, const Ctx& C, int l, int rep) {
    const int gw = C.bid * NWAVES + C.wave, NGW = C.G * NWAVES, lane = C.lane;
    const bf16_t* HB = WSP(bf16_t, WS_HB); const bf16_t* TMP = WSP(bf16_t, WS_TMP);
    const float* wr = P.in[16] + (size_t)l * D * NE; const float* br = P.in[17] + l * NE;
    const float* g = P.in[14] + l * D; const float* bb = P.in[15] + l * D;
    int* top_idx = (int*)(P.ws + WS_RT + RT_TOPIDX); float* top_gate = (float*)(P.ws + WS_RT + RT_TOPGATE);
    LAS float* xs = (LAS float*)(C.lds + C.wave * 16384);
    const int e_me = lane & 31, half = lane >> 5;
    LAS unsigned* hist = (LAS unsigned*)(C.lds + LDS_TAB);
    if (C.tid < NE) hist[C.tid] = 0u;
    __syncthreads();
    for (int gi = gw; gi < T / 4; gi += NGW) {
        u32x2 hbr[4][4], tbr[4][4];
#pragma unroll
        for (int rr = 0; rr < 4; ++rr)
#pragma unroll
            for (int j = 0; j < 4; ++j) { hbr[rr][j] = *(const u32x2*)(HB + (size_t)(4 * gi + rr) * D + 4 * lane + 256 * j); tbr[rr][j] = *(const u32x2*)(TMP + (size_t)(4 * gi + rr) * D + 4 * lane + 256 * j); }
#pragma unroll
        for (int rr = 0; rr < 4; ++rr) {
            const int row = 4 * gi + rr;
            float v[16]; float s = 0.f;
#pragma unroll
            for (int j = 0; j < 4; ++j) { const u32x2 hb = hbr[rr][j]; const u32x2 tb = tbr[rr][j]; const float t[4] = {__uint_as_float(tb.x << 16), __uint_as_float(tb.x & 0xffff0000u), __uint_as_float(tb.y << 16), __uint_as_float(tb.y & 0xffff0000u)};
                const float a[4] = {__uint_as_float(hb.x << 16), __uint_as_float(hb.x & 0xffff0000u), __uint_as_float(hb.y << 16), __uint_as_float(hb.y & 0xffff0000u)};
#pragma unroll
                for (int x = 0; x < 4; ++x) { v[4 * j + x] = ALPHA * a[x] + t[x]; s += v[4 * j + x]; } }
            const float mean = wave_sum(s) * (1.f / D); float q = 0.f;
#pragma unroll
            for (int i = 0; i < 16; ++i) { v[i] -= mean; q += v[i] * v[i]; }
            const float rstd = rsqrtf(wave_sum(q) * (1.f / D) + LN_EPS);
#pragma unroll
            for (int j = 0; j < 4; ++j) { const int c = 4 * lane + 256 * j; const f32x4 gg = *(const f32x4*)(g + c), b4 = *(const f32x4*)(bb + c);
                f32x4 o;
#pragma unroll
                for (int x = 0; x < 4; ++x) o[x] = v[4 * j + x] * rstd * gg[x] + b4[x];
                u32x2 w; w.x = pk2(o[0], o[1]); w.y = pk2(o[2], o[3]); *(u32x2*)(WSP(bf16_t, WS_H1B) + (size_t)row * D + c) = w;
                *(LAS f32x4*)(xs + rr * 1024 + c) = o; }
        }
        float acc[4] = {0.f, 0.f, 0.f, 0.f};
        { const float* wp = wr + (size_t)(half * 512) * NE + e_me; const LAS float* xp = xs + half * 512;
#pragma unroll 8
          for (int k = 0; k < 512; k += 4) { const float w0 = wp[(size_t)k * NE], w1 = wp[(size_t)(k + 1) * NE], w2 = wp[(size_t)(k + 2) * NE], w3 = wp[(size_t)(k + 3) * NE];
#pragma unroll
              for (int rr = 0; rr < 4; ++rr) { const f32x4 x4 = *(const LAS f32x4*)(xp + rr * 1024 + k); acc[rr] += (x4[0] * w0 + x4[1] * w1) + (x4[2] * w2 + x4[3] * w3); } } }
        const float bias = br[e_me];
#pragma unroll
        for (int rr = 0; rr < 4; ++rr) {
            const int row = 4 * gi + rr;
            float logit = acc[rr] + shx(acc[rr], 32, lane) + bias;
            float vals[4]; int ids[4];
#pragma unroll
            for (int r = 0; r < 4; ++r) {
                float bv = logit; int bi = e_me;
#pragma unroll
                for (int o = 16; o >= 1; o >>= 1) { const float ov = shx(bv, o, lane); const int oi = shxi(bi, o, lane); if (ov > bv || (ov == bv && oi < bi)) { bv = ov; bi = oi; } }
                vals[r] = bv; ids[r] = bi; if (e_me == bi) logit = -INFINITY;
            }
            float ex[4], se = 0.f;
#pragma unroll
            for (int r = 0; r < 4; ++r) { ex[r] = __expf(vals[r] - vals[0]); se += ex[r]; }
            if (lane == 0) {
#pragma unroll
                for (int r = 0; r < 4; ++r) { top_idx[row * 4 + r] = ids[r]; top_gate[row * 4 + r] = ex[r] * __builtin_amdgcn_rcpf(se); __hip_atomic_fetch_add(&hist[ids[r]], 1u, __ATOMIC_RELAXED, __HIP_MEMORY_SCOPE_WORKGROUP); }
            }
        }
    }
    __syncthreads();
    if (C.tid < NE) ((unsigned*)(P.ws + WS_RT + RT_WGCNT))[(size_t)rep * 256 * NE + C.bid * NE + C.tid] = hist[C.tid];
}
__device__ __forceinline__ void phase_scatter(const Params& P, const Ctx& C, int l, int rep) {
    LAS int* pad_start = (LAS int*)(C.lds + LDS_TAB);
    LAS unsigned* cur = (LAS unsigned*)(C.lds + LDS_TAB + 256);
    LAS unsigned* ptot = (LAS unsigned*)(C.lds + LDS_TAB + 512);
    LAS unsigned* ppre = (LAS unsigned*)(C.lds + LDS_TAB + 512 + 2048);
    const unsigned* wgcnt = (const unsigned*)(P.ws + WS_RT + RT_WGCNT);
    { const int e = C.tid & 31, part = C.tid >> 5; unsigned st = 0, sp = 0;
      unsigned cv[16];
#pragma unroll
      for (int i = 0; i < 16; ++i) { const int wb = part * 16 + i; cv[i] = wb < C.G ? wgcnt[wb * NE + e] : 0u; }
#pragma unroll
      for (int i = 0; i < 16; ++i) { const int wb = part * 16 + i; st += cv[i]; if (wb < C.bid) sp += cv[i]; }
      ptot[part * 32 + e] = st; ppre[part * 32 + e] = sp; }
    __syncthreads();
    if (C.tid < NE) { unsigned st = 0, sp = 0; for (int p = 0; p < 16; ++p) { st += ptot[p * 32 + C.tid]; sp += ppre[p * 32 + C.tid]; } ptot[C.tid] = st; ppre[C.tid] = sp; }
    __syncthreads();
    if (C.tid == 0) { int acc = 0; for (int e = 0; e < NE; ++e) { pad_start[e] = acc; cur[e] = (unsigned)acc + ppre[e]; acc += ((int)ptot[e] + MOEB - 1) / MOEB * MOEB; } pad_start[NE] = acc; }
    __syncthreads();
    const int* top_idx = (const int*)(P.ws + WS_RT + RT_TOPIDX); const float* top_gate = (const float*)(P.ws + WS_RT + RT_TOPGATE);
    int* tok_slot = (int*)(P.ws + WS_RT + RT_TOKSLOT); int* slot_tok = (int*)(P.ws + WS_RT + RT_SLOTTOK); float* slot_gate = (float*)(P.ws + WS_RT + RT_SLOTGATE);
    { const int gw = C.bid * NWAVES + C.wave, NGW = C.G * NWAVES;
      for (int gi = gw; gi < T / 4; gi += NGW) if (C.lane < 16) { const int a = 16 * gi + C.lane;
          const int e = top_idx[a]; const int slot = (int)__hip_atomic_fetch_add(&cur[e], 1u, __ATOMIC_RELAXED, __HIP_MEMORY_SCOPE_WORKGROUP);
          slot_tok[slot] = a >> 2; slot_gate[slot] = top_gate[a]; tok_slot[a] = slot; } }
    if (C.bid == 0) { int* block_e = (int*)(P.ws + WS_RT + RT_BLOCKE);
        for (int nb = C.tid; nb < NBLK; nb += NTHREADS) { int c = 0; for (int e = 0; e < NE; ++e) c += (pad_start[e + 1] <= nb * MOEB) ? 1 : 0; block_e[nb] = c < NE - 1 ? c : NE - 1; }
        if (C.tid == 0) block_e[NBLK] = pad_start[NE] / MOEB; }
    __syncthreads();
    DenseOrder S; S.init(T, D, 256, P.ws + WS_W + (size_t)l * W_LAYER + W_PP, C.G, C.bid);
    EpiB16<0> E{WSP(bf16_t, WS_PLE), D, nullptr};
    gemm_phase(C.lds, C.tid, (const char*)(P.ws + WS_PB + (size_t)l * T * 256 * 2), 256, S, E);
}
template <bool GATHER> __device__ __forceinline__ void moe_order_init(MoeOrder<GATHER>& S, const Params& P, const Ctx& C, int nN, int K, const void* Wt, size_t estride, bool mirror = false) {
    const int* block_e = (const int*)(P.ws + WS_RT + RT_BLOCKE); const int* slot_tok = (const int*)(P.ws + WS_RT + RT_SLOTTOK);
    LAS int* tab = (LAS int*)(C.lds + LDS_TAB); LAS int* ue = (LAS int*)(C.lds + LDS_UE);
    const int nblk = block_e[NBLK];
    S.nN = nN; S.nunits = nblk * nN; S.G = C.G; S.cm = (C.G % 8 == 0) ? (C.bid % 8) * (C.G / 8) + C.bid / 8 : C.bid; if (mirror) S.cm = C.G - 1 - S.cm; S.K = K; S.Wt = (const char*)Wt; S.estride = estride; S.tab = tab; S.ue = ue;
    { int ev[12], tk[12];
#pragma unroll
      for (int i = 0; i < 12; ++i) { const int L = i * S.G + S.cm; const bool ok = L < S.nunits; const int rb = ok ? L / nN : 0;
          ev[i] = (ok && C.tid < 64) ? block_e[rb] : 0; tk[i] = (GATHER && ok && C.tid < 256) ? slot_tok[rb * 256 + C.tid] : 0; }
#pragma unroll
      for (int i = 0; i < 12; ++i) { if (C.tid == 0) ue[i] = ev[i]; if (GATHER && C.tid < 256) tab[i * 256 + C.tid] = tk[i] < 0 ? 0 : tk[i]; } }
    __syncthreads();
}
__device__ __forceinline__ void phase_moe1(const Params& P, const Ctx& C, int l) {
    { DenseOrder S; S.init(T, D, D, P.ws + WS_W + (size_t)l * W_LAYER + W_PG, C.G, C.bid);
      EpiB16<1> E{WSP(bf16_t, WS_TMP), D, WSP(bf16_t, WS_PLE)};
      gemm_phase(C.lds, C.tid, (const char*)(P.ws + WS_H1B), D, S, E); }
    unsigned* ready = ctl_words(P) + CW_MOEC + l * NBLK * 16;
    { MoeOrder<true> S; moe_order_init<true>(S, P, C, 8, D, P.ws + WS_W + (size_t)l * W_LAYER + W_GU, (size_t)2048 * D * 2); S.ready = ready;
      EpiMoe1 E{P, l + 1, C.G, S.nunits, WSP(bf16_t, WS_HM), P.in[19] + (size_t)l * NE * 2048, ready};
      gemm_phase(C.lds, C.tid, (const char*)(P.ws + WS_H1B), D, S, E); }
    { MoeOrder<false> S; moe_order_init<false>(S, P, C, 4, DFF, P.ws + WS_W + (size_t)l * W_LAYER + W_DN, (size_t)D * DFF * 2, true); S.ready = ready;
      EpiMoe2 E{WSP(bf16_t, WS_YB), P.in[21] + (size_t)l * NE * D, (const float*)(P.ws + WS_RT + RT_SLOTGATE)};
      gemm_phase(C.lds, C.tid, (const char*)(P.ws + WS_HM), DFF, S, E); }
}
__device__ __forceinline__ void phase_moe2(const Params& P, const Ctx& C, int l) {}
__device__ __forceinline__ void phase_ln2(const Params& P, const Ctx& C, int l) {
    const int gw = C.bid * NWAVES + C.wave, NGW = C.G * NWAVES, lane = C.lane;
    const bf16_t* H1B = WSP(bf16_t, WS_H1B); const bf16_t* PLE = WSP(bf16_t, WS_TMP); const bf16_t* Yb = WSP(bf16_t, WS_YB); const int* tok_slot = (const int*)(P.ws + WS_RT + RT_TOKSLOT);
    for (int row0 = gw; row0 < T; row0 += 2 * NGW) {
        int sl[2][4];
#pragma unroll
        for (int k = 0; k < 2; ++k) { const int row = row0 + k * NGW < T ? row0 + k * NGW : row0;
#pragma unroll
            for (int r = 0; r < 4; ++r) sl[k][r] = tok_slot[row * 4 + r]; }
        float v[2][16]; float s[2] = {0.f, 0.f};
#pragma unroll
        for (int k = 0; k < 2; ++k) { const int row = row0 + k * NGW < T ? row0 + k * NGW : row0;
#pragma unroll
            for (int j = 0; j < 4; ++j) { const int c = 4 * lane + 256 * j; const u32x2 hb = *(const u32x2*)(H1B + (size_t)row * D + c); const u32x2 plb = *(const u32x2*)(PLE + (size_t)row * D + c);
                float f[4] = {__uint_as_float(plb.x << 16), __uint_as_float(plb.x & 0xffff0000u), __uint_as_float(plb.y << 16), __uint_as_float(plb.y & 0xffff0000u)};
#pragma unroll
                for (int r = 0; r < 4; ++r) { const u32x2 y = *(const u32x2*)(Yb + (size_t)sl[k][r] * D + c); f[0] += __uint_as_float(y.x << 16); f[1] += __uint_as_float(y.x & 0xffff0000u); f[2] += __uint_as_float(y.y << 16); f[3] += __uint_as_float(y.y & 0xffff0000u); }
                v[k][4 * j] = ALPHA * __uint_as_float(hb.x << 16) + f[0]; v[k][4 * j + 1] = ALPHA * __uint_as_float(hb.x & 0xffff0000u) + f[1];
                v[k][4 * j + 2] = ALPHA * __uint_as_float(hb.y << 16) + f[2]; v[k][4 * j + 3] = ALPHA * __uint_as_float(hb.y & 0xffff0000u) + f[3];
                s[k] += (v[k][4 * j] + v[k][4 * j + 1]) + (v[k][4 * j + 2] + v[k][4 * j + 3]); } }
#pragma unroll
        for (int k = 0; k < 2; ++k) { const int row = row0 + k * NGW; if (row < T) {
            const float mean = wave_sum(s[k]) * (1.f / D); float q = 0.f;
#pragma unroll
            for (int i = 0; i < 16; ++i) { v[k][i] -= mean; q += v[k][i] * v[k][i]; }
            const float rstd = rsqrtf(wave_sum(q) * (1.f / D) + LN_EPS);
            float* of = (l == DEPTH - 1) ? P.out + (size_t)row * D : nullptr;
            ln_store_row(v[k], rstd, P.in[24] + l * D, P.in[25] + l * D, of, (l == DEPTH - 1) ? nullptr : WSP(bf16_t, WS_HB) + (size_t)row * D, lane); } }
    }
}

enum { PH_PRO = 0, PH_INPROJ, PH_GPREP, PH_MIX, PH_GPOST, PH_OUTPROJ, PH_LN1, PH_SCAT, PH_MOE1, PH_MOE2, PH_LN2 };
__device__ __forceinline__ Ctx make_ctx(unsigned char* lds) {
    Ctx C; C.lds = (LAS unsigned char*)lds; C.tid = threadIdx.x; C.lane = C.tid & 63; C.wave = __builtin_amdgcn_readfirstlane(C.tid >> 6); C.G = gridDim.x; C.bid = blockIdx.x; return C;
}
template <int PH> __device__ __forceinline__ void run_phase(const Params& P, const Ctx& C, int l, int rep = 0) {
    if (PH == PH_PRO) phase_prologue(P, C);
    if (PH == PH_INPROJ) phase_inproj(P, C, l);
    if (PH == PH_GPREP) phase_gprep2(P, C, l);
    if (PH == PH_MIX) phase_mix(P, C, l, rep);
    if (PH == PH_GPOST) phase_gpost(P, C, l);
    if (PH == PH_OUTPROJ) phase_outproj(P, C, l);
    if (PH == PH_LN1) phase_ln1(P, C, l, rep);
    if (PH == PH_SCAT) phase_scatter(P, C, l, rep);
    if (PH == PH_MOE1) phase_moe1(P, C, l);
    if (PH == PH_MOE2) phase_moe2(P, C, l);
    if (PH == PH_LN2) phase_ln2(P, C, l);
}
#if MK_MULTI
template <int PH> __global__ void __launch_bounds__(NTHREADS, 2) kphase(Params P, int l) {
    extern __shared__ __attribute__((aligned(16))) unsigned char lds[];
    const Ctx C = make_ctx(lds);
    run_phase<PH>(P, C, l);
}
#else
__device__ __forceinline__ Params load_params() {
    Params r{};
#if defined(__HIP_DEVICE_COMPILE__)
    const __attribute__((address_space(4))) unsigned long long* p = (const __attribute__((address_space(4))) unsigned long long*)__builtin_amdgcn_kernarg_segment_ptr();
    asm volatile("" : "+s"(p));
#pragma unroll
    for (int i = 0; i < 26; ++i) r.in[i] = (const float*)(const __attribute__((address_space(1))) float*)p[i];
    r.out = (float*)(__attribute__((address_space(1))) float*)p[26]; r.ws = (unsigned char*)(__attribute__((address_space(1))) unsigned char*)p[27];
#endif
    return r;
}
__device__ __forceinline__ Ctx make_ctx_opaque(unsigned char* lds) {
    int t = threadIdx.x, b = blockIdx.x, g = gridDim.x; asm volatile("" : "+v"(t)); asm volatile("" : "+s"(b), "+s"(g));
    LAS unsigned char* lp = (LAS unsigned char*)lds; asm volatile("" : "+s"(lp));
    Ctx C; C.lds = lp; C.tid = t; C.lane = t & 63; C.wave = __builtin_amdgcn_readfirstlane(t >> 6); C.G = g; C.bid = b; return C;
}
#define GRID_BAR() do { XcdBarrier b2 = bar; asm volatile("" : "+s"(b2.bar), "+s"(b2.x)); xcd_barrier(b2); } while (0)
#ifndef PROBE_MASK
#define PROBE_MASK 0
#endif
#define PHASE1(PH, l, rep) do { asm volatile("; PHASE_BEGIN " #PH); const Params Pl = load_params(); const Ctx Cl = make_ctx_opaque(lds); run_phase<PH>(Pl, Cl, (l), (rep)); asm volatile("; PHASE_END " #PH); } while (0)
#define PHASE(PH, l) do { PHASE1(PH, l, 0); if ((PROBE_MASK >> PH) & 1) { GRID_BAR(); PHASE1(PH, l, 1); } } while (0)
__global__ void __launch_bounds__(NTHREADS, 2) mega(Params Pk) {
    extern __shared__ __attribute__((aligned(16))) unsigned char lds[];
    const Ctx C = make_ctx(lds);
    if (C.tid < 4) ((LAS unsigned*)(C.lds + LDS_MISC))[C.tid] = 0u;
    __syncthreads();
    XcdBarrier bar;
    { const Params Pl = load_params(); bar = xcd_barrier_post(ctl_words(Pl) + CW_BAR, (volatile LAS unsigned*)(C.lds + LDS_MISC)); }
    PHASE(PH_PRO, 0); GRID_BAR();
#define LAYER(l) do { PHASE(PH_INPROJ, l); GRID_BAR(); PHASE(PH_GPREP, l); GRID_BAR(); PHASE(PH_MIX, l); GRID_BAR(); PHASE(PH_GPOST, l); GRID_BAR(); \
        PHASE(PH_OUTPROJ, l); GRID_BAR(); PHASE(PH_LN1, l); GRID_BAR(); PHASE(PH_SCAT, l); GRID_BAR(); PHASE(PH_MOE1, l); GRID_BAR(); \
        PHASE(PH_LN2, l); if ((l) + 1 < DEPTH) GRID_BAR(); } while (0)
    LAYER(0); LAYER(1); LAYER(2); LAYER(3);
}
#endif
}

extern "C" void kernel_launch(void* const* d_in, const int* in_sizes, int n_in, void* d_out, int out_size, void* d_ws, size_t ws_size, hipStream_t stream) {
    static int grid = 0;
    if (grid == 0) {
        if (n_in != 26 || out_size != T * D || ws_size < WS_END) { fprintf(stderr, "kernel_launch: unexpected shapes (n_in %d out %d ws %zu need %zu)\n", n_in, out_size, ws_size, (size_t)WS_END); grid = -1; return; }
        int dev = 0, cus = 0; hipGetDevice(&dev); hipDeviceGetAttribute(&cus, hipDeviceAttributeMultiprocessorCount, dev);
#if MK_MULTI
#define SETATTR(PH) hipFuncSetAttribute((const void*)kphase<PH>, hipFuncAttributeMaxDynamicSharedMemorySize, LDS_BYTES)
        SETATTR(PH_PRO); SETATTR(PH_INPROJ); SETATTR(PH_GPREP); SETATTR(PH_MIX); SETATTR(PH_GPOST); SETATTR(PH_OUTPROJ); SETATTR(PH_LN1); SETATTR(PH_SCAT); SETATTR(PH_MOE1); SETATTR(PH_MOE2); SETATTR(PH_LN2);
#else
        hipFuncSetAttribute((const void*)mega, hipFuncAttributeMaxDynamicSharedMemorySize, LDS_BYTES);
        int per_cu = 0; hipOccupancyMaxActiveBlocksPerMultiprocessor(&per_cu, (const void*)mega, NTHREADS, LDS_BYTES);
        if (per_cu < 1) fprintf(stderr, "kernel_launch: occupancy query reports %d blocks per CU\n", per_cu);
#endif
        (void)hipGetLastError();
        grid = cus > 0 ? cus : 256;
    }
    if (grid < 0) return;
    hipMemsetAsync((char*)d_ws + WS_CTL, 0, CTL_BYTES, stream);
    Params P{};
    for (int i = 0; i < 26; ++i) P.in[i] = (const float*)d_in[i];
    P.out = (float*)d_out; P.ws = (unsigned char*)d_ws;
#if MK_MULTI
#define LAUNCH(PH, l) hipLaunchKernelGGL(kphase<PH>, dim3(grid), dim3(NTHREADS), LDS_BYTES, stream, P, l)
    LAUNCH(PH_PRO, 0);
    for (int l = 0; l < DEPTH; ++l) {
        LAUNCH(PH_INPROJ, l); LAUNCH(PH_GPREP, l); LAUNCH(PH_MIX, l); LAUNCH(PH_GPOST, l); LAUNCH(PH_OUTPROJ, l);
        LAUNCH(PH_LN1, l); LAUNCH(PH_SCAT, l); LAUNCH(PH_MOE1, l); LAUNCH(PH_MOE2, l); LAUNCH(PH_LN2, l);
    }
#else
    hipLaunchKernelGGL(mega, dim3(grid), dim3(NTHREADS), LDS_BYTES, stream, P);
#endif
}
```

```cpp
#include <hip/hip_runtime.h>
#include <cstdio>
#include <cstdint>

#ifndef MK_MULTI
#define MK_MULTI 0
#endif

namespace {
#define LAS __attribute__((address_space(3)))
typedef unsigned short bf16_t;
typedef short bf16x8 __attribute__((ext_vector_type(8)));
typedef float f32x4 __attribute__((ext_vector_type(4)));
typedef unsigned u32x4 __attribute__((ext_vector_type(4)));
typedef unsigned u32x2 __attribute__((ext_vector_type(2)));
#define ST16_NT(p, v) (*(u32x4*)(p) = (v))
__device__ __forceinline__ void st16_wt(void* p, u32x4 v) { asm volatile("global_store_dwordx4 %0, %1, off sc1\n\ts_nop 2" :: "v"(p), "v"(v) : "memory"); }

constexpr int D = 1024, BATCH = 8, SEQ = 2048, DEPTH = 4, T = BATCH * SEQ;
constexpr int DIN = 3856, NU = 3840, NINP = 4096;
constexpr int U_MQ = 0, U_MK = 256, U_MV = 512, U_MO = 768, U_SQ = 1024, U_SK = 1280, U_SV = 1536, U_GQ = 1792, U_GZ = 3328;
constexpr int NE = 32, DFF = 1024, MOEB = 256;
constexpr int NBLK = (T * 4) / MOEB + NE;
constexpr int PSLOTS = NBLK * MOEB;
constexpr float ALPHA = 1.6817928305074290f;
constexpr float LN_EPS = 1e-5f, NORM_EPS = 1e-6f;
constexpr int NTHREADS = 512, NWAVES = 8;

constexpr size_t MiB = 1u << 20;
constexpr size_t WS_CTL = 0;
constexpr size_t WS_HF = 1 * MiB;
constexpr size_t WS_HB = WS_HF + 64 * MiB;
constexpr size_t WS_H1F = WS_HB + 32 * MiB;
constexpr size_t WS_H1B = WS_H1F + 64 * MiB;
constexpr size_t WS_U16 = WS_H1B + 32 * MiB;
constexpr size_t WS_GT = WS_U16 + 120 * MiB;
constexpr size_t WS_Y = WS_GT + 1 * MiB;
constexpr size_t WS_TMP = WS_Y + 32 * MiB;
constexpr size_t WS_PLE = WS_TMP + 64 * MiB;
constexpr size_t WS_PB = WS_PLE + 64 * MiB;
constexpr size_t WS_GQ = WS_PB + 32 * MiB;
constexpr size_t WS_GK = WS_GQ + 32 * MiB;
constexpr size_t WS_GV = WS_GK + 32 * MiB;
constexpr size_t WS_GO = WS_GV + 32 * MiB;
constexpr size_t WS_HM = WS_GO + 32 * MiB;
constexpr size_t WS_YB = WS_HM + 144 * MiB;
constexpr size_t WS_RT = WS_YB + 144 * MiB;
constexpr size_t RT_TOPIDX = 0, RT_TOPGATE = 256 * 1024, RT_TOKSLOT = 512 * 1024, RT_SLOTTOK = 768 * 1024, RT_SLOTGATE = 1088 * 1024, RT_BLOCKE = 1408 * 1024, RT_WGCNT = 1536 * 1024  ;
constexpr size_t WS_W = WS_RT + 4 * MiB;
constexpr size_t W_IN = 0, W_OUT = 8 * MiB, W_PG = 10 * MiB, W_PP = 12 * MiB, W_GU = 13 * MiB, W_DN = 141 * MiB, W_LAYER = 205 * MiB;
constexpr size_t WS_END = WS_W + 4 * W_LAYER;
constexpr int CW_BAR = 4096;
constexpr int CW_SBQ = 8192;
constexpr int CW_MOEC = 16384;
constexpr size_t CTL_BYTES = 192 * 1024;
static_assert((CW_MOEC + DEPTH * NBLK * 16) * 4 <= (int)CTL_BYTES, "control words inside the per-call memset");

struct Params { const float* in[26]; float* out; unsigned char* ws; };

__device__ __forceinline__ float bf2f(bf16_t b) { return __uint_as_float(((unsigned)b) << 16); }
typedef __bf16 bf16x2_t __attribute__((ext_vector_type(2)));
typedef float f32x2_t __attribute__((ext_vector_type(2)));
__device__ __forceinline__ unsigned cvt_pk_bf16(float lo, float hi) { const f32x2_t v = {lo, hi}; const bf16x2_t b = __builtin_convertvector(v, bf16x2_t); return __builtin_bit_cast(unsigned, b); }
__device__ __forceinline__ unsigned f2bf(float f) { unsigned u = __float_as_uint(f); return (u + 0x7fffu + ((u >> 16) & 1u)) >> 16; }
__device__ __forceinline__ unsigned pk2(float lo, float hi) { return cvt_pk_bf16(lo, hi); }
__device__ __forceinline__ int lane_id_opaque() { int l = (int)__builtin_amdgcn_mbcnt_hi(~0u, __builtin_amdgcn_mbcnt_lo(~0u, 0u)); asm volatile("" : "+v"(l)); return l; }
__device__ __forceinline__ float shx(float v, int o, int lane) { return __uint_as_float((unsigned)__builtin_amdgcn_ds_bpermute((lane ^ o) << 2, (int)__float_as_uint(v))); }
__device__ __forceinline__ int shxi(int v, int o, int lane) { return __builtin_amdgcn_ds_bpermute((lane ^ o) << 2, v); }
__device__ __forceinline__ float wave_sum(float v) {
    const int lane = lane_id_opaque();
#pragma unroll
    for (int o = 32; o >= 1; o >>= 1) v += shx(v, o, lane);
    return v;
}
__device__ __forceinline__ float rl(float x, int d) { return __uint_as_float((unsigned)__builtin_amdgcn_readlane((int)__float_as_uint(x), d)); }
__device__ __forceinline__ float sigmoidf_(float x) { return __builtin_amdgcn_rcpf(1.0f + __expf(-x)); }
__device__ __forceinline__ float softplusf_(float x) { return fmaxf(x, 0.f) + log1pf(__expf(-fabsf(x))); }
__device__ __forceinline__ float siluf_(float x) { return x * sigmoidf_(x); }

#define XB_TMO      128
#define XB_XCNT(j)  (256  + 64 * (j))
#define XB_XSUB(j)  (1280 + 64 * (j))
#define XB_XGEN(j)  (2304 + 64 * (j))
#define XB_TOP      3328
#define XB_TOPGEN   3392
#define XCD_BAR_WORDS 3456
#define XB_SPIN_CAP (1u << 18)
__device__ __forceinline__ unsigned xb_ld(unsigned* p)              { return __hip_atomic_load(p, __ATOMIC_RELAXED, __HIP_MEMORY_SCOPE_AGENT); }
__device__ __forceinline__ unsigned xb_add(unsigned* p, unsigned v) { return __hip_atomic_fetch_add(p, v, __ATOMIC_RELAXED, __HIP_MEMORY_SCOPE_AGENT); }
__device__ __forceinline__ unsigned xb_xcc_id() { return (unsigned)__builtin_amdgcn_s_getreg((3 << 11) | 20) & 0xFu; }
#define XB_SPIN(cond, bar) do { unsigned _sp = 0; while (cond) { __builtin_amdgcn_s_sleep(1); \
    if ((++_sp & 255u) == 0u) { if (xb_ld(&(bar)[XB_TMO])) break; if (_sp > XB_SPIN_CAP) { atomicAdd(&(bar)[XB_TMO], 1u); break; } } } } while (0)
struct XcdBarrier { unsigned* bar; unsigned x; volatile LAS unsigned* st; };
__device__ __forceinline__ XcdBarrier xcd_barrier_post(unsigned* bar, volatile LAS unsigned* st) {
    XcdBarrier b; b.bar = bar; b.x = xb_xcc_id(); b.st = st;
    if (threadIdx.x == 0) (void)xb_add(&bar[XB_XCNT(b.x)], 1u);
    return b;
}
__device__ __forceinline__ void xcd_barrier_complete(unsigned* bar, unsigned x, unsigned& nloc, unsigned& nx) {
    const unsigned G = gridDim.x * gridDim.y * gridDim.z;
    unsigned sum, cnt, mine, sp = 0u;
    for (;;) {
        sum = 0u; cnt = 0u; mine = 0u;
#pragma unroll
        for (unsigned j = 0; j < 16; ++j) { const unsigned c = xb_ld(&bar[XB_XCNT(j)]); sum += c; cnt += (c > 0u) ? 1u : 0u; mine = (j == x) ? c : mine; }
        if (sum == G) break;
        __builtin_amdgcn_s_sleep(1);
        if ((++sp & 255u) == 0u) { if (xb_ld(&bar[XB_TMO])) break; if (sp > XB_SPIN_CAP) { atomicAdd(&bar[XB_TMO], 1u); break; } }
    }
    nloc = mine > 0u ? mine : 1u; nx = cnt > 0u ? cnt : 1u;
}
__device__ __forceinline__ void xcd_barrier(const XcdBarrier& b) {
    asm volatile("s_waitcnt vmcnt(0)" ::: "memory");
    __syncthreads();
    if (threadIdx.x == 0) {
        unsigned* bar = b.bar;
        __builtin_amdgcn_s_waitcnt(0);
        unsigned nloc = b.st[0], nx = b.st[1];
        if (nloc == 0u) { xcd_barrier_complete(bar, b.x, nloc, nx); b.st[0] = nloc; b.st[1] = nx; }
        const unsigned old = xb_add(&bar[XB_XSUB(b.x)], 1u);
        const unsigned gen = old / nloc;
        if (old + 1u == (gen + 1u) * nloc) {
            __builtin_amdgcn_fence(__ATOMIC_RELEASE, "agent");
            asm volatile("s_waitcnt vmcnt(0)" ::: "memory");
            const unsigned og = xb_add(&bar[XB_TOP], 1u);
            const unsigned tg = og / nx;
            if (og + 1u == (tg + 1u) * nx) xb_add(&bar[XB_TOPGEN], 1u);
            else XB_SPIN(xb_ld(&bar[XB_TOPGEN]) == tg, bar);
            __builtin_amdgcn_fence(__ATOMIC_ACQUIRE, "agent");
            xb_add(&bar[XB_XGEN(b.x)], 1u);
            asm volatile("s_waitcnt vmcnt(0)" ::: "memory");
        } else {
            XB_SPIN(xb_ld(&bar[XB_XGEN(b.x)]) == gen, bar);
            __builtin_amdgcn_fence(__ATOMIC_ACQUIRE, "agent");
            asm volatile("s_waitcnt vmcnt(0)" ::: "memory");
        }
    }
    __syncthreads();
}

constexpr int BM = 256, BK = 64, HALF = 128, HTB = HALF * BK * 2, STAGE_BYTES = 8 * HTB, NXCD = 8, WGM = 8;
constexpr int LDS_TAB = STAGE_BYTES;
constexpr int LDS_UE = LDS_TAB + 12288;
constexpr int LDS_MISC = LDS_UE + 64;
constexpr int LDS_BIAS = LDS_MISC + 64;
constexpr int LDS_BYTES = 151552;
static_assert(LDS_BIAS + 4096 <= LDS_BYTES, "LDS");
__host__ __device__ __forceinline__ int lds_byte(int r, int c) { const int st = (r >> 4) * 2 + (c >> 5), rr = r & 15, cc = c & 31, ob = rr * 64 + cc * 2; return st * 1024 + (ob ^ (((ob >> 9) & 1) << 5)); }
__host__ __device__ __forceinline__ void stage_rc(int b, int& R, int& C) { const int st = b / 1024, sb = b % 1024, swz = sb ^ (((sb >> 9) & 1) << 5); R = (st >> 1) * 16 + swz / 64; C = (st & 1) * 32 + (swz % 64) / 2; }
__host__ __device__ __forceinline__ int perm32(int rho) { const int n = rho >> 4, i = rho & 15; return 8 * (i >> 2) + 4 * n + (i & 3); }

constexpr int CV_IN = 16 * 31, CV_OUT = 16 * 8, CV_PG = 16 * 8, CV_PP = 4 * 8, CV_GU1 = 16 * 16, CV_DN1 = 16 * 8;
constexpr int CV_LAYER = CV_IN + CV_OUT + CV_PG + CV_PP + NE * CV_GU1 + NE * CV_DN1;
struct Unit { int pm, pn, e, L; };
__device__ __forceinline__ void convert_item(const Params& P, int l, int r, int lane);

struct DenseOrder {
    int nM, nN, nwg, G, c, K; const char* Bt;
    __device__ void init(int M, int N, int K_, const void* Bt_, int G_, int c_) { nM = M / BM; nN = N / BM; nwg = nM * nN; G = G_; c = c_; K = K_; Bt = (const char*)Bt_; }
    __device__ __forceinline__ bool next(int i, Unit& u) const {
        const long L = (long)i * G + c; if (L >= nwg) return false;
        int wgid = (int)L; { const int q = nwg / NXCD, r = nwg % NXCD, xcd = wgid % NXCD, off = wgid / NXCD; wgid = (xcd < r ? xcd * (q + 1) : r * (q + 1) + (xcd - r) * q) + off; }
        const int nig = WGM * nN, gid = wgid / nig, fm = gid * WGM, gsz = (nM - fm) < WGM ? (nM - fm) : WGM;
        u.pm = fm + ((wgid % nig) % gsz); u.pn = (wgid % nig) / gsz; u.e = 0; u.L = (int)L; return true;
    }
    __device__ __forceinline__ const char* b_base(const Unit& u) const { return Bt + (size_t)u.pn * BM * K * 2; }
    __device__ __forceinline__ void a_ready(const Unit&) const {}
    __device__ __forceinline__ unsigned a_off(int, const Unit& u, int row) const { return (unsigned)(u.pm * BM + row) * (unsigned)(K * 2); }
};
template <bool GATHER> struct MoeOrder {
    int nN, nunits, G, cm, K; const char* Wt; size_t estride; const LAS int* tab; const LAS int* ue;
    unsigned* ready;
    __device__ __forceinline__ void a_ready(const Unit& u) const {
        if (GATHER) return;
        if (threadIdx.x < 64) {
            unsigned sp = 0;
            while ((unsigned)__builtin_amdgcn_readfirstlane(__hip_atomic_load(ready + 16 * u.pm, __ATOMIC_RELAXED, __HIP_MEMORY_SCOPE_AGENT)) < 64u) { __builtin_amdgcn_s_sleep(2); if (++sp > (1u << 21)) break; }
            __builtin_amdgcn_fence(__ATOMIC_ACQUIRE, "agent");
            asm volatile("s_waitcnt vmcnt(0)" ::: "memory");
        }
        asm volatile("" ::: "memory"); __builtin_amdgcn_s_barrier(); asm volatile("" ::: "memory");
    }
    __device__ __forceinline__ bool next(int i, Unit& u) const {
        const int L = i * G + cm; if (L >= nunits) return false;
        u.pm = L / nN; u.pn = L - u.pm * nN; u.e = ue[i]; u.L = L; return true;
    }
    __device__ __forceinline__ const char* b_base(const Unit& u) const { return Wt + (size_t)u.e * estride + (size_t)u.pn * BM * K * 2; }
    __device__ __forceinline__ unsigned a_off(int i, const Unit& u, int row) const {
        if (GATHER) return (unsigned)tab[i * 256 + row] * (unsigned)(K * 2);
        return (unsigned)(u.pm * BM + row) * (unsigned)(K * 2);
    }
};

template <class Epi, class Sched>
__device__ __forceinline__ void gemm_phase(LAS unsigned char* lds, const int tid, const char* Abase, const int K, const Sched& S, const Epi& E) {
    const int wid = __builtin_amdgcn_readfirstlane(tid >> 6), lane = tid & 63, wr = wid >> 2, wc = wid & 3, fr = lane & 15, fq = lane >> 4;
    const int nt = K / BK;
    int Rr[2]; unsigned cb[2], voffB[2];
#pragma unroll
    for (int i = 0; i < 2; ++i) { int R, C; stage_rc(tid * 16 + i * 8192, R, C); const int Rb = Epi::PERM ? ((R & ~31) + perm32(R & 31)) : R;
        Rr[i] = R; cb[i] = (unsigned)C * 2u; voffB[i] = (unsigned)(Rb * K + C) * 2u; }
    const size_t kstep = (size_t)(BK * 2);
    const size_t hstep = (size_t)HALF * K * 2;
    const unsigned ldsw = (unsigned)wid * 1024u;
    const int aoff = lds_byte(wr * 64 + fr, fq * 8), boff = lds_byte(wc * 32 + fr, fq * 8);
#define G_SA(b, h) (((b) * 2 + (h)) * HTB)
#define G_SB(b, h) ((4 + (b) * 2 + (h)) * HTB)
#define G_STAGE_B(bufoff, gbase) do { _Pragma("unroll") for (int _i = 0; _i < 2; ++_i) \
        __builtin_amdgcn_global_load_lds((const unsigned*)((const char*)(gbase) + voffB[_i]), (LAS unsigned*)(lds + (bufoff) + ldsw + _i * 8192), 16, 0, 0); } while (0)
#define G_STAGE_A(bufoff, kbyte, ao) do { _Pragma("unroll") for (int _i = 0; _i < 2; ++_i) \
        __builtin_amdgcn_global_load_lds((const unsigned*)(Abase + (size_t)(kbyte) + (ao)[_i]), (LAS unsigned*)(lds + (bufoff) + ldsw + _i * 8192), 16, 0, 0); } while (0)
#define G_LDA(dst, b, h) do { _Pragma("unroll") for (int m = 0; m < 4; ++m) _Pragma("unroll") for (int k = 0; k < 2; ++k) dst[m][k] = *(const LAS bf16x8*)(lds + G_SA(b, h) + aoff + m * 2048 + k * 1024); } while (0)
#define G_LDB(dst, b, h) do { _Pragma("unroll") for (int n = 0; n < 2; ++n) _Pragma("unroll") for (int k = 0; k < 2; ++k) dst[n][k] = *(const LAS bf16x8*)(lds + G_SB(b, h) + boff + n * 2048 + k * 1024); } while (0)
#define G_MMA(ai, bj, At, Bt) do { __builtin_amdgcn_s_setprio(1); _Pragma("unroll") for (int m = 0; m < 4; ++m) _Pragma("unroll") for (int n = 0; n < 2; ++n) _Pragma("unroll") for (int k = 0; k < 2; ++k) \
        acc[ai][bj][m][n] = __builtin_amdgcn_mfma_f32_16x16x32_bf16(Bt[n][k], At[m][k], acc[ai][bj][m][n], 0, 0, 0); __builtin_amdgcn_s_setprio(0); } while (0)
#define G_WAIT_V(n) asm volatile("s_waitcnt vmcnt(" #n ")" ::: "memory")
#define G_WAIT_L(n) asm volatile("s_waitcnt lgkmcnt(" #n ")" ::: "memory")
#define G_BAR __builtin_amdgcn_s_barrier()
#define G_SCHED __builtin_amdgcn_sched_barrier(0)
    Unit cur, nxt; int ui = 0;
    if (!S.next(0, cur)) return;
    f32x4 acc[2][2][4][2];
#pragma unroll
    for (int a = 0; a < 2; ++a)
#pragma unroll
        for (int b = 0; b < 2; ++b)
#pragma unroll
            for (int m = 0; m < 4; ++m)
#pragma unroll
                for (int n = 0; n < 2; ++n) acc[a][b][m][n] = (f32x4){0.f, 0.f, 0.f, 0.f};
    bf16x8 At[4][2], B0[2][2], B1[2][2];
    unsigned aoc[2][2], aon[2][2];
#pragma unroll
    for (int h = 0; h < 2; ++h)
#pragma unroll
        for (int i = 0; i < 2; ++i) aoc[h][i] = S.a_off(0, cur, h * HALF + Rr[i]) + cb[i];
    const char* cB = S.b_base(cur);
    S.a_ready(cur);
    Unit prv = cur; bool have_prv = false;
    G_STAGE_B(G_SB(0, 0), cB); G_STAGE_A(G_SA(0, 0), 0, aoc[0]); G_STAGE_B(G_SB(0, 1), cB + hstep); G_STAGE_A(G_SA(0, 1), 0, aoc[1]);
    if (wr == 1) G_BAR;
    G_WAIT_V(4); G_BAR;
    G_STAGE_B(G_SB(1, 0), cB + kstep); G_STAGE_A(G_SA(1, 0), kstep, aoc[0]); G_STAGE_B(G_SB(1, 1), cB + hstep + kstep);
    G_WAIT_V(6); G_BAR;
    for (;;) {
        const bool has_next = S.next(ui + 1, nxt);
        E.stage(cur, wid, lane);
        const char* nB = has_next ? S.b_base(nxt) : cB;
#pragma unroll
        for (int h = 0; h < 2; ++h)
#pragma unroll
            for (int i = 0; i < 2; ++i) aon[h][i] = has_next ? (S.a_off(ui + 1, nxt, h * HALF + Rr[i]) + cb[i]) : aoc[h][i];
        for (int t = 0; t < nt; t += 2) {
            const bool last = (t == nt - 2);
            if (last) { if (have_prv) { E.publish(prv, lane); have_prv = false; } if (has_next) S.a_ready(nxt); }
            const size_t k1 = (size_t)(t + 1) * kstep;
            const size_t k2 = last ? (size_t)0 : (size_t)(t + 2) * kstep;
            const char* b2 = last ? nB : cB + (size_t)(t + 2) * kstep;
            const char* b3 = b2 + kstep;
            unsigned a2o[2][2];
#pragma unroll
            for (int h = 0; h < 2; ++h)
#pragma unroll
                for (int i = 0; i < 2; ++i) a2o[h][i] = last ? aon[h][i] : aoc[h][i];
            G_LDB(B0, 0, 0); G_SCHED; G_LDA(At, 0, 0); G_STAGE_A(G_SA(1, 1), k1, aoc[1]);
            G_WAIT_L(8); G_BAR; G_WAIT_L(0); G_MMA(0, 0, At, B0); G_BAR; G_SCHED;
            G_LDB(B1, 0, 1); G_STAGE_B(G_SB(0, 0), b2);
            G_BAR; G_WAIT_L(0); G_MMA(0, 1, At, B1); G_BAR;
            G_LDA(At, 0, 1); G_STAGE_A(G_SA(0, 0), k2, a2o[0]);
            G_BAR; G_WAIT_L(0); G_MMA(1, 0, At, B0); G_BAR; G_SCHED;
            G_STAGE_B(G_SB(0, 1), b2 + hstep);
            G_WAIT_V(6); G_BAR; G_MMA(1, 1, At, B1); G_BAR;
            G_LDB(B0, 1, 0); G_SCHED; G_LDA(At, 1, 0); G_STAGE_A(G_SA(0, 1), k2, a2o[1]);
            G_WAIT_L(8); G_BAR; G_WAIT_L(0); G_MMA(0, 0, At, B0); G_BAR; G_SCHED;
            G_LDB(B1, 1, 1); G_STAGE_B(G_SB(1, 0), b3);
            G_BAR; G_WAIT_L(0); G_MMA(0, 1, At, B1); G_BAR;
            G_LDA(At, 1, 1); G_STAGE_A(G_SA(1, 0), k2 + kstep, a2o[0]);
            G_BAR; G_WAIT_L(0); G_MMA(1, 0, At, B0); G_BAR; G_SCHED;
            G_STAGE_B(G_SB(1, 1), b3 + hstep);
            G_WAIT_V(6); G_BAR; G_MMA(1, 1, At, B1); G_BAR;
        }
        E(acc, cur, wr, wc, fr, fq);
        prv = cur; have_prv = true;
        E.after_unit(cur, wid, lane);
        if (!has_next) break;
#pragma unroll
        for (int a = 0; a < 2; ++a)
#pragma unroll
            for (int b = 0; b < 2; ++b)
#pragma unroll
                for (int m = 0; m < 4; ++m)
#pragma unroll
                    for (int n = 0; n < 2; ++n) acc[a][b][m][n] = (f32x4){0.f, 0.f, 0.f, 0.f};
        cur = nxt; cB = nB; ++ui;
#pragma unroll
        for (int h = 0; h < 2; ++h)
#pragma unroll
            for (int i = 0; i < 2; ++i) aoc[h][i] = aon[h][i];
    }
    G_WAIT_V(0);
    if (have_prv) E.publish(prv, lane);
    if (wr == 0) G_BAR;
    G_BAR;
#undef G_SA
#undef G_SB
#undef G_STAGE_A
#undef G_STAGE_B
#undef G_LDA
#undef G_LDB
#undef G_MMA
#undef G_WAIT_V
#undef G_WAIT_L
#undef G_BAR
#undef G_SCHED
}

struct EpiU {
    static constexpr bool PERM = true;
    __device__ __forceinline__ void after_unit(const Unit&, int, int) const {}
    __device__ __forceinline__ void publish(const Unit&, int) const {}
    __device__ __forceinline__ void stage(const Unit&, int, int) const {}
    bf16_t* U; float* GT;
    __device__ __forceinline__ void operator()(const f32x4 (&acc)[2][2][4][2], const Unit& u, int wr, int wc, int fr, int fq) const {
        const int row0 = u.pm * BM + wr * 64 + fr;
        if (u.pn < 15) {
            const int col0 = u.pn * BM + wc * 32 + 8 * fq;
#pragma unroll
            for (int ai = 0; ai < 2; ++ai)
#pragma unroll
                for (int m = 0; m < 4; ++m) { bf16_t* rowp = U + (size_t)(row0 + ai * HALF + m * 16) * NU + col0;
#pragma unroll
                    for (int bj = 0; bj < 2; ++bj) { const f32x4 v0 = acc[ai][bj][m][0], v1 = acc[ai][bj][m][1];
                        u32x4 w; w.x = cvt_pk_bf16(v0[0], v0[1]); w.y = cvt_pk_bf16(v0[2], v0[3]); w.z = cvt_pk_bf16(v1[0], v1[1]); w.w = cvt_pk_bf16(v1[2], v1[3]);
                        ST16_NT(rowp + bj * HALF, w); } }
        } else if (wc == 0 && fq < 2) {
#pragma unroll
            for (int ai = 0; ai < 2; ++ai)
#pragma unroll
                for (int m = 0; m < 4; ++m) { float* rowp = GT + (size_t)(row0 + ai * HALF + m * 16) * 16 + 8 * fq;
#pragma unroll
                    for (int n = 0; n < 2; ++n) *(f32x4*)(rowp + 4 * n) = acc[ai][0][m][n]; }
        }
    }
};
template <int MODE  > struct EpiF32 {
    static constexpr bool PERM = false;
    __device__ __forceinline__ void after_unit(const Unit&, int, int) const {}
    __device__ __forceinline__ void publish(const Unit&, int) const {}
    __device__ __forceinline__ void stage(const Unit&, int, int) const {}
    float* C; int ldc; const float* Src;
    __device__ __forceinline__ void operator()(const f32x4 (&acc)[2][2][4][2], const Unit& u, int wr, int wc, int fr, int fq) const {
        const int row0 = u.pm * BM + wr * 64 + fr, col0 = u.pn * BM + wc * 32 + 4 * fq;
#pragma unroll
        for (int ai = 0; ai < 2; ++ai)
#pragma unroll
            for (int m = 0; m < 4; ++m) { float* rowp = C + (size_t)(row0 + ai * HALF + m * 16) * ldc + col0;
#pragma unroll
                for (int bj = 0; bj < 2; ++bj)
#pragma unroll
                    for (int n = 0; n < 2; ++n) { f32x4 v = acc[ai][bj][m][n];
                        if (MODE == 1) { const f32x4 o = *(const f32x4*)(Src + (size_t)(row0 + ai * HALF + m * 16) * ldc + col0 + bj * HALF + n * 16);
#pragma unroll
                            for (int j = 0; j < 4; ++j) v[j] = sigmoidf_(v[j]) * o[j]; }
                        *(f32x4*)(rowp + bj * HALF + n * 16) = v; } }
    }
};
template <int MODE  > struct EpiB16 {
    static constexpr bool PERM = true;
    __device__ __forceinline__ void after_unit(const Unit&, int, int) const {}
    __device__ __forceinline__ void publish(const Unit&, int) const {}
    __device__ __forceinline__ void stage(const Unit&, int, int) const {}
    bf16_t* O; int ldc; const bf16_t* Src;
    __device__ __forceinline__ void operator()(const f32x4 (&acc)[2][2][4][2], const Unit& u, int wr, int wc, int fr, int fq) const {
        const int row0 = u.pm * BM + wr * 64 + fr, col0 = u.pn * BM + wc * 32 + 8 * fq;
#pragma unroll
        for (int ai = 0; ai < 2; ++ai)
#pragma unroll
            for (int m = 0; m < 4; ++m) { const size_t off = (size_t)(row0 + ai * HALF + m * 16) * ldc + col0;
#pragma unroll
                for (int bj = 0; bj < 2; ++bj) { f32x4 v0 = acc[ai][bj][m][0], v1 = acc[ai][bj][m][1];
                    if (MODE == 1) { const u32x4 g = *(const u32x4*)(Src + off + bj * HALF);
                        v0[0] = sigmoidf_(v0[0]) * __uint_as_float(g.x << 16); v0[1] = sigmoidf_(v0[1]) * __uint_as_float(g.x & 0xffff0000u); v0[2] = sigmoidf_(v0[2]) * __uint_as_float(g.y << 16); v0[3] = sigmoidf_(v0[3]) * __uint_as_float(g.y & 0xffff0000u);
                        v1[0] = sigmoidf_(v1[0]) * __uint_as_float(g.z << 16); v1[1] = sigmoidf_(v1[1]) * __uint_as_float(g.z & 0xffff0000u); v1[2] = sigmoidf_(v1[2]) * __uint_as_float(g.w << 16); v1[3] = sigmoidf_(v1[3]) * __uint_as_float(g.w & 0xffff0000u); }
                    u32x4 w; w.x = cvt_pk_bf16(v0[0], v0[1]); w.y = cvt_pk_bf16(v0[2], v0[3]); w.z = cvt_pk_bf16(v1[0], v1[1]); w.w = cvt_pk_bf16(v1[2], v1[3]);
                    *(u32x4*)(O + off + bj * HALF) = w; } }
    }
};
struct EpiMoe1 {
    static constexpr bool PERM = true;
    Params Pc; int lnext, G, nunits;
    __device__ __forceinline__ void after_unit(const Unit& u, int wid, int lane) const {
        if (lnext >= DEPTH) return;
        const int i = u.L / G, c = u.L - i * G;
        if (i != (c & 7)) return;
        const int n9 = nunits - 8 * G > 0 ? (nunits - 8 * G < G ? nunits - 8 * G : G) : 0, n8 = G - n9;
        int x = (CV_LAYER / NWAVES - 3 * n8 + G - 1) / G; if (x < 0) x = 0;
        const int cnt = c < n9 ? x : x + 3, start = c < n9 ? c * NWAVES * x : n9 * NWAVES * x + (c - n9) * NWAVES * (x + 3);
        for (int k = 0; k < cnt; ++k) { const int idx = start + wid * cnt + k; if (idx < CV_LAYER) convert_item(Pc, lnext, idx, lane); }
    }
    bf16_t* H; const float* b_gu;
    unsigned* ready;
    LAS unsigned char* lds;
    __device__ __forceinline__ void stage(const Unit& u, int wid, int lane) const {
        if (wid == 0) { const float* src = b_gu + (size_t)u.e * 2048 + (lane >> 5) * 1024 + u.pn * HALF + (lane & 31) * 4;
            __builtin_amdgcn_global_load_lds((const unsigned*)src, (LAS unsigned*)(lds + LDS_BIAS + ((u.L / G) & 1) * 2048), 16, 0, 0); }
    }
    __device__ __forceinline__ void publish(const Unit& u, int lane) const { if (lane == 0) __hip_atomic_fetch_add(ready + 16 * u.pm, 1u, __ATOMIC_RELAXED, __HIP_MEMORY_SCOPE_AGENT); }
    __device__ __forceinline__ void operator()(const f32x4 (&acc)[2][2][4][2], const Unit& u, int wr, int wc, int fr, int fq) const {
        const int row0 = u.pm * BM + wr * 64 + fr, col0 = u.pn * HALF + wc * 32 + 8 * fq;
        f32x4 bg[2], bu[2];
#pragma unroll
        for (int n = 0; n < 2; ++n) { const LAS float* bl = (const LAS float*)(lds + LDS_BIAS + ((u.L / G) & 1) * 2048) + wc * 32 + 8 * fq + 4 * n; bg[n] = *(const LAS f32x4*)bl; bu[n] = *(const LAS f32x4*)(bl + 128); }
#pragma unroll
        for (int ai = 0; ai < 2; ++ai)
#pragma unroll
            for (int m = 0; m < 4; ++m) { float o[8];
#pragma unroll
                for (int n = 0; n < 2; ++n)
#pragma unroll
                    for (int j = 0; j < 4; ++j) { float g = acc[ai][0][m][n][j] + bg[n][j], up = acc[ai][1][m][n][j] + bu[n][j];
                        g = fminf(g, 7.0f); up = fminf(fmaxf(up, -7.0f), 7.0f);
                        o[n * 4 + j] = (up + 1.0f) * g * sigmoidf_(1.702f * g); }
                u32x4 w; w.x = cvt_pk_bf16(o[0], o[1]); w.y = cvt_pk_bf16(o[2], o[3]); w.z = cvt_pk_bf16(o[4], o[5]); w.w = cvt_pk_bf16(o[6], o[7]);
                st16_wt(H + (size_t)(row0 + ai * HALF + m * 16) * DFF + col0, w); }
    }
};
struct EpiMoe2 {
    static constexpr bool PERM = true;
    __device__ __forceinline__ void after_unit(const Unit&, int, int) const {}
    __device__ __forceinline__ void publish(const Unit&, int) const {}
    bf16_t* Yb; const float* b_down; const float* slot_gate; int G; LAS unsigned char* lds;
    __device__ __forceinline__ void stage(const Unit& u, int wid, int lane) const {
        if (wid == 0) { LAS unsigned char* dst = lds + LDS_BIAS + ((u.L / G) & 1) * 2048;
            __builtin_amdgcn_global_load_lds((const unsigned*)(b_down + (size_t)u.e * D + u.pn * BM + lane * 4), (LAS unsigned*)dst, 16, 0, 0);
            __builtin_amdgcn_global_load_lds((const unsigned*)(slot_gate + (size_t)u.pm * BM + lane * 4), (LAS unsigned*)(dst + 1024), 16, 0, 0); }
    }
    __device__ __forceinline__ void operator()(const f32x4 (&acc)[2][2][4][2], const Unit& u, int wr, int wc, int fr, int fq) const {
        const int row0 = u.pm * BM + wr * 64 + fr, col0 = u.pn * BM + wc * 32 + 8 * fq;
        f32x4 bv[2][2];
#pragma unroll
        for (int bj = 0; bj < 2; ++bj)
#pragma unroll
            for (int n = 0; n < 2; ++n) bv[bj][n] = *(const LAS f32x4*)((const LAS float*)(lds + LDS_BIAS + ((u.L / G) & 1) * 2048) + wc * 32 + 8 * fq + bj * HALF + 4 * n);
#pragma unroll
        for (int ai = 0; ai < 2; ++ai)
#pragma unroll
            for (int m = 0; m < 4; ++m) { const int row = row0 + ai * HALF + m * 16; const float gt = ((const LAS float*)(lds + LDS_BIAS + ((u.L / G) & 1) * 2048 + 1024))[wr * 64 + fr + ai * HALF + m * 16];
#pragma unroll
                for (int bj = 0; bj < 2; ++bj) { const f32x4 v0 = (acc[ai][bj][m][0] + bv[bj][0]) * gt, v1 = (acc[ai][bj][m][1] + bv[bj][1]) * gt;
                    u32x4 w; w.x = cvt_pk_bf16(v0[0], v0[1]); w.y = cvt_pk_bf16(v0[2], v0[3]); w.z = cvt_pk_bf16(v1[0], v1[1]); w.w = cvt_pk_bf16(v1[2], v1[3]);
                    ST16_NT(Yb + (size_t)row * D + col0 + bj * HALF, w); } }
    }
};

struct Ctx {
    LAS unsigned char* lds; int tid, lane, wave, G, bid;
};
#define WSP(T_, off) ((T_*)(P.ws + (off)))
__device__ __forceinline__ unsigned* ctl_words(const Params& P) { return (unsigned*)(P.ws + WS_CTL); }

__device__ __forceinline__ int map_win(int n) { return n < 1024 ? n : (n < 1032 ? n + 2816 : (n < 3848 ? n - 8 : n)); }
__device__ __forceinline__ int map_wgu(int n) { return n < 1024 ? ((n >> 7) * 256 + (n & 127)) : ((((n - 1024) >> 7) * 256) + 128 + ((n - 1024) & 127)); }
__device__ __forceinline__ void transpose_item(const float* W, int K, int N, bf16_t* WT, int map, int item, int lane) {
    const int nblk = (N + 127) / 128, kb = item / nblk, nb = item - kb * nblk;
    const int kg = lane & 7, ng = lane >> 3, k0 = kb * 64 + 8 * kg, n0 = nb * 128 + 4 * ng;
    f32x4 v[4][8];
#pragma unroll
    for (int q = 0; q < 4; ++q) { const int n = n0 + 32 * q, nn = n < N ? n : 0;
#pragma unroll
        for (int i = 0; i < 8; ++i) v[q][i] = *(const f32x4*)(W + (size_t)(k0 + i) * N + nn); }
#pragma unroll
    for (int q = 0; q < 4; ++q) { const int n = n0 + 32 * q;
        if (n < N) {
#pragma unroll
            for (int j = 0; j < 4; ++j) { const int ngl = n + j; const int nr = map == 1 ? map_win(ngl) : (map == 2 ? map_wgu(ngl) : ngl);
                u32x4 o;
#pragma unroll
                for (int x = 0; x < 4; ++x) o[x] = cvt_pk_bf16(v[q][2 * x][j], v[q][2 * x + 1][j]);
                *(u32x4*)(WT + (size_t)nr * K + k0) = o; } } }
}
__device__ __forceinline__ void convert_item(const Params& P, int l, int r, int lane) {
    unsigned char* wl = P.ws + WS_W + (size_t)l * W_LAYER;
    const float* W; bf16_t* WT; int K = D, N = D, map = 0;
    if (r < CV_IN) { W = P.in[4] + (size_t)l * D * DIN; N = DIN; WT = (bf16_t*)(wl + W_IN); map = 1; }
    else if ((r -= CV_IN) < CV_OUT) { W = P.in[13] + (size_t)l * D * D; WT = (bf16_t*)(wl + W_OUT); }
    else if ((r -= CV_OUT) < CV_PG) { W = P.in[22] + (size_t)l * D * D; WT = (bf16_t*)(wl + W_PG); }
    else if ((r -= CV_PG) < CV_PP) { W = P.in[23] + (size_t)l * 256 * D; K = 256; WT = (bf16_t*)(wl + W_PP); }
    else if ((r -= CV_PP) < NE * CV_GU1) { const int e = r / CV_GU1; r -= e * CV_GU1; W = P.in[18] + ((size_t)l * NE + e) * D * 2048; N = 2048; WT = (bf16_t*)(wl + W_GU) + (size_t)e * 2048 * D; map = 2; }
    else { r -= NE * CV_GU1; const int e = r / CV_DN1; r -= e * CV_DN1; W = P.in[20] + ((size_t)l * NE + e) * DFF * D; WT = (bf16_t*)(wl + W_DN) + (size_t)e * D * DFF; }
    transpose_item(W, K, N, WT, map, r, lane);
}
__device__ __forceinline__ void ln_store_row(const float (&v)[16], float rstd, const float* g, const float* b, float* of, bf16_t* ob, int lane) {
#pragma unroll
    for (int j = 0; j < 4; ++j) { const int c = 4 * lane + 256 * j; const f32x4 gg = *(const f32x4*)(g + c), bb = *(const f32x4*)(b + c);
        f32x4 o; o[0] = v[4 * j] * rstd * gg[0] + bb[0]; o[1] = v[4 * j + 1] * rstd * gg[1] + bb[1]; o[2] = v[4 * j + 2] * rstd * gg[2] + bb[2]; o[3] = v[4 * j + 3] * rstd * gg[3] + bb[3];
        if (of) *(f32x4*)(of + c) = o;
        if (ob) { u32x2 w; w.x = pk2(o[0], o[1]); w.y = pk2(o[2], o[3]); *(u32x2*)(ob + c) = w; } }
}
__device__ __forceinline__ void phase_prologue(const Params& P, const Ctx& C) {
    const int gw = C.bid * NWAVES + C.wave, NGW = C.G * NWAVES;
    for (int it = gw; it < CV_LAYER; it += NGW) convert_item(P, 0, it, C.lane);
    { const float* p = P.in[1]; bf16_t* pb = WSP(bf16_t, WS_PB); const size_t n4 = (size_t)DEPTH * T * 256 / 4;
      const size_t stride = (size_t)C.G * NTHREADS;
      for (size_t i0 = (size_t)C.bid * NTHREADS + C.tid; i0 < n4; i0 += 8 * stride) {
          f32x4 v[8];
#pragma unroll
          for (int k = 0; k < 8; ++k) { const size_t i = i0 + k * stride; if (i < n4) v[k] = *(const f32x4*)(p + 4 * i); }
#pragma unroll
          for (int k = 0; k < 8; ++k) { const size_t i = i0 + k * stride; if (i < n4) { u32x2 w; w.x = pk2(v[k][0], v[k][1]); w.y = pk2(v[k][2], v[k][3]); *(u32x2*)(pb + 4 * i) = w; } } } }
    for (int row0 = gw; row0 < T; row0 += 2 * NGW) {
        float v[2][16]; float s[2] = {0.f, 0.f};
#pragma unroll
        for (int k = 0; k < 2; ++k) { const int row = row0 + k * NGW < T ? row0 + k * NGW : row0; const float* x = P.in[0] + (size_t)row * D;
#pragma unroll
            for (int j = 0; j < 4; ++j) { const f32x4 t = *(const f32x4*)(x + 4 * C.lane + 256 * j); v[k][4 * j] = t[0]; v[k][4 * j + 1] = t[1]; v[k][4 * j + 2] = t[2]; v[k][4 * j + 3] = t[3]; s[k] += (t[0] + t[1]) + (t[2] + t[3]); } }
#pragma unroll
        for (int k = 0; k < 2; ++k) { const int row = row0 + k * NGW; if (row < T) {
            const float mean = wave_sum(s[k]) * (1.f / D); float q = 0.f;
#pragma unroll
            for (int i = 0; i < 16; ++i) { v[k][i] -= mean; q += v[k][i] * v[k][i]; }
            const float rstd = rsqrtf(wave_sum(q) * (1.f / D) + LN_EPS);
            ln_store_row(v[k], rstd, P.in[2], P.in[3], nullptr, WSP(bf16_t, WS_HB) + (size_t)row * D, C.lane); } }
    }
}

__device__ __forceinline__ void phase_inproj(const Params& P, const Ctx& C, int l) {
    DenseOrder S; S.init(T, NINP, D, P.ws + WS_W + (size_t)l * W_LAYER + W_IN, C.G, C.bid);
    EpiU E{WSP(bf16_t, WS_U16), WSP(float, WS_GT)};
    gemm_phase(C.lds, C.tid, (const char*)(P.ws + WS_HB), D, S, E);
}

typedef float f32x16 __attribute__((ext_vector_type(16)));
#define MFMA32(a, b, c) __builtin_amdgcn_mfma_f32_32x32x16_bf16((a), (b), (c), 0, 0, 0)
constexpr int SB_KSTR = 72, SB_VSTR = 68, SB_KBYTES = 64 * SB_KSTR * 2, SB_BUF = SB_KBYTES + 64 * SB_VSTR * 2;
__device__ __forceinline__ float shx32(float v, int lane) { return __uint_as_float((unsigned)__builtin_amdgcn_ds_bpermute((lane ^ 32) << 2, (int)__float_as_uint(v))); }
template <bool DIAG> __device__ __forceinline__ void sb_tile_math(const f32x16& sacc, float& carry, bf16x8 (&pf)[2], int r, int hh, int lane) {
    float sg[16], om[16];
#pragma unroll
    for (int i = 0; i < 16; ++i) {
        const float t = fminf(sacc[i] * (-0.125f * 1.4426950408889634f), 80.f);
        const float e = __builtin_amdgcn_exp2f(t);
        float sgm = __builtin_amdgcn_rcpf(1.0f + e), omv = e * sgm;
        if (DIAG) { const int srow_i = (i & 3) + 8 * (i >> 2) + 4 * hh; const bool masked = srow_i >= r; sgm = masked ? 0.f : sgm; omv = masked ? 1.f : omv; }
        sg[i] = sgm; om[i] = omv;
    }
    float sfx[16], pg[4], pp[4], both[4];
#pragma unroll
    for (int g = 0; g < 4; ++g) { sfx[4 * g + 3] = 1.f; sfx[4 * g + 2] = om[4 * g + 3]; sfx[4 * g + 1] = sfx[4 * g + 2] * om[4 * g + 2]; sfx[4 * g] = sfx[4 * g + 1] * om[4 * g + 1]; pg[g] = sfx[4 * g] * om[4 * g]; }
#pragma unroll
    for (int g = 0; g < 4; ++g) { pp[g] = shx32(pg[g], lane); both[g] = pg[g] * pp[g]; }
    float outer[4];
    outer[3] = 1.f; outer[2] = both[3]; outer[1] = both[3] * both[2]; outer[0] = outer[1] * both[1];
    const float total = outer[0] * both[0];
#pragma unroll
    for (int g = 0; g < 4; ++g) { if (hh == 0) outer[g] *= pp[g]; outer[g] *= carry; }
    carry *= total;
#pragma unroll
    for (int s2 = 0; s2 < 2; ++s2) { u32x4 pk;
#pragma unroll
        for (int x = 0; x < 4; ++x) { const int i0 = 8 * s2 + 2 * x; pk[x] = cvt_pk_bf16(sg[i0] * (sfx[i0] * outer[i0 >> 2]), sg[i0 + 1] * (sfx[i0 + 1] * outer[(i0 + 1) >> 2])); }
        pf[s2] = __builtin_bit_cast(bf16x8, pk); }
}
__device__ __forceinline__ void sb_unit(const Params& P, const Ctx& C, int l, int b, int h, int qb) {
    const bf16_t* base = WSP(bf16_t, WS_U16) + (size_t)b * SEQ * NU;
    int tid_ = C.tid; asm volatile("" : "+v"(tid_));
    const int w = __builtin_amdgcn_readfirstlane(tid_ >> 6), lane = tid_ & 63, r = lane & 31, hh = lane >> 5;
    const int q0 = qb * 256 + 32 * w;
    bf16x8 qf[4];
#pragma unroll
    for (int kk = 0; kk < 4; ++kk) qf[kk] = *(const bf16x8*)(base + (size_t)(q0 + r) * NU + U_SQ + h * 64 + 16 * kk + 8 * hh);
    f32x16 oacc[2];
#pragma unroll
    for (int i = 0; i < 16; ++i) { oacc[0][i] = 0.f; oacc[1][i] = 0.f; }
    float carry = 1.f;
    const int nst = 4 * (qb + 1);
    const int srow = tid_ >> 3, scol = (tid_ & 7) * 8;
    LAS unsigned* alive = (LAS unsigned*)(C.lds + 2 * SB_BUF);
    u32x4 kreg, vreg;
    { const bf16_t* rowp = base + (size_t)(64 * (nst - 1) + srow) * NU + h * 64 + scol; kreg = *(const u32x4*)(rowp + U_SK); vreg = *(const u32x4*)(rowp + U_SV); }
    for (int st = nst - 1; st >= 0; --st) {
        LAS unsigned char* buf = C.lds + (st & 1) * SB_BUF;
        *(LAS u32x4*)(buf + (srow * SB_KSTR + scol) * 2) = kreg;
        { LAS bf16_t* vt = (LAS bf16_t*)(buf + SB_KBYTES);
#pragma unroll
          for (int j = 0; j < 4; ++j) { vt[(scol + 2 * j) * SB_VSTR + srow] = (bf16_t)(vreg[j] & 0xffffu); vt[(scol + 2 * j + 1) * SB_VSTR + srow] = (bf16_t)(vreg[j] >> 16); } }
        const bool wave_alive = __any(carry != 0.f) != 0;
        if (lane == 0) alive[(st & 1) * 8 + w] = wave_alive ? 1u : 0u;
        __syncthreads();
        { unsigned any_alive = 0u;
#pragma unroll
          for (int i = 0; i < 8; ++i) any_alive |= alive[(st & 1) * 8 + i];
          if (any_alive == 0u) break; }
        if (st > 0) { const bf16_t* rowp = base + (size_t)(64 * (st - 1) + srow) * NU + h * 64 + scol; kreg = *(const u32x4*)(rowp + U_SK); vreg = *(const u32x4*)(rowp + U_SV); }
        const LAS bf16_t* vt = (const LAS bf16_t*)(buf + SB_KBYTES);
#pragma unroll
        for (int half = 1; half >= 0; --half) {
            const int kb = 64 * st + 32 * half;
            if (kb >= q0 + 32 || !wave_alive) continue;
            const bool diag = (kb == q0);
            f32x16 sacc;
#pragma unroll
            for (int i = 0; i < 16; ++i) sacc[i] = 0.f;
#pragma unroll
            for (int kk = 0; kk < 4; ++kk) { const bf16x8 kf = *(const LAS bf16x8*)(buf + ((32 * half + r) * SB_KSTR + 16 * kk + 8 * hh) * 2); sacc = MFMA32(kf, qf[kk], sacc); }
            bf16x8 pf[2];
            if (diag) sb_tile_math<true>(sacc, carry, pf, r, hh, lane); else sb_tile_math<false>(sacc, carry, pf, r, hh, lane);
#pragma unroll
            for (int dt = 0; dt < 2; ++dt)
#pragma unroll
                for (int s2 = 0; s2 < 2; ++s2) { const LAS bf16_t* vrow = vt + (32 * dt + r) * SB_VSTR + 32 * half + 16 * s2 + 4 * hh;
                    const u32x2 lo = *(const LAS u32x2*)vrow, hi = *(const LAS u32x2*)(vrow + 8);
                    u32x4 vv; vv.x = lo.x; vv.y = lo.y; vv.z = hi.x; vv.w = hi.y;
                    oacc[dt] = MFMA32(__builtin_bit_cast(bf16x8, vv), pf[s2], oacc[dt]); }
        }
    }
    float ss = 0.f;
#pragma unroll
    for (int i = 0; i < 16; ++i) ss += oacc[0][i] * oacc[0][i] + oacc[1][i] * oacc[1][i];
    ss += shx32(ss, lane);
    const float sc = rsqrtf(ss * (1.f / 64.f) + NORM_EPS);
    const float* nw = P.in[8] + l * 256 + h * 64;
    bf16_t* yrow = WSP(bf16_t, WS_Y) + (size_t)(b * SEQ + q0 + r) * D + 256 + h * 64;
#pragma unroll
    for (int dt = 0; dt < 2; ++dt)
#pragma unroll
        for (int g = 0; g < 4; ++g) { const int d0 = 32 * dt + 8 * g + 4 * hh; const f32x4 n4 = *(const f32x4*)(nw + d0);
            u32x2 o2; o2.x = cvt_pk_bf16(oacc[dt][4 * g] * sc * n4[0], oacc[dt][4 * g + 1] * sc * n4[1]); o2.y = cvt_pk_bf16(oacc[dt][4 * g + 2] * sc * n4[2], oacc[dt][4 * g + 3] * sc * n4[3]);
            *(u32x2*)(yrow + d0) = o2; }
    __syncthreads();
}

constexpr int ML_STR = 72;
constexpr int ML_MAT = 64 * ML_STR * 2;
constexpr int ML_STAGE = 4 * ML_MAT;
constexpr int ML_K = 0, ML_Q = ML_MAT, ML_VT = 2 * ML_MAT, ML_KWT = 3 * ML_MAT;
constexpr int ML_CT = 2 * ML_STAGE  , ML_N = ML_CT + 2 * ML_MAT  , ML_SSQ = ML_N + 512  ,
              ML_GB = ML_SSQ + 1024  , ML_GWL = ML_GB + 8192, ML_GEB = ML_GWL + 8192, ML_GWG = ML_GEB + 8192  , ML_GG = ML_GWG + 8192  , ML_END = ML_GG + 128;
static_assert(ML_END <= LDS_TAB, "mLSTM LDS map");
__device__ __forceinline__ float shup(float v, int o, int lane) { return __uint_as_float((unsigned)__builtin_amdgcn_ds_bpermute((lane - o) << 2, (int)__float_as_uint(v))); }
__device__ __forceinline__ float shidx(float v, int src) { return __uint_as_float((unsigned)__builtin_amdgcn_ds_bpermute(src << 2, (int)__float_as_uint(v))); }
__device__ __forceinline__ void mlstm_unit(const Params& P, const Ctx& C, int l, int b, int h, int par) {
    const bf16_t* U = WSP(bf16_t, WS_U16) + (size_t)b * SEQ * NU; const float* GT = WSP(float, WS_GT) + (size_t)b * SEQ * 16;
    LAS unsigned char* lds = C.lds;
    const int w = C.wave, lane = C.lane, r = lane & 31, hh = lane >> 5, tid = C.tid;
    const float ib = P.in[5][l * 4 + h], fb = P.in[6][l * 4 + h];
    for (int i = tid; i < (2 * ML_MAT + 512 + 1024) / 4; i += NTHREADS) ((LAS unsigned*)(lds + ML_CT))[i] = 0u;
    for (int n = w; n < SEQ / 64; n += NWAVES) {
        const size_t tk = (size_t)64 * n + lane;
        float bcs = -softplusf_(-(GT[tk * 16 + 4 + h] + fb));
#pragma unroll
        for (int o = 1; o < 64; o <<= 1) { const float t = shup(bcs, o, lane); if (lane >= o) bcs += t; }
        const float wl = (GT[tk * 16 + h] + ib) - bcs, bL = shidx(bcs, 63);
        ((LAS float*)(lds + ML_GB))[tk] = bcs; ((LAS float*)(lds + ML_GWL))[tk] = wl; ((LAS float*)(lds + ML_GEB))[tk] = __expf(bcs); ((LAS float*)(lds + ML_GWG))[tk] = __expf(bL + wl);
        if (lane == 0) ((LAS float*)(lds + ML_GG))[n] = __expf(bL);
    }
    const int srow = tid >> 3, c0 = (tid & 7) * 8;
    u32x4 qreg, kreg, vreg;
    { const bf16_t* rowp = U + (size_t)srow * NU + h * 64 + c0; qreg = *(const u32x4*)(rowp + U_MQ); kreg = *(const u32x4*)(rowp + U_MK); vreg = *(const u32x4*)(rowp + U_MV); }
    f32x16 cacc;
#pragma unroll
    for (int i = 0; i < 16; ++i) cacc[i] = 0.f;
    float n_d = 0.f;
    const int ti = w & 1, ei = (w >> 1) & 1;
    f32x16 hv; float rs_part = 0.f; u32x2 opre[4];
#pragma unroll
    for (int i = 0; i < 16; ++i) hv[i] = 0.f;
#pragma unroll
    for (int g = 0; g < 4; ++g) opre[g] = (u32x2){0u, 0u};
    const float* nw = P.in[7] + l * 256 + h * 64;
    __syncthreads();
    for (int n = 0; n <= SEQ / 64; ++n) {
        const int cb = n & 1;
        LAS unsigned char* sb = lds + cb * ML_STAGE;
        if (n < SEQ / 64) {
            const float wgt_row = ((const LAS float*)(lds + ML_GWG))[64 * n + srow];
            u32x4 ks; float kf[8];
#pragma unroll
            for (int x = 0; x < 4; ++x) { kf[2 * x] = __uint_as_float(kreg[x] << 16) * 0.125f; kf[2 * x + 1] = __uint_as_float(kreg[x] & 0xffff0000u) * 0.125f; ks[x] = (__float_as_uint(kf[2 * x]) >> 16) | (__float_as_uint(kf[2 * x + 1]) & 0xffff0000u); }
            *(LAS u32x4*)(sb + ML_K + (srow * ML_STR + c0) * 2) = ks;
            if ((n & 1) == par) *(LAS u32x4*)(sb + ML_Q + (srow * ML_STR + c0) * 2) = qreg;
            LAS bf16_t* vt = (LAS bf16_t*)(sb + ML_VT); LAS bf16_t* kwt = (LAS bf16_t*)(sb + ML_KWT);
#pragma unroll
            for (int x = 0; x < 4; ++x) { vt[(c0 + 2 * x) * ML_STR + srow] = (bf16_t)(vreg[x] & 0xffffu); vt[(c0 + 2 * x + 1) * ML_STR + srow] = (bf16_t)(vreg[x] >> 16);
                kwt[(c0 + 2 * x) * ML_STR + srow] = (bf16_t)f2bf(kf[2 * x] * wgt_row); kwt[(c0 + 2 * x + 1) * ML_STR + srow] = (bf16_t)f2bf(kf[2 * x + 1] * wgt_row); }
        }
        __syncthreads();
        if (n + 1 < SEQ / 64) { const bf16_t* rowp = U + (size_t)(64 * (n + 1) + srow) * NU + h * 64 + c0; qreg = *(const u32x4*)(rowp + U_MQ); kreg = *(const u32x4*)(rowp + U_MK); vreg = *(const u32x4*)(rowp + U_MV); }
        if (w < 4 && n > 0 && ((n - 1) & 1) == par) {
            const float tot = rs_part + ((const LAS float*)(lds + ML_SSQ))[(cb ^ 1) * 128 + (ti * 2 + (ei ^ 1)) * 32 + r];
            const float rs = rsqrtf(tot * (1.f / 64.f) + NORM_EPS);
            const size_t tok = (size_t)64 * (n - 1) + 32 * ti + r;
            bf16_t* yrow = WSP(bf16_t, WS_Y) + ((size_t)b * SEQ + tok) * D + h * 64;
#pragma unroll
            for (int g = 0; g < 4; ++g) { const int e0 = 32 * ei + 8 * g + 4 * hh; const f32x4 n4 = *(const f32x4*)(nw + e0); const u32x2 op = opre[g];
                const float o0 = sigmoidf_(__uint_as_float(op.x << 16)), o1 = sigmoidf_(__uint_as_float(op.x & 0xffff0000u)), o2 = sigmoidf_(__uint_as_float(op.y << 16)), o3 = sigmoidf_(__uint_as_float(op.y & 0xffff0000u));
                u32x2 y2; y2.x = cvt_pk_bf16(hv[4 * g] * rs * n4[0] * o0, hv[4 * g + 1] * rs * n4[1] * o1); y2.y = cvt_pk_bf16(hv[4 * g + 2] * rs * n4[2] * o2, hv[4 * g + 3] * rs * n4[3] * o3);
                *(u32x2*)(yrow + e0) = y2; }
        }
        if (n == SEQ / 64) break;
        if (w < 4) { if ((n & 1) == par) {
            { const size_t tokp = (size_t)64 * n + 32 * ti + r;
#pragma unroll
              for (int g = 0; g < 4; ++g) opre[g] = *(const u32x2*)(U + tokp * NU + U_MO + h * 64 + 32 * ei + 8 * g + 4 * hh); }
            const LAS float* gwl = (const LAS float*)(lds + ML_GWL) + 64 * n;
            const float bt = ((const LAS float*)(lds + ML_GB))[64 * n + 32 * ti + r], ebt = ((const LAS float*)(lds + ML_GEB))[64 * n + 32 * ti + r];
            bf16x8 qf[4];
#pragma unroll
            for (int kk = 0; kk < 4; ++kk) qf[kk] = *(const LAS bf16x8*)(sb + ML_Q + ((32 * ti + r) * ML_STR + 16 * kk + 8 * hh) * 2);
            f32x16 acc1, acc2;
#pragma unroll
            for (int i = 0; i < 16; ++i) { acc1[i] = 0.f; acc2[i] = 0.f; }
            float den = 0.f;
#pragma unroll
            for (int si = 0; si < 2; ++si) {
                if (si > ti) continue;
                f32x16 sacc;
#pragma unroll
                for (int i = 0; i < 16; ++i) sacc[i] = 0.f;
#pragma unroll
                for (int kk = 0; kk < 4; ++kk) { const bf16x8 kf = *(const LAS bf16x8*)(sb + ML_K + ((32 * si + r) * ML_STR + 16 * kk + 8 * hh) * 2); sacc = MFMA32(kf, qf[kk], sacc); }
                float pv[16];
#pragma unroll
                for (int g = 0; g < 4; ++g) { const f32x4 wl4 = *(const LAS f32x4*)(gwl + 32 * si + 8 * g + 4 * hh);
#pragma unroll
                    for (int x = 0; x < 4; ++x) { const int srow_i = 8 * g + 4 * hh + x; const bool keep = (si < ti) || (srow_i <= r);
                        const float pvv = keep ? sacc[4 * g + x] * __expf(bt + wl4[x]) : 0.f; pv[4 * g + x] = pvv; den += pvv; } }
#pragma unroll
                for (int s2 = 0; s2 < 2; ++s2) { u32x4 pk;
#pragma unroll
                    for (int x = 0; x < 4; ++x) pk[x] = cvt_pk_bf16(pv[8 * s2 + 2 * x], pv[8 * s2 + 2 * x + 1]);
                    const LAS bf16_t* vrow = (const LAS bf16_t*)(sb + ML_VT) + (32 * ei + r) * ML_STR + 32 * si + 16 * s2 + 4 * hh;
                    const u32x2 lo = *(const LAS u32x2*)vrow, hi = *(const LAS u32x2*)(vrow + 8);
                    u32x4 vv; vv.x = lo.x; vv.y = lo.y; vv.z = hi.x; vv.w = hi.y;
                    acc1 = MFMA32(__builtin_bit_cast(bf16x8, vv), __builtin_bit_cast(bf16x8, pk), acc1); }
            }
#pragma unroll
            for (int kk = 0; kk < 4; ++kk) { const bf16x8 cf = *(const LAS bf16x8*)(lds + ML_CT + cb * ML_MAT + ((32 * ei + r) * ML_STR + 16 * kk + 8 * hh) * 2); acc2 = MFMA32(cf, qf[kk], acc2); }
            float qn = 0.f;
            { const LAS float* nv = (const LAS float*)(lds + ML_N + cb * 256);
#pragma unroll
              for (int kk = 0; kk < 4; ++kk) { const u32x4 qq = *(const LAS u32x4*)(sb + ML_Q + ((32 * ti + r) * ML_STR + 32 * hh + 8 * kk) * 2);
                  const f32x4 n0 = *(const LAS f32x4*)(nv + 32 * hh + 8 * kk), n1 = *(const LAS f32x4*)(nv + 32 * hh + 8 * kk + 4);
                  qn += __uint_as_float(qq[0] << 16) * n0[0] + __uint_as_float(qq[0] & 0xffff0000u) * n0[1] + __uint_as_float(qq[1] << 16) * n0[2] + __uint_as_float(qq[1] & 0xffff0000u) * n0[3]
                      + __uint_as_float(qq[2] << 16) * n1[0] + __uint_as_float(qq[2] & 0xffff0000u) * n1[1] + __uint_as_float(qq[3] << 16) * n1[2] + __uint_as_float(qq[3] & 0xffff0000u) * n1[3]; } }
            den += ebt * qn;
            den += shx32(den, lane);
            const float dinv = __builtin_amdgcn_rcpf(fmaxf(fabsf(den), 1.0f));
            rs_part = 0.f;
#pragma unroll
            for (int i = 0; i < 16; ++i) { hv[i] = (acc1[i] + ebt * acc2[i]) * dinv; rs_part += hv[i] * hv[i]; }
            rs_part += shx32(rs_part, lane);
            if (hh == 0) ((LAS float*)(lds + ML_SSQ))[cb * 128 + (ti * 2 + ei) * 32 + r] = rs_part;
        } } else {
            const int di = w & 1; const float G = ((const LAS float*)(lds + ML_GG))[n];
#pragma unroll
            for (int i = 0; i < 16; ++i) cacc[i] *= G;
#pragma unroll
            for (int kk = 0; kk < 4; ++kk) { const bf16x8 vf = *(const LAS bf16x8*)(sb + ML_VT + ((32 * ei + r) * ML_STR + 16 * kk + 8 * hh) * 2);
                const bf16x8 kf = *(const LAS bf16x8*)(sb + ML_KWT + ((32 * di + r) * ML_STR + 16 * kk + 8 * hh) * 2); cacc = MFMA32(vf, kf, cacc); }
            LAS bf16_t* ct = (LAS bf16_t*)(lds + ML_CT + (cb ^ 1) * ML_MAT);
#pragma unroll
            for (int i = 0; i < 16; ++i) ct[(32 * ei + (i & 3) + 8 * (i >> 2) + 4 * hh) * ML_STR + 32 * di + r] = (bf16_t)f2bf(cacc[i]);
            if (w == 4) { float sum = 0.f;
#pragma unroll
                for (int kk = 0; kk < 8; ++kk) { const u32x4 kk4 = *(const LAS u32x4*)(sb + ML_KWT + (lane * ML_STR + 8 * kk) * 2);
#pragma unroll
                    for (int x = 0; x < 4; ++x) sum += __uint_as_float(kk4[x] << 16) + __uint_as_float(kk4[x] & 0xffff0000u); }
                n_d = G * n_d + sum; ((LAS float*)(lds + ML_N + (cb ^ 1) * 256))[lane] = n_d; }
        }
    }
    __syncthreads();
}
constexpr int GP_W = 0, GP_QD = 16384, GP_KDT = 32768, GP_QK = 49152, GP_U = 57344, GP_CD = 73728, GP_CHUNK = 74752;
constexpr size_t WS_GP = WS_GQ;
static_assert((size_t)1024 * GP_CHUNK <= 96 * MiB, "GDN prep buffer");
constexpr int PL_KSTR = 136, PL_KN = 0, PL_QN = 17408, PL_RHS = 34816, PL_RSTR = 260, PL_M = 101376, PL_MSTR = 72  , PL_QK = 118784, PL_QKSTR = 72, PL_WC = 128000, PL_GATE = 134144, PL_UWSTR = 264;
__device__ __forceinline__ unsigned bfmul2(unsigned pk, float a) { return cvt_pk_bf16(__uint_as_float(pk << 16) * a, __uint_as_float(pk & 0xffff0000u) * a); }
__device__ __forceinline__ void gdn_prep_unit(const Params& P, const Ctx& C, int l, int b, int h, int n) {
    LAS unsigned char* lds = C.lds;
    int tid_ = C.tid; asm volatile("" : "+v"(tid_));
    const int tid = tid_, w = __builtin_amdgcn_readfirstlane(tid >> 6), lane = tid & 63, r = lane & 31, hh = lane >> 5;
    const bf16_t* U = WSP(bf16_t, WS_U16) + (size_t)b * SEQ * NU; const float* GT = WSP(float, WS_GT) + (size_t)b * SEQ * 16;
    unsigned char* outp = P.ws + WS_GP + (size_t)((b * 4 + h) * 32 + n) * GP_CHUNK;
    const int t0 = 64 * n;
    { const float* cw = P.in[9] + (size_t)l * 4 * 1536; LAS float* wc = (LAS float*)(lds + PL_WC);
      for (int idx = tid; idx < 1536; idx += NTHREADS) { const int j = idx / 384, rem = idx - j * 384, p = rem >> 7, cc = rem & 127; wc[idx] = cw[j * 1536 + p * 512 + h * 128 + cc]; } }
    float beta_l, gam_l, gamL;
    { const float A = __expf(P.in[10][l * 4 + h]), dtb = P.in[11][l * 4 + h];
      const float ga = GT[(size_t)(t0 + lane) * 16 + 8 + h], gb = GT[(size_t)(t0 + lane) * 16 + 12 + h];
      float g = -A * softplusf_(ga + dtb);
#pragma unroll
      for (int o = 1; o < 64; o <<= 1) { const float t = shup(g, o, lane); if (lane >= o) g += t; }
      gam_l = g; beta_l = sigmoidf_(gb); gamL = shidx(g, 63);
      if (w == 0) { LAS float* gt = (LAS float*)(lds + PL_GATE); gt[lane] = gam_l; gt[64 + lane] = beta_l; gt[128 + lane] = __expf(gam_l); gt[192 + lane] = __expf(gamL - gam_l); } }
    __syncthreads();
    { const int t = tid >> 3, cg = tid & 7;
      const float beta_t = shidx(beta_l, t), gam_t = shidx(gam_l, t);
      float acc[3][16];
#pragma unroll
      for (int p = 0; p < 3; ++p)
#pragma unroll
          for (int c = 0; c < 16; ++c) acc[p][c] = 0.f;
      const LAS float* wc = (const LAS float*)(lds + PL_WC);
#pragma unroll
      for (int j = 0; j < 4; ++j) { const int ts = t0 + t - 3 + j;
          if (ts >= 0) {
#pragma unroll
              for (int p = 0; p < 3; ++p) { const bf16_t* src = U + (size_t)ts * NU + U_GQ + p * 512 + h * 128 + 16 * cg; const u32x4 x0 = *(const u32x4*)src, x1 = *(const u32x4*)(src + 8);
                  const LAS float* wp = wc + j * 384 + p * 128 + 16 * cg;
#pragma unroll
                  for (int c4 = 0; c4 < 4; ++c4) { const f32x4 w4 = *(const LAS f32x4*)(wp + 4 * c4); const unsigned xa = c4 < 2 ? x0[2 * c4] : x1[2 * c4 - 4], xb = c4 < 2 ? x0[2 * c4 + 1] : x1[2 * c4 - 3];
                      acc[p][4 * c4] += w4[0] * __uint_as_float(xa << 16); acc[p][4 * c4 + 1] += w4[1] * __uint_as_float(xa & 0xffff0000u);
                      acc[p][4 * c4 + 2] += w4[2] * __uint_as_float(xb << 16); acc[p][4 * c4 + 3] += w4[3] * __uint_as_float(xb & 0xffff0000u); } } } }
      float ssq = 0.f, ssk = 0.f;
#pragma unroll
      for (int c = 0; c < 16; ++c) { acc[0][c] = siluf_(acc[0][c]); acc[1][c] = siluf_(acc[1][c]); acc[2][c] = siluf_(acc[2][c]); ssq += acc[0][c] * acc[0][c]; ssk += acc[1][c] * acc[1][c]; }
      { const int ln = lane_id_opaque();
#pragma unroll
        for (int o = 1; o < 8; o <<= 1) { ssq += shx(ssq, o, ln); ssk += shx(ssk, o, ln); } }
      const float scq = rsqrtf(ssq + NORM_EPS) * 0.08838834764831845f, sck = rsqrtf(ssk + NORM_EPS), bw = beta_t * __expf(gam_t);
      u32x4 qa, qb, ka, kb;
#pragma unroll
      for (int x = 0; x < 4; ++x) { qa[x] = cvt_pk_bf16(acc[0][2 * x] * scq, acc[0][2 * x + 1] * scq); qb[x] = cvt_pk_bf16(acc[0][8 + 2 * x] * scq, acc[0][9 + 2 * x] * scq);
                                     ka[x] = cvt_pk_bf16(acc[1][2 * x] * sck, acc[1][2 * x + 1] * sck); kb[x] = cvt_pk_bf16(acc[1][8 + 2 * x] * sck, acc[1][9 + 2 * x] * sck); }
      *(LAS u32x4*)(lds + PL_QN + (t * PL_KSTR + 16 * cg) * 2) = qa; *(LAS u32x4*)(lds + PL_QN + (t * PL_KSTR + 16 * cg + 8) * 2) = qb;
      *(LAS u32x4*)(lds + PL_KN + (t * PL_KSTR + 16 * cg) * 2) = ka; *(LAS u32x4*)(lds + PL_KN + (t * PL_KSTR + 16 * cg + 8) * 2) = kb;
      LAS float* rhs = (LAS float*)(lds + PL_RHS) + t * PL_RSTR;
#pragma unroll
      for (int c4 = 0; c4 < 4; ++c4) { f32x4 rv, rk;
#pragma unroll
          for (int x = 0; x < 4; ++x) { rv[x] = beta_t * acc[2][4 * c4 + x]; rk[x] = bw * sck * acc[1][4 * c4 + x]; }
          *(LAS f32x4*)(rhs + 16 * cg + 4 * c4) = rv; *(LAS f32x4*)(rhs + 128 + 16 * cg + 4 * c4) = rk; } }
    __syncthreads();
    { const int p = w >> 2, ti = (w >> 1) & 1, si = w & 1;
      const LAS float* gt = (const LAS float*)(lds + PL_GATE);
      if (si <= ti) {
          f32x16 acc;
#pragma unroll
          for (int i = 0; i < 16; ++i) acc[i] = 0.f;
#pragma unroll
          for (int kk = 0; kk < 8; ++kk) { const bf16x8 af = *(const LAS bf16x8*)(lds + (p ? PL_QN : PL_KN) + ((32 * ti + r) * PL_KSTR + 16 * kk + 8 * hh) * 2);
              const bf16x8 bf = *(const LAS bf16x8*)(lds + PL_KN + ((32 * si + r) * PL_KSTR + 16 * kk + 8 * hh) * 2); acc = MFMA32(af, bf, acc); }
          const float gam_s = gt[32 * si + r];
#pragma unroll
          for (int g = 0; g < 4; ++g) { const f32x4 gt4 = *(const LAS f32x4*)(gt + 32 * ti + 8 * g + 4 * hh), bt4 = *(const LAS f32x4*)(gt + 64 + 32 * ti + 8 * g + 4 * hh);
#pragma unroll
              for (int x = 0; x < 4; ++x) { const int trow = 8 * g + 4 * hh + x; const float dec = __expf(fminf(gt4[x] - gam_s, 0.f)) * acc[4 * g + x];
                  if (p == 0) { const bool keep = (si < ti) || (r < trow); ((LAS _Float16*)(lds + PL_M))[(32 * ti + trow) * PL_MSTR + 32 * si + r] = (_Float16)(keep ? bt4[x] * dec : 0.f); }
                  else { const bool keep = (si < ti) || (r <= trow); ((LAS bf16_t*)(lds + PL_QK))[(32 * ti + trow) * PL_QKSTR + 32 * si + r] = (bf16_t)f2bf(keep ? dec : 0.f); } } }
      } else if (p == 1) {
#pragma unroll
          for (int i = 0; i < 16; ++i) ((LAS bf16_t*)(lds + PL_QK))[(32 * ti + (i & 3) + 8 * (i >> 2) + 4 * hh) * PL_QKSTR + 32 * si + r] = (bf16_t)0;
      } }
    __syncthreads();
    float xs[64];
    if (w < 4) {
        int vz = 0; asm volatile("" : "+v"(vz));
        typedef _Float16 f16x8 __attribute__((ext_vector_type(8)));
        const LAS float* rhs = (const LAS float*)(lds + PL_RHS) + tid; const LAS _Float16* Mh = (const LAS _Float16*)(lds + PL_M) + vz;
#pragma clang loop unroll(full)
        for (int t = 0; t < 64; ++t) { float a = rhs[t * PL_RSTR];
            const LAS _Float16* Mrow = Mh + t * PL_MSTR;
#pragma clang loop unroll(full)
            for (int s8 = 0; s8 < (t + 7) / 8; ++s8) { const f16x8 m8 = *(const LAS f16x8*)(Mrow + 8 * s8);
#pragma unroll
                for (int x = 0; x < 8; ++x) if (8 * s8 + x < t) a -= (float)m8[x] * xs[8 * s8 + x]; }
            xs[t] = a; }
    } else {
        const LAS float* gt = (const LAS float*)(lds + PL_GATE);
        for (int it = w - 4; it < 40; it += 4) {
            u32x4 o;
            if (it < 16) { const int ti = it >> 3, kk = it & 7; const u32x4 q = *(const LAS u32x4*)(lds + PL_QN + ((32 * ti + r) * PL_KSTR + 16 * kk + 8 * hh) * 2); const float eg = gt[128 + 32 * ti + r];
#pragma unroll
                for (int x = 0; x < 4; ++x) o[x] = bfmul2(q[x], eg);
                *(u32x4*)(outp + GP_QD + (size_t)((ti * 8 + kk) * 64 + lane) * 16) = o;
            } else if (it < 32) { const int dt = (it - 16) >> 2, ks = (it - 16) & 3; const LAS bf16_t* kn = (const LAS bf16_t*)(lds + PL_KN) + 32 * dt + r;
#pragma unroll
                for (int x = 0; x < 4; ++x) { const int ta = 16 * ks + 8 * ((2 * x) >> 2) + 4 * hh + ((2 * x) & 3), tb = ta + 1;
                    o[x] = cvt_pk_bf16(bf2f(kn[ta * PL_KSTR]) * gt[192 + ta], bf2f(kn[tb * PL_KSTR]) * gt[192 + tb]); }
                *(u32x4*)(outp + GP_KDT + (size_t)((dt * 4 + ks) * 64 + lane) * 16) = o;
            } else { const int ti = (it - 32) >> 2, ks = (it - 32) & 3; const LAS bf16_t* qrow = (const LAS bf16_t*)(lds + PL_QK) + (32 * ti + r) * PL_QKSTR + 16 * ks + 4 * hh;
                const u32x2 lo = *(const LAS u32x2*)qrow, hi = *(const LAS u32x2*)(qrow + 8); o.x = lo.x; o.y = lo.y; o.z = hi.x; o.w = hi.y;
                *(u32x4*)(outp + GP_QK + (size_t)((ti * 4 + ks) * 64 + lane) * 16) = o; }
        }
    }
    __syncthreads();
    if (w < 4) { LAS bf16_t* uw = (LAS bf16_t*)(lds + PL_RHS) + tid;
#pragma unroll
        for (int t = 0; t < 64; ++t) uw[t * PL_UWSTR] = (bf16_t)f2bf(xs[t]); }
    __syncthreads();
    { const LAS bf16_t* uw = (const LAS bf16_t*)(lds + PL_RHS);
      for (int it = w; it < 24; it += 8) {
          if (it < 16) { const int ti = it >> 3, kk = it & 7; const u32x4 o = *(const LAS u32x4*)(uw + (32 * ti + r) * PL_UWSTR + 128 + 16 * kk + 8 * hh);
              *(u32x4*)(outp + GP_W + (size_t)((ti * 8 + kk) * 64 + lane) * 16) = o;
          } else { const int ti = (it - 16) >> 2, es = (it - 16) & 3; u32x4 o0, o1;
#pragma unroll
              for (int x = 0; x < 8; ++x) { const int ia = 2 * x, ib = 2 * x + 1; const int ta = 32 * ti + (ia & 3) + 8 * (ia >> 2) + 4 * hh, tb = 32 * ti + (ib & 3) + 8 * (ib >> 2) + 4 * hh;
                  const unsigned v = (unsigned)uw[ta * PL_UWSTR + 32 * es + r] | ((unsigned)uw[tb * PL_UWSTR + 32 * es + r] << 16); if (x < 4) o0[x] = v; else o1[x - 4] = v; }
              unsigned char* dst = outp + GP_U + (size_t)((ti * 4 + es) * 64 + lane) * 32; *(u32x4*)dst = o0; *(u32x4*)(dst + 16) = o1; }
      }
      if (tid == 0) *(float*)(outp + GP_CD) = __expf(gamL); }
    __syncthreads();
}
__device__ __forceinline__ void phase_gprep2(const Params& P, const Ctx& C, int l) {
    { int* slot_tok = (int*)(P.ws + WS_RT + RT_SLOTTOK); for (int i = C.bid * NTHREADS + C.tid; i < PSLOTS; i += C.G * NTHREADS) slot_tok[i] = -1; }
    for (int u = C.bid; u < 1024; u += C.G) gdn_prep_unit(P, C, l, u >> 7, (u >> 5) & 3, u & 31);
}
constexpr int GS_SLOT = 61440, GS_ST = 2 * GS_SLOT, GS_STSTR = 136, GS_STBYTES = 32 * GS_STSTR * 2;
__device__ __forceinline__ void gdn_scan_unit(const Params& P, const Ctx& C, int l, int b, int h, int es) {
    LAS unsigned char* lds = C.lds;
    const int tid = C.tid, w = C.wave, lane = C.lane, r = lane & 31, hh = lane >> 5;
    const unsigned char* gp = P.ws + WS_GP + (size_t)((b * 4 + h) * 32) * GP_CHUNK;
    float* O = WSP(float, WS_GO) + (size_t)b * SEQ * 512 + h * 128 + 32 * es;
    for (int i = tid; i < 2 * GS_STBYTES / 4; i += NTHREADS) ((LAS unsigned*)(lds + GS_ST))[i] = 0u;
#define GS_ISSUE(nn) do { const unsigned char* src = gp + (size_t)(nn) * GP_CHUNK; LAS unsigned char* dst = lds + ((nn) & 1) * GS_SLOT; \
        for (int p = w; p < 60; p += 8) { const size_t go = p < 56 ? (size_t)p * 1024 : (size_t)GP_U + (size_t)(((p - 56) >> 1) * 4 + es) * 2048 + (size_t)((p - 56) & 1) * 1024; \
            __builtin_amdgcn_global_load_lds((const unsigned*)(src + go + lane * 16), (LAS unsigned*)(dst + p * 1024), 16, 0, 0); } } while (0)
    GS_ISSUE(0);
    float cd_next = *(const float*)(gp + GP_CD);
    f32x16 sacc;
#pragma unroll
    for (int i = 0; i < 16; ++i) sacc[i] = 0.f;
    asm volatile("s_waitcnt vmcnt(0)" ::: "memory");
    __syncthreads();
    for (int n = 0; n < 32; ++n) {
        const float cd = cd_next;
        if (n + 1 < 32) { GS_ISSUE(n + 1); cd_next = *(const float*)(gp + (size_t)(n + 1) * GP_CHUNK + GP_CD); }
        const LAS unsigned char* slot = lds + (n & 1) * GS_SLOT;
        const LAS unsigned char* stc = lds + GS_ST + (n & 1) * GS_STBYTES;
        if (w < 6) {
            f32x16 xa[2];
#pragma unroll
            for (int i = 0; i < 16; ++i) { xa[0][i] = 0.f; xa[1][i] = 0.f; }
            bf16x8 sf[8];
#pragma unroll
            for (int kk = 0; kk < 8; ++kk) sf[kk] = *(const LAS bf16x8*)(stc + (r * GS_STSTR + 16 * kk + 8 * hh) * 2);
#pragma unroll
            for (int ti = 0; ti < 2; ++ti)
#pragma unroll
                for (int kk = 0; kk < 8; ++kk) { const bf16x8 wf = *(const LAS bf16x8*)(slot + GP_W + ((ti * 8 + kk) * 64 + lane) * 16); xa[ti] = MFMA32(wf, sf[kk], xa[ti]); }
            bf16x8 pf[2][2];
#pragma unroll
            for (int ti = 0; ti < 2; ++ti) { const u32x4 u0 = *(const LAS u32x4*)(slot + GP_U + ti * 2048 + lane * 32), u1 = *(const LAS u32x4*)(slot + GP_U + ti * 2048 + lane * 32 + 16);
#pragma unroll
                for (int s2 = 0; s2 < 2; ++s2) { const u32x4 uu = s2 ? u1 : u0; u32x4 pk;
#pragma unroll
                    for (int x = 0; x < 4; ++x) pk[x] = cvt_pk_bf16(__uint_as_float(uu[x] << 16) - xa[ti][8 * s2 + 2 * x], __uint_as_float(uu[x] & 0xffff0000u) - xa[ti][8 * s2 + 2 * x + 1]);
                    pf[ti][s2] = __builtin_bit_cast(bf16x8, pk); } }
            if (w < 4) {
#pragma unroll
                for (int i = 0; i < 16; ++i) sacc[i] *= cd;
#pragma unroll
                for (int ks = 0; ks < 4; ++ks) { const bf16x8 kf = *(const LAS bf16x8*)(slot + GP_KDT + ((w * 4 + ks) * 64 + lane) * 16); sacc = MFMA32(kf, pf[ks >> 1][ks & 1], sacc); }
                LAS unsigned char* stn = lds + GS_ST + ((n + 1) & 1) * GS_STBYTES;
#pragma unroll
                for (int g = 0; g < 4; ++g) { u32x2 o2; o2.x = cvt_pk_bf16(sacc[4 * g], sacc[4 * g + 1]); o2.y = cvt_pk_bf16(sacc[4 * g + 2], sacc[4 * g + 3]);
                    *(LAS u32x2*)(stn + (r * GS_STSTR + 32 * w + 8 * g + 4 * hh) * 2) = o2; }
            } else {
                const int ti = w - 4;
                f32x16 oa;
#pragma unroll
                for (int i = 0; i < 16; ++i) oa[i] = 0.f;
#pragma unroll
                for (int kk = 0; kk < 8; ++kk) { const bf16x8 qf = *(const LAS bf16x8*)(slot + GP_QD + ((ti * 8 + kk) * 64 + lane) * 16); oa = MFMA32(qf, sf[kk], oa); }
#pragma unroll
                for (int ks = 0; ks < 4; ++ks) { if ((ks >> 1) > ti) continue; const bf16x8 qf = *(const LAS bf16x8*)(slot + GP_QK + ((ti * 4 + ks) * 64 + lane) * 16); oa = MFMA32(qf, pf[ks >> 1][ks & 1], oa); }
                float* orow = O + (size_t)(64 * n + 32 * ti) * 512 + r;
#pragma unroll
                for (int i = 0; i < 16; ++i) orow[(size_t)((i & 3) + 8 * (i >> 2) + 4 * hh) * 512] = oa[i];
            }
        }
        asm volatile("s_waitcnt vmcnt(0)" ::: "memory");
        __syncthreads();
    }
#undef GS_ISSUE
}
__device__ __forceinline__ void phase_mix(const Params& P, const Ctx& C, int l, int rep) {
#ifndef MIX_SEL
#define MIX_SEL 7
#endif
    const int sel = rep ? MIX_SEL : 7;
    if (C.bid < 128) { if (sel & 1) { const int j = C.bid >> 3, bh = (j >> 2) * 8 + (C.bid & 7); gdn_scan_unit(P, C, l, bh >> 2, bh & 3, j & 3); } }
    else if (C.bid < 192) { if (sel & 2) { const int q = C.bid - 128, j = q >> 3, bh = (j >> 1) * 8 + (q & 7); mlstm_unit(P, C, l, bh >> 2, bh & 3, j & 1); } }
    if (!(sel & 4)) return;
    LAS int* qslot = (LAS int*)(C.lds + LDS_MISC + 32);
    for (;;) {
        if (C.tid == 0) *qslot = (int)atomicAdd(ctl_words(P) + CW_SBQ + (l + 4 * rep) * 64, 1u);
        __syncthreads();
        const int u = *qslot;
        __syncthreads();
        if (u >= 256) break;
        sb_unit(P, C, l, (u & 31) >> 2, u & 3, 7 - (u >> 5));
    }
}
__device__ __forceinline__ void phase_gpost(const Params& P, const Ctx& C, int l) {
    const float* O = WSP(float, WS_GO); const bf16_t* U = WSP(bf16_t, WS_U16); bf16_t* Y = WSP(bf16_t, WS_Y); const float* nw = P.in[12] + l * 128 + (C.lane & 15) * 8;
    const int gw = C.bid * NWAVES + C.wave, NGW = C.G * NWAVES, lane = C.lane;
    const f32x4 n0 = *(const f32x4*)nw, n1 = *(const f32x4*)(nw + 4);
    for (int tok0 = gw; tok0 < T; tok0 += 4 * NGW) {
        f32x4 a[4], b[4]; u32x4 z[4];
#pragma unroll
        for (int k = 0; k < 4; ++k) { const int tok = tok0 + k * NGW; if (tok < T) { a[k] = *(const f32x4*)(O + (size_t)tok * 512 + lane * 8); b[k] = *(const f32x4*)(O + (size_t)tok * 512 + lane * 8 + 4); z[k] = *(const u32x4*)(U + (size_t)tok * NU + U_GZ + lane * 8); } }
#pragma unroll
        for (int k = 0; k < 4; ++k) { const int tok = tok0 + k * NGW; if (tok < T) {
            float ss = (a[k][0] * a[k][0] + a[k][1] * a[k][1]) + (a[k][2] * a[k][2] + a[k][3] * a[k][3]) + (b[k][0] * b[k][0] + b[k][1] * b[k][1]) + (b[k][2] * b[k][2] + b[k][3] * b[k][3]);
            { const int ln = lane_id_opaque();
#pragma unroll
              for (int o = 1; o < 16; o <<= 1) ss += shx(ss, o, ln); }
            const float sc = rsqrtf(ss * (1.f / 128.f) + NORM_EPS);
            u32x4 o;
            o.x = cvt_pk_bf16(a[k][0] * sc * n0[0] * siluf_(__uint_as_float(z[k].x << 16)), a[k][1] * sc * n0[1] * siluf_(__uint_as_float(z[k].x & 0xffff0000u)));
            o.y = cvt_pk_bf16(a[k][2] * sc * n0[2] * siluf_(__uint_as_float(z[k].y << 16)), a[k][3] * sc * n0[3] * siluf_(__uint_as_float(z[k].y & 0xffff0000u)));
            o.z = cvt_pk_bf16(b[k][0] * sc * n1[0] * siluf_(__uint_as_float(z[k].z << 16)), b[k][1] * sc * n1[1] * siluf_(__uint_as_float(z[k].z & 0xffff0000u)));
            o.w = cvt_pk_bf16(b[k][2] * sc * n1[2] * siluf_(__uint_as_float(z[k].w << 16)), b[k][3] * sc * n1[3] * siluf_(__uint_as_float(z[k].w & 0xffff0000u)));
            *(u32x4*)(Y + (size_t)tok * D + 512 + lane * 8) = o; } }
    }
}
__device__ __forceinline__ void phase_outproj(const Params& P, const Ctx& C, int l) {
    DenseOrder S; S.init(T, D, D, P.ws + WS_W + (size_t)l * W_LAYER + W_OUT, C.G, C.bid);
    EpiB16<0> E{WSP(bf16_t, WS_TMP), D, nullptr};
    gemm_phase(C.lds, C.tid, (const char*)(P.ws + WS_Y), D, S, E);
}
__device__ __forceinline__ void phase_ln1(const Params& P, const Ctx& C, int l, int rep) {
    const int gw = C.bid * NWAVES + C.wave, NGW = C.G * NWAVES, lane = C.lane;
    const bf16_t* HB = WSP(bf16_t, WS_HB); const bf16_t* TMP = WSP(bf16_t, WS_TMP);
    const float* wr = P.in[16] + (size_t)l * D * NE; const float* br = P.in[17] + l * NE;
    const float* g = P.in[14] + l * D; const float* bb = P.in[15] + l * D;
    int* top_idx = (int*)(P.ws + WS_RT + RT_TOPIDX); float* top_gate = (float*)(P.ws + WS_RT + RT_TOPGATE);
    LAS float* xs = (LAS float*)(C.lds + C.wave * 16384);
    const int e_me = lane & 31, half = lane >> 5;
    LAS unsigned* hist = (LAS unsigned*)(C.lds + LDS_TAB);
    if (C.tid < NE) hist[C.tid] = 0u;
    __syncthreads();
    for (int gi = gw; gi < T / 4; gi += NGW) {
        u32x2 hbr[4][4], tbr[4][4];
#pragma unroll
        for (int rr = 0; rr < 4; ++rr)
#pragma unroll
            for (int j = 0; j < 4; ++j) { hbr[rr][j] = *(const u32x2*)(HB + (size_t)(4 * gi + rr) * D + 4 * lane + 256 * j); tbr[rr][j] = *(const u32x2*)(TMP + (size_t)(4 * gi + rr) * D + 4 * lane + 256 * j); }
#pragma unroll
        for (int rr = 0; rr < 4; ++rr) {
            const int row = 4 * gi + rr;
            float v[16]; float s = 0.f;
#pragma unroll
            for (int j = 0; j < 4; ++j) { const u32x2 hb = hbr[rr][j]; const u32x2 tb = tbr[rr][j]; const float t[4] = {__uint_as_float(tb.x << 16), __uint_as_float(tb.x & 0xffff0000u), __uint_as_float(tb.y << 16), __uint_as_float(tb.y & 0xffff0000u)};
                const float a[4] = {__uint_as_float(hb.x << 16), __uint_as_float(hb.x & 0xffff0000u), __uint_as_float(hb.y << 16), __uint_as_float(hb.y & 0xffff0000u)};
#pragma unroll
                for (int x = 0; x < 4; ++x) { v[4 * j + x] = ALPHA * a[x] + t[x]; s += v[4 * j + x]; } }
            const float mean = wave_sum(s) * (1.f / D); float q = 0.f;
#pragma unroll
            for (int i = 0; i < 16; ++i) { v[i] -= mean; q += v[i] * v[i]; }
            const float rstd = rsqrtf(wave_sum(q) * (1.f / D) + LN_EPS);
#pragma unroll
            for (int j = 0; j < 4; ++j) { const int c = 4 * lane + 256 * j; const f32x4 gg = *(const f32x4*)(g + c), b4 = *(const f32x4*)(bb + c);
                f32x4 o;
#pragma unroll
                for (int x = 0; x < 4; ++x) o[x] = v[4 * j + x] * rstd * gg[x] + b4[x];
                u32x2 w; w.x = pk2(o[0], o[1]); w.y = pk2(o[2], o[3]); *(u32x2*)(WSP(bf16_t, WS_H1B) + (size_t)row * D + c) = w;
                *(LAS f32x4*)(xs + rr * 1024 + c) = o; }
        }
        float acc[4] = {0.f, 0.f, 0.f, 0.f};
        { const float* wp = wr + (size_t)(half * 512) * NE + e_me; const LAS float* xp = xs + half * 512;
#pragma unroll 8
          for (int k = 0; k < 512; k += 4) { const float w0 = wp[(size_t)k * NE], w1 = wp[(size_t)(k + 1) * NE], w2 = wp[(size_t)(k + 2) * NE], w3 = wp[(size_t)(k + 3) * NE];
#pragma unroll
              for (int rr = 0; rr < 4; ++rr) { const f32x4 x4 = *(const LAS f32x4*)(xp + rr * 1024 + k); acc[rr] += (x4[0] * w0 + x4[1] * w1) + (x4[2] * w2 + x4[3] * w3); } } }
        const float bias = br[e_me];
#pragma unroll
        for (int rr = 0; rr < 4; ++rr) {
            const int row = 4 * gi + rr;
            float logit = acc[rr] + shx(acc[rr], 32, lane) + bias;
            float vals[4]; int ids[4];
#pragma unroll
            for (int r = 0; r < 4; ++r) {
                float bv = logit; int bi = e_me;
#pragma unroll
                for (int o = 16; o >= 1; o >>= 1) { const float ov = shx(bv, o, lane); const int oi = shxi(bi, o, lane); if (ov > bv || (ov == bv && oi < bi)) { bv = ov; bi = oi; } }
                vals[r] = bv; ids[r] = bi; if (e_me == bi) logit = -INFINITY;
            }
            float ex[4], se = 0.f;
#pragma unroll
            for (int r = 0; r < 4; ++r) { ex[r] = __expf(vals[r] - vals[0]); se += ex[r]; }
            if (lane == 0) {
#pragma unroll
                for (int r = 0; r < 4; ++r) { top_idx[row * 4 + r] = ids[r]; top_gate[row * 4 + r] = ex[r] * __builtin_amdgcn_rcpf(se); __hip_atomic_fetch_add(&hist[ids[r]], 1u, __ATOMIC_RELAXED, __HIP_MEMORY_SCOPE_WORKGROUP); }
            }
        }
    }
    __syncthreads();
    if (C.tid < NE) ((unsigned*)(P.ws + WS_RT + RT_WGCNT))[(size_t)rep * 256 * NE + C.bid * NE + C.tid] = hist[C.tid];
}
__device__ __forceinline__ void phase_scatter(const Params& P, const Ctx& C, int l, int rep) {
    LAS int* pad_start = (LAS int*)(C.lds + LDS_TAB);
    LAS unsigned* cur = (LAS unsigned*)(C.lds + LDS_TAB + 256);
    LAS unsigned* ptot = (LAS unsigned*)(C.lds + LDS_TAB + 512);
    LAS unsigned* ppre = (LAS unsigned*)(C.lds + LDS_TAB + 512 + 2048);
    const unsigned* wgcnt = (const unsigned*)(P.ws + WS_RT + RT_WGCNT);
    { const int e = C.tid & 31, part = C.tid >> 5; unsigned st = 0, sp = 0;
      unsigned cv[16];
#pragma unroll
      for (int i = 0; i < 16; ++i) { const int wb = part * 16 + i; cv[i] = wb < C.G ? wgcnt[wb * NE + e] : 0u; }
#pragma unroll
      for (int i = 0; i < 16; ++i) { const int wb = part * 16 + i; st += cv[i]; if (wb < C.bid) sp += cv[i]; }
      ptot[part * 32 + e] = st; ppre[part * 32 + e] = sp; }
    __syncthreads();
    if (C.tid < NE) { unsigned st = 0, sp = 0; for (int p = 0; p < 16; ++p) { st += ptot[p * 32 + C.tid]; sp += ppre[p * 32 + C.tid]; } ptot[C.tid] = st; ppre[C.tid] = sp; }
    __syncthreads();
    if (C.tid == 0) { int acc = 0; for (int e = 0; e < NE; ++e) { pad_start[e] = acc; cur[e] = (unsigned)acc + ppre[e]; acc += ((int)ptot[e] + MOEB - 1) / MOEB * MOEB; } pad_start[NE] = acc; }
    __syncthreads();
    const int* top_idx = (const int*)(P.ws + WS_RT + RT_TOPIDX); const float* top_gate = (const float*)(P.ws + WS_RT + RT_TOPGATE);
    int* tok_slot = (int*)(P.ws + WS_RT + RT_TOKSLOT); int* slot_tok = (int*)(P.ws + WS_RT + RT_SLOTTOK); float* slot_gate = (float*)(P.ws + WS_RT + RT_SLOTGATE);
    { const int gw = C.bid * NWAVES + C.wave, NGW = C.G * NWAVES;
      for (int gi = gw; gi < T / 4; gi += NGW) if (C.lane < 16) { const int a = 16 * gi + C.lane;
          const int e = top_idx[a]; const int slot = (int)__hip_atomic_fetch_add(&cur[e], 1u, __ATOMIC_RELAXED, __HIP_MEMORY_SCOPE_WORKGROUP);
          slot_tok[slot] = a >> 2; slot_gate[slot] = top_gate[a]; tok_slot[a] = slot; } }
    if (C.bid == 0) { int* block_e = (int*)(P.ws + WS_RT + RT_BLOCKE);
        for (int nb = C.tid; nb < NBLK; nb += NTHREADS) { int c = 0; for (int e = 0; e < NE; ++e) c += (pad_start[e + 1] <= nb * MOEB) ? 1 : 0; block_e[nb] = c < NE - 1 ? c : NE - 1; }
        if (C.tid == 0) block_e[NBLK] = pad_start[NE] / MOEB; }
    __syncthreads();
    DenseOrder S; S.init(T, D, 256, P.ws + WS_W + (size_t)l * W_LAYER + W_PP, C.G, C.bid);
    EpiB16<0> E{WSP(bf16_t, WS_PLE), D, nullptr};
    gemm_phase(C.lds, C.tid, (const char*)(P.ws + WS_PB + (size_t)l * T * 256 * 2), 256, S, E);
}
template <bool GATHER> __device__ __forceinline__ void moe_order_init(MoeOrder<GATHER>& S, const Params& P, const Ctx& C, int nN, int K, const void* Wt, size_t estride, bool mirror = false) {
    const int* block_e = (const int*)(P.ws + WS_RT + RT_BLOCKE); const int* slot_tok = (const int*)(P.ws + WS_RT + RT_SLOTTOK);
    LAS int* tab = (LAS int*)(C.lds + LDS_TAB); LAS int* ue = (LAS int*)(C.lds + LDS_UE);
    const int nblk = block_e[NBLK];
    S.nN = nN; S.nunits = nblk * nN; S.G = C.G; S.cm = (C.G % 8 == 0) ? (C.bid % 8) * (C.G / 8) + C.bid / 8 : C.bid; if (mirror) S.cm = C.G - 1 - S.cm; S.K = K; S.Wt = (const char*)Wt; S.estride = estride; S.tab = tab; S.ue = ue;
    { int ev[12], tk[12];
#pragma unroll
      for (int i = 0; i < 12; ++i) { const int L = i * S.G + S.cm; const bool ok = L < S.nunits; const int rb = ok ? L / nN : 0;
          ev[i] = (ok && C.tid < 64) ? block_e[rb] : 0; tk[i] = (GATHER && ok && C.tid < 256) ? slot_tok[rb * 256 + C.tid] : 0; }
#pragma unroll
      for (int i = 0; i < 12; ++i) { if (C.tid == 0) ue[i] = ev[i]; if (GATHER && C.tid < 256) tab[i * 256 + C.tid] = tk[i] < 0 ? 0 : tk[i]; } }
    __syncthreads();
}
__device__ __forceinline__ void phase_moe1(const Params& P, const Ctx& C, int l) {
    { DenseOrder S; S.init(T, D, D, P.ws + WS_W + (size_t)l * W_LAYER + W_PG, C.G, C.bid);
      EpiB16<1> E{WSP(bf16_t, WS_TMP), D, WSP(bf16_t, WS_PLE)};
      gemm_phase(C.lds, C.tid, (const char*)(P.ws + WS_H1B), D, S, E); }
    unsigned* ready = ctl_words(P) + CW_MOEC + l * NBLK * 16;
    { MoeOrder<true> S; moe_order_init<true>(S, P, C, 8, D, P.ws + WS_W + (size_t)l * W_LAYER + W_GU, (size_t)2048 * D * 2); S.ready = ready;
      EpiMoe1 E{P, l + 1, C.G, S.nunits, WSP(bf16_t, WS_HM), P.in[19] + (size_t)l * NE * 2048, ready, C.lds};
      gemm_phase(C.lds, C.tid, (const char*)(P.ws + WS_H1B), D, S, E); }
    { MoeOrder<false> S; moe_order_init<false>(S, P, C, 4, DFF, P.ws + WS_W + (size_t)l * W_LAYER + W_DN, (size_t)D * DFF * 2, true); S.ready = ready;
      EpiMoe2 E{WSP(bf16_t, WS_YB), P.in[21] + (size_t)l * NE * D, (const float*)(P.ws + WS_RT + RT_SLOTGATE), C.G, C.lds};
      gemm_phase(C.lds, C.tid, (const char*)(P.ws + WS_HM), DFF, S, E); }
}
__device__ __forceinline__ void phase_moe2(const Params& P, const Ctx& C, int l) {}
__device__ __forceinline__ void phase_ln2(const Params& P, const Ctx& C, int l) {
    const int gw = C.bid * NWAVES + C.wave, NGW = C.G * NWAVES, lane = C.lane;
    const bf16_t* H1B = WSP(bf16_t, WS_H1B); const bf16_t* PLE = WSP(bf16_t, WS_TMP); const bf16_t* Yb = WSP(bf16_t, WS_YB); const int* tok_slot = (const int*)(P.ws + WS_RT + RT_TOKSLOT);
    for (int row0 = gw; row0 < T; row0 += 2 * NGW) {
        int sl[2][4];
#pragma unroll
        for (int k = 0; k < 2; ++k) { const int row = row0 + k * NGW < T ? row0 + k * NGW : row0;
#pragma unroll
            for (int r = 0; r < 4; ++r) sl[k][r] = tok_slot[row * 4 + r]; }
        float v[2][16]; float s[2] = {0.f, 0.f};
#pragma unroll
        for (int k = 0; k < 2; ++k) { const int row = row0 + k * NGW < T ? row0 + k * NGW : row0;
#pragma unroll
            for (int j = 0; j < 4; ++j) { const int c = 4 * lane + 256 * j; const u32x2 hb = *(const u32x2*)(H1B + (size_t)row * D + c); const u32x2 plb = *(const u32x2*)(PLE + (size_t)row * D + c);
                float f[4] = {__uint_as_float(plb.x << 16), __uint_as_float(plb.x & 0xffff0000u), __uint_as_float(plb.y << 16), __uint_as_float(plb.y & 0xffff0000u)};
#pragma unroll
                for (int r = 0; r < 4; ++r) { const u32x2 y = *(const u32x2*)(Yb + (size_t)sl[k][r] * D + c); f[0] += __uint_as_float(y.x << 16); f[1] += __uint_as_float(y.x & 0xffff0000u); f[2] += __uint_as_float(y.y << 16); f[3] += __uint_as_float(y.y & 0xffff0000u); }
                v[k][4 * j] = ALPHA * __uint_as_float(hb.x << 16) + f[0]; v[k][4 * j + 1] = ALPHA * __uint_as_float(hb.x & 0xffff0000u) + f[1];
                v[k][4 * j + 2] = ALPHA * __uint_as_float(hb.y << 16) + f[2]; v[k][4 * j + 3] = ALPHA * __uint_as_float(hb.y & 0xffff0000u) + f[3];
                s[k] += (v[k][4 * j] + v[k][4 * j + 1]) + (v[k][4 * j + 2] + v[k][4 * j + 3]); } }
#pragma unroll
        for (int k = 0; k < 2; ++k) { const int row = row0 + k * NGW; if (row < T) {
            const float mean = wave_sum(s[k]) * (1.f / D); float q = 0.f;
#pragma unroll
            for (int i = 0; i < 16; ++i) { v[k][i] -= mean; q += v[k][i] * v[k][i]; }
            const float rstd = rsqrtf(wave_sum(q) * (1.f / D) + LN_EPS);
            float* of = (l == DEPTH - 1) ? P.out + (size_t)row * D : nullptr;
            ln_store_row(v[k], rstd, P.in[24] + l * D, P.in[25] + l * D, of, (l == DEPTH - 1) ? nullptr : WSP(bf16_t, WS_HB) + (size_t)row * D, lane); } }
    }
}

enum { PH_PRO = 0, PH_INPROJ, PH_GPREP, PH_MIX, PH_GPOST, PH_OUTPROJ, PH_LN1, PH_SCAT, PH_MOE1, PH_MOE2, PH_LN2 };
__device__ __forceinline__ Ctx make_ctx(unsigned char* lds) {
    Ctx C; C.lds = (LAS unsigned char*)lds; C.tid = threadIdx.x; C.lane = C.tid & 63; C.wave = __builtin_amdgcn_readfirstlane(C.tid >> 6); C.G = gridDim.x; C.bid = blockIdx.x; return C;
}
template <int PH> __device__ __forceinline__ void run_phase(const Params& P, const Ctx& C, int l, int rep = 0) {
    if (PH == PH_PRO) phase_prologue(P, C);
    if (PH == PH_INPROJ) phase_inproj(P, C, l);
    if (PH == PH_GPREP) phase_gprep2(P, C, l);
    if (PH == PH_MIX) phase_mix(P, C, l, rep);
    if (PH == PH_GPOST) phase_gpost(P, C, l);
    if (PH == PH_OUTPROJ) phase_outproj(P, C, l);
    if (PH == PH_LN1) phase_ln1(P, C, l, rep);
    if (PH == PH_SCAT) phase_scatter(P, C, l, rep);
    if (PH == PH_MOE1) phase_moe1(P, C, l);
    if (PH == PH_MOE2) phase_moe2(P, C, l);
    if (PH == PH_LN2) phase_ln2(P, C, l);
}
#if MK_MULTI
template <int PH> __global__ void __launch_bounds__(NTHREADS, 2) kphase(Params P, int l) {
    extern __shared__ __attribute__((aligned(16))) unsigned char lds[];
    const Ctx C = make_ctx(lds);
    run_phase<PH>(P, C, l);
}
#else
__device__ __forceinline__ Params load_params() {
    Params r{};
#if defined(__HIP_DEVICE_COMPILE__)
    const __attribute__((address_space(4))) unsigned long long* p = (const __attribute__((address_space(4))) unsigned long long*)__builtin_amdgcn_kernarg_segment_ptr();
    asm volatile("" : "+s"(p));
#pragma unroll
    for (int i = 0; i < 26; ++i) r.in[i] = (const float*)(const __attribute__((address_space(1))) float*)p[i];
    r.out = (float*)(__attribute__((address_space(1))) float*)p[26]; r.ws = (unsigned char*)(__attribute__((address_space(1))) unsigned char*)p[27];
#endif
    return r;
}
__device__ __forceinline__ Ctx make_ctx_opaque(unsigned char* lds) {
    int t = threadIdx.x, b = blockIdx.x, g = gridDim.x; asm volatile("" : "+v"(t)); asm volatile("" : "+s"(b), "+s"(g));
    LAS unsigned char* lp = (LAS unsigned char*)lds; asm volatile("" : "+s"(lp));
    Ctx C; C.lds = lp; C.tid = t; C.lane = t & 63; C.wave = __builtin_amdgcn_readfirstlane(t >> 6); C.G = g; C.bid = b; return C;
}
#define GRID_BAR() do { XcdBarrier b2 = bar; asm volatile("" : "+s"(b2.bar), "+s"(b2.x)); xcd_barrier(b2); } while (0)
#ifndef PROBE_MASK
#define PROBE_MASK 0
#endif
#define PHASE1(PH, l, rep) do { asm volatile("; PHASE_BEGIN " #PH); const Params Pl = load_params(); const Ctx Cl = make_ctx_opaque(lds); run_phase<PH>(Pl, Cl, (l), (rep)); asm volatile("; PHASE_END " #PH); } while (0)
#define PHASE(PH, l) do { PHASE1(PH, l, 0); if ((PROBE_MASK >> PH) & 1) { GRID_BAR(); PHASE1(PH, l, 1); } } while (0)
__global__ void __launch_bounds__(NTHREADS, 2) mega(Params Pk) {
    extern __shared__ __attribute__((aligned(16))) unsigned char lds[];
    const Ctx C = make_ctx(lds);
    if (C.tid < 4) ((LAS unsigned*)(C.lds + LDS_MISC))[C.tid] = 0u;
    __syncthreads();
    XcdBarrier bar;
    { const Params Pl = load_params(); bar = xcd_barrier_post(ctl_words(Pl) + CW_BAR, (volatile LAS unsigned*)(C.lds + LDS_MISC)); }
    PHASE(PH_PRO, 0); GRID_BAR();
#define LAYER(l) do { PHASE(PH_INPROJ, l); GRID_BAR(); PHASE(PH_GPREP, l); GRID_BAR(); PHASE(PH_MIX, l); GRID_BAR(); PHASE(PH_GPOST, l); GRID_BAR(); \
        PHASE(PH_OUTPROJ, l); GRID_BAR(); PHASE(PH_LN1, l); GRID_BAR(); PHASE(PH_SCAT, l); GRID_BAR(); PHASE(PH_MOE1, l); GRID_BAR(); \
        PHASE(PH_LN2, l); if ((l) + 1 < DEPTH) GRID_BAR(); } while (0)
    LAYER(0); LAYER(1); LAYER(2); LAYER(3);
}
#endif
}

extern "C" void kernel_launch(void* const* d_in, const int* in_sizes, int n_in, void* d_out, int out_size, void* d_ws, size_t ws_size, hipStream_t stream) {
    static int grid = 0;
    if (grid == 0) {
        if (n_in != 26 || out_size != T * D || ws_size < WS_END) { fprintf(stderr, "kernel_launch: unexpected shapes (n_in %d out %d ws %zu need %zu)\n", n_in, out_size, ws_size, (size_t)WS_END); grid = -1; return; }
        int dev = 0, cus = 0; hipGetDevice(&dev); hipDeviceGetAttribute(&cus, hipDeviceAttributeMultiprocessorCount, dev);
#if MK_MULTI
#define SETATTR(PH) hipFuncSetAttribute((const void*)kphase<PH>, hipFuncAttributeMaxDynamicSharedMemorySize, LDS_BYTES)
        SETATTR(PH_PRO); SETATTR(PH_INPROJ); SETATTR(PH_GPREP); SETATTR(PH_MIX); SETATTR(PH_GPOST); SETATTR(PH_OUTPROJ); SETATTR(PH_LN1); SETATTR(PH_SCAT); SETATTR(PH_MOE1); SETATTR(PH_MOE2); SETATTR(PH_LN2);
#else
        hipFuncSetAttribute((const void*)mega, hipFuncAttributeMaxDynamicSharedMemorySize, LDS_BYTES);
        int per_cu = 0; hipOccupancyMaxActiveBlocksPerMultiprocessor(&per_cu, (const void*)mega, NTHREADS, LDS_BYTES);
        if (per_cu < 1) fprintf(stderr, "kernel_launch: occupancy query reports %d blocks per CU\n", per_cu);
#endif
        (void)hipGetLastError();
        grid = cus > 0 ? cus : 256;
    }
    if (grid < 0) return;
    hipMemsetAsync((char*)d_ws + WS_CTL, 0, CTL_BYTES, stream);
    Params P{};
    for (int i = 0; i < 26; ++i) P.in[i] = (const float*)d_in[i];
    P.out = (float*)d_out; P.ws = (unsigned char*)d_ws;
#if MK_MULTI
#define LAUNCH(PH, l) hipLaunchKernelGGL(kphase<PH>, dim3(grid), dim3(NTHREADS), LDS_BYTES, stream, P, l)
    LAUNCH(PH_PRO, 0);
    for (int l = 0; l < DEPTH; ++l) {
        LAUNCH(PH_INPROJ, l); LAUNCH(PH_GPREP, l); LAUNCH(PH_MIX, l); LAUNCH(PH_GPOST, l); LAUNCH(PH_OUTPROJ, l);
        LAUNCH(PH_LN1, l); LAUNCH(PH_SCAT, l); LAUNCH(PH_MOE1, l); LAUNCH(PH_MOE2, l); LAUNCH(PH_LN2, l);
    }
#else
    hipLaunchKernelGGL(mega, dim3(grid), dim3(NTHREADS), LDS_BYTES, stream, P);
#endif
}
```

```cpp
#include <hip/hip_runtime.h>
#include <cstdio>
#include <cstdint>

#ifndef MK_MULTI
#define MK_MULTI 0
#endif

namespace {
#define LAS __attribute__((address_space(3)))
typedef unsigned short bf16_t;
typedef short bf16x8 __attribute__((ext_vector_type(8)));
typedef float f32x4 __attribute__((ext_vector_type(4)));
typedef unsigned u32x4 __attribute__((ext_vector_type(4)));
typedef unsigned u32x2 __attribute__((ext_vector_type(2)));
#define ST16_NT(p, v) (*(u32x4*)(p) = (v))
__device__ __forceinline__ void st16_wt(void* p, u32x4 v) { asm volatile("global_store_dwordx4 %0, %1, off sc1\n\ts_nop 2" :: "v"(p), "v"(v) : "memory"); }

constexpr int D = 1024, BATCH = 8, SEQ = 2048, DEPTH = 4, T = BATCH * SEQ;
constexpr int DIN = 3856, NU = 3840, NINP = 4096;
constexpr int U_MQ = 0, U_MK = 256, U_MV = 512, U_MO = 768, U_SQ = 1024, U_SK = 1280, U_SV = 1536, U_GQ = 1792, U_GZ = 3328;
constexpr int NE = 32, DFF = 1024, MOEB = 256;
constexpr int NBLK = (T * 4) / MOEB + NE;
constexpr int PSLOTS = NBLK * MOEB;
constexpr float ALPHA = 1.6817928305074290f;
constexpr float LN_EPS = 1e-5f, NORM_EPS = 1e-6f;
constexpr int NTHREADS = 512, NWAVES = 8;

constexpr size_t MiB = 1u << 20;
constexpr size_t WS_CTL = 0;
constexpr size_t WS_HF = 1 * MiB;
constexpr size_t WS_HB = WS_HF + 64 * MiB;
constexpr size_t WS_H1F = WS_HB + 32 * MiB;
constexpr size_t WS_H1B = WS_H1F + 64 * MiB;
constexpr size_t WS_U16 = WS_H1B + 32 * MiB;
constexpr size_t WS_GT = WS_U16 + 120 * MiB;
constexpr size_t WS_Y = WS_GT + 1 * MiB;
constexpr size_t WS_TMP = WS_Y + 32 * MiB;
constexpr size_t WS_PLE = WS_TMP + 64 * MiB;
constexpr size_t WS_PB = WS_PLE + 64 * MiB;
constexpr size_t WS_GQ = WS_PB + 32 * MiB;
constexpr size_t WS_GK = WS_GQ + 32 * MiB;
constexpr size_t WS_GV = WS_GK + 32 * MiB;
constexpr size_t WS_GO = WS_GV + 32 * MiB;
constexpr size_t WS_HM = WS_GO + 32 * MiB;
constexpr size_t WS_YB = WS_HM + 144 * MiB;
constexpr size_t WS_RT = WS_YB + 144 * MiB;
constexpr size_t RT_TOPIDX = 0, RT_TOPGATE = 256 * 1024, RT_TOKSLOT = 512 * 1024, RT_SLOTTOK = 768 * 1024, RT_SLOTGATE = 1088 * 1024, RT_BLOCKE = 1408 * 1024, RT_WGCNT = 1536 * 1024  ;
constexpr size_t WS_W = WS_RT + 4 * MiB;
constexpr size_t W_IN = 0, W_OUT = 8 * MiB, W_PG = 10 * MiB, W_PP = 12 * MiB, W_GU = 13 * MiB, W_DN = 141 * MiB, W_LAYER = 205 * MiB;
constexpr size_t WS_END = WS_W + 4 * W_LAYER;
constexpr int CW_BAR = 4096;
constexpr int CW_SBQ = 8192;
constexpr int CW_MOEC = 16384;
constexpr size_t CTL_BYTES = 192 * 1024;
static_assert((CW_MOEC + DEPTH * NBLK * 16) * 4 <= (int)CTL_BYTES, "control words inside the per-call memset");

struct Params { const float* in[26]; float* out; unsigned char* ws; };

__device__ __forceinline__ float bf2f(bf16_t b) { return __uint_as_float(((unsigned)b) << 16); }
typedef __bf16 bf16x2_t __attribute__((ext_vector_type(2)));
typedef float f32x2_t __attribute__((ext_vector_type(2)));
__device__ __forceinline__ unsigned cvt_pk_bf16(float lo, float hi) { const f32x2_t v = {lo, hi}; const bf16x2_t b = __builtin_convertvector(v, bf16x2_t); return __builtin_bit_cast(unsigned, b); }
__device__ __forceinline__ unsigned f2bf(float f) { unsigned u = __float_as_uint(f); return (u + 0x7fffu + ((u >> 16) & 1u)) >> 16; }
__device__ __forceinline__ unsigned pk2(float lo, float hi) { return cvt_pk_bf16(lo, hi); }
__device__ __forceinline__ int lane_id_opaque() { int l = (int)__builtin_amdgcn_mbcnt_hi(~0u, __builtin_amdgcn_mbcnt_lo(~0u, 0u)); asm volatile("" : "+v"(l)); return l; }
__device__ __forceinline__ float shx(float v, int o, int lane) { return __uint_as_float((unsigned)__builtin_amdgcn_ds_bpermute((lane ^ o) << 2, (int)__float_as_uint(v))); }
__device__ __forceinline__ int shxi(int v, int o, int lane) { return __builtin_amdgcn_ds_bpermute((lane ^ o) << 2, v); }
__device__ __forceinline__ float wave_sum(float v) {
    const int lane = lane_id_opaque();
#pragma unroll
    for (int o = 32; o >= 1; o >>= 1) v += shx(v, o, lane);
    return v;
}
__device__ __forceinline__ float rl(float x, int d) { return __uint_as_float((unsigned)__builtin_amdgcn_readlane((int)__float_as_uint(x), d)); }
__device__ __forceinline__ float sigmoidf_(float x) { return __builtin_amdgcn_rcpf(1.0f + __expf(-x)); }
__device__ __forceinline__ float softplusf_(float x) { return fmaxf(x, 0.f) + log1pf(__expf(-fabsf(x))); }
__device__ __forceinline__ float siluf_(float x) { return x * sigmoidf_(x); }

#define XB_TMO      128
#define XB_XCNT(j)  (256  + 64 * (j))
#define XB_XSUB(j)  (1280 + 64 * (j))
#define XB_XGEN(j)  (2304 + 64 * (j))
#define XB_TOP      3328
#define XB_TOPGEN   3392
#define XCD_BAR_WORDS 3456
#define XB_SPIN_CAP (1u << 18)
__device__ __forceinline__ unsigned xb_ld(unsigned* p)              { return __hip_atomic_load(p, __ATOMIC_RELAXED, __HIP_MEMORY_SCOPE_AGENT); }
__device__ __forceinline__ unsigned xb_add(unsigned* p, unsigned v) { return __hip_atomic_fetch_add(p, v, __ATOMIC_RELAXED, __HIP_MEMORY_SCOPE_AGENT); }
__device__ __forceinline__ unsigned xb_xcc_id() { return (unsigned)__builtin_amdgcn_s_getreg((3 << 11) | 20) & 0xFu; }
#define XB_SPIN(cond, bar) do { unsigned _sp = 0; while (cond) { __builtin_amdgcn_s_sleep(1); \
    if ((++_sp & 255u) == 0u) { if (xb_ld(&(bar)[XB_TMO])) break; if (_sp > XB_SPIN_CAP) { atomicAdd(&(bar)[XB_TMO], 1u); break; } } } } while (0)
struct XcdBarrier { unsigned* bar; unsigned x; volatile LAS unsigned* st; };
__device__ __forceinline__ XcdBarrier xcd_barrier_post(unsigned* bar, volatile LAS unsigned* st) {
    XcdBarrier b; b.bar = bar; b.x = xb_xcc_id(); b.st = st;
    if (threadIdx.x == 0) (void)xb_add(&bar[XB_XCNT(b.x)], 1u);
    return b;
}
__device__ __forceinline__ void xcd_barrier_complete(unsigned* bar, unsigned x, unsigned& nloc, unsigned& nx) {
    const unsigned G = gridDim.x * gridDim.y * gridDim.z;
    unsigned sum, cnt, mine, sp = 0u;
    for (;;) {
        sum = 0u; cnt = 0u; mine = 0u;
#pragma unroll
        for (unsigned j = 0; j < 16; ++j) { const unsigned c = xb_ld(&bar[XB_XCNT(j)]); sum += c; cnt += (c > 0u) ? 1u : 0u; mine = (j == x) ? c : mine; }
        if (sum == G) break;
        __builtin_amdgcn_s_sleep(1);
        if ((++sp & 255u) == 0u) { if (xb_ld(&bar[XB_TMO])) break; if (sp > XB_SPIN_CAP) { atomicAdd(&bar[XB_TMO], 1u); break; } }
    }
    nloc = mine > 0u ? mine : 1u; nx = cnt > 0u ? cnt : 1u;
}
__device__ __forceinline__ void xcd_barrier(const XcdBarrier& b) {
    asm volatile("s_waitcnt vmcnt(0)" ::: "memory");
    __syncthreads();
    if (threadIdx.x == 0) {
        unsigned* bar = b.bar;
        __builtin_amdgcn_s_waitcnt(0);
        unsigned nloc = b.st[0], nx = b.st[1];
        if (nloc == 0u) { xcd_barrier_complete(bar, b.x, nloc, nx); b.st[0] = nloc; b.st[1] = nx; }
        const unsigned old = xb_add(&bar[XB_XSUB(b.x)], 1u);
        const unsigned gen = old / nloc;
        if (old + 1u == (gen + 1u) * nloc) {
            __builtin_amdgcn_fence(__ATOMIC_RELEASE, "agent");
            asm volatile("s_waitcnt vmcnt(0)" ::: "memory");
            const unsigned og = xb_add(&bar[XB_TOP], 1u);
            const unsigned tg = og / nx;
            if (og + 1u == (tg + 1u) * nx) xb_add(&bar[XB_TOPGEN], 1u);
            else XB_SPIN(xb_ld(&bar[XB_TOPGEN]) == tg, bar);
            __builtin_amdgcn_fence(__ATOMIC_ACQUIRE, "agent");
            xb_add(&bar[XB_XGEN(b.x)], 1u);
            asm volatile("s_waitcnt vmcnt(0)" ::: "memory");
        } else {
            XB_SPIN(xb_ld(&bar[XB_XGEN(b.x)]) == gen, bar);
            __builtin_amdgcn_fence(__ATOMIC_ACQUIRE, "agent");
            asm volatile("s_waitcnt vmcnt(0)" ::: "memory");
        }
    }
    __syncthreads();
}

constexpr int BM = 256, BK = 64, HALF = 128, HTB = HALF * BK * 2, STAGE_BYTES = 8 * HTB, NXCD = 8, WGM = 8;
constexpr int LDS_TAB = STAGE_BYTES;
constexpr int LDS_UE = LDS_TAB + 12288;
constexpr int LDS_MISC = LDS_UE + 64;
constexpr int LDS_BIAS = LDS_MISC + 64;
constexpr int LDS_BYTES = 151552;
static_assert(LDS_BIAS + 4096 <= LDS_BYTES, "LDS");
__host__ __device__ __forceinline__ int lds_byte(int r, int c) { const int st = (r >> 4) * 2 + (c >> 5), rr = r & 15, cc = c & 31, ob = rr * 64 + cc * 2; return st * 1024 + (ob ^ (((ob >> 9) & 1) << 5)); }
__host__ __device__ __forceinline__ void stage_rc(int b, int& R, int& C) { const int st = b / 1024, sb = b % 1024, swz = sb ^ (((sb >> 9) & 1) << 5); R = (st >> 1) * 16 + swz / 64; C = (st & 1) * 32 + (swz % 64) / 2; }
__host__ __device__ __forceinline__ int perm32(int rho) { const int n = rho >> 4, i = rho & 15; return 8 * (i >> 2) + 4 * n + (i & 3); }

constexpr int CV_IN = 16 * 31, CV_OUT = 16 * 8, CV_PG = 16 * 8, CV_PP = 4 * 8, CV_GU1 = 16 * 16, CV_DN1 = 16 * 8;
constexpr int CV_LAYER = CV_IN + CV_OUT + CV_PG + CV_PP + NE * CV_GU1 + NE * CV_DN1;
struct Unit { int pm, pn, e, L; };
__device__ __forceinline__ void convert_item(const Params& P, int l, int r, int lane);

struct DenseOrder {
    int nM, nN, nwg, G, c, K; const char* Bt;
    __device__ void init(int M, int N, int K_, const void* Bt_, int G_, int c_) { nM = M / BM; nN = N / BM; nwg = nM * nN; G = G_; c = c_; K = K_; Bt = (const char*)Bt_; }
    __device__ __forceinline__ bool next(int i, Unit& u) const {
        const long L = (long)i * G + c; if (L >= nwg) return false;
        int wgid = (int)L; { const int q = nwg / NXCD, r = nwg % NXCD, xcd = wgid % NXCD, off = wgid / NXCD; wgid = (xcd < r ? xcd * (q + 1) : r * (q + 1) + (xcd - r) * q) + off; }
        const int nig = WGM * nN, gid = wgid / nig, fm = gid * WGM, gsz = (nM - fm) < WGM ? (nM - fm) : WGM;
        u.pm = fm + ((wgid % nig) % gsz); u.pn = (wgid % nig) / gsz; u.e = 0; u.L = (int)L; return true;
    }
    __device__ __forceinline__ const char* b_base(const Unit& u) const { return Bt + (size_t)u.pn * BM * K * 2; }
    __device__ __forceinline__ void a_ready(const Unit&) const {}
    __device__ __forceinline__ unsigned a_off(int, const Unit& u, int row) const { return (unsigned)(u.pm * BM + row) * (unsigned)(K * 2); }
};
template <bool GATHER> struct MoeOrder {
    int nN, nunits, G, cm, K; const char* Wt; size_t estride; const LAS int* tab; const LAS int* ue;
    unsigned* ready;
    __device__ __forceinline__ void a_ready(const Unit& u) const {
        if (GATHER) return;
        if (threadIdx.x < 64) {
            unsigned sp = 0;
            while ((unsigned)__builtin_amdgcn_readfirstlane(__hip_atomic_load(ready + 16 * u.pm, __ATOMIC_RELAXED, __HIP_MEMORY_SCOPE_AGENT)) < 64u) { __builtin_amdgcn_s_sleep(2); if (++sp > (1u << 21)) break; }
            __builtin_amdgcn_fence(__ATOMIC_ACQUIRE, "agent");
            asm volatile("s_waitcnt vmcnt(0)" ::: "memory");
        }
        asm volatile("" ::: "memory"); __builtin_amdgcn_s_barrier(); asm volatile("" ::: "memory");
    }
    __device__ __forceinline__ bool next(int i, Unit& u) const {
        const int L = i * G + cm; if (L >= nunits) return false;
        u.pm = L / nN; u.pn = L - u.pm * nN; u.e = ue[i]; u.L = L; return true;
    }
    __device__ __forceinline__ const char* b_base(const Unit& u) const { return Wt + (size_t)u.e * estride + (size_t)u.pn * BM * K * 2; }
    __device__ __forceinline__ unsigned a_off(int i, const Unit& u, int row) const {
        if (GATHER) return (unsigned)tab[i * 256 + row] * (unsigned)(K * 2);
        return (unsigned)(u.pm * BM + row) * (unsigned)(K * 2);
    }
};

template <class Epi, class Sched>
__device__ __forceinline__ void gemm_phase(LAS unsigned char* lds, const int tid, const char* Abase, const int K, const Sched& S, const Epi& E) {
    const int wid = __builtin_amdgcn_readfirstlane(tid >> 6), lane = tid & 63, wr = wid >> 2, wc = wid & 3, fr = lane & 15, fq = lane >> 4;
    const int nt = K / BK;
    int Rr[2]; unsigned cb[2], voffB[2];
#pragma unroll
    for (int i = 0; i < 2; ++i) { int R, C; stage_rc(tid * 16 + i * 8192, R, C); const int Rb = Epi::PERM ? ((R & ~31) + perm32(R & 31)) : R;
        Rr[i] = R; cb[i] = (unsigned)C * 2u; voffB[i] = (unsigned)(Rb * K + C) * 2u; }
    const size_t kstep = (size_t)(BK * 2);
    const size_t hstep = (size_t)HALF * K * 2;
    const unsigned ldsw = (unsigned)wid * 1024u;
    const int aoff = lds_byte(wr * 64 + fr, fq * 8), boff = lds_byte(wc * 32 + fr, fq * 8);
#define G_SA(b, h) (((b) * 2 + (h)) * HTB)
#define G_SB(b, h) ((4 + (b) * 2 + (h)) * HTB)
#define G_STAGE_B(bufoff, gbase) do { _Pragma("unroll") for (int _i = 0; _i < 2; ++_i) \
        __builtin_amdgcn_global_load_lds((const unsigned*)((const char*)(gbase) + voffB[_i]), (LAS unsigned*)(lds + (bufoff) + ldsw + _i * 8192), 16, 0, 0); } while (0)
#define G_STAGE_A(bufoff, kbyte, ao) do { _Pragma("unroll") for (int _i = 0; _i < 2; ++_i) \
        __builtin_amdgcn_global_load_lds((const unsigned*)(Abase + (size_t)(kbyte) + (ao)[_i]), (LAS unsigned*)(lds + (bufoff) + ldsw + _i * 8192), 16, 0, 0); } while (0)
#define G_LDA(dst, b, h) do { _Pragma("unroll") for (int m = 0; m < 4; ++m) _Pragma("unroll") for (int k = 0; k < 2; ++k) dst[m][k] = *(const LAS bf16x8*)(lds + G_SA(b, h) + aoff + m * 2048 + k * 1024); } while (0)
#define G_LDB(dst, b, h) do { _Pragma("unroll") for (int n = 0; n < 2; ++n) _Pragma("unroll") for (int k = 0; k < 2; ++k) dst[n][k] = *(const LAS bf16x8*)(lds + G_SB(b, h) + boff + n * 2048 + k * 1024); } while (0)
#define G_MMA(ai, bj, At, Bt) do { __builtin_amdgcn_s_setprio(1); _Pragma("unroll") for (int m = 0; m < 4; ++m) _Pragma("unroll") for (int n = 0; n < 2; ++n) _Pragma("unroll") for (int k = 0; k < 2; ++k) \
        acc[ai][bj][m][n] = __builtin_amdgcn_mfma_f32_16x16x32_bf16(Bt[n][k], At[m][k], acc[ai][bj][m][n], 0, 0, 0); __builtin_amdgcn_s_setprio(0); } while (0)
#define G_WAIT_V(n) asm volatile("s_waitcnt vmcnt(" #n ")" ::: "memory")
#define G_WAIT_L(n) asm volatile("s_waitcnt lgkmcnt(" #n ")" ::: "memory")
#define G_BAR __builtin_amdgcn_s_barrier()
#define G_SCHED __builtin_amdgcn_sched_barrier(0)
    Unit cur, nxt; int ui = 0;
    if (!S.next(0, cur)) return;
    f32x4 acc[2][2][4][2];
#pragma unroll
    for (int a = 0; a < 2; ++a)
#pragma unroll
        for (int b = 0; b < 2; ++b)
#pragma unroll
            for (int m = 0; m < 4; ++m)
#pragma unroll
                for (int n = 0; n < 2; ++n) acc[a][b][m][n] = (f32x4){0.f, 0.f, 0.f, 0.f};
    bf16x8 At[4][2], B0[2][2], B1[2][2];
    unsigned aoc[2][2], aon[2][2];
#pragma unroll
    for (int h = 0; h < 2; ++h)
#pragma unroll
        for (int i = 0; i < 2; ++i) aoc[h][i] = S.a_off(0, cur, h * HALF + Rr[i]) + cb[i];
    const char* cB = S.b_base(cur);
    S.a_ready(cur);
    Unit prv = cur; bool have_prv = false;
    G_STAGE_B(G_SB(0, 0), cB); G_STAGE_A(G_SA(0, 0), 0, aoc[0]); G_STAGE_B(G_SB(0, 1), cB + hstep); G_STAGE_A(G_SA(0, 1), 0, aoc[1]);
    if (wr == 1) G_BAR;
    G_WAIT_V(4); G_BAR;
    G_STAGE_B(G_SB(1, 0), cB + kstep); G_STAGE_A(G_SA(1, 0), kstep, aoc[0]); G_STAGE_B(G_SB(1, 1), cB + hstep + kstep);
    G_WAIT_V(6); G_BAR;
    for (;;) {
        const bool has_next = S.next(ui + 1, nxt);
        E.stage(cur, wid, lane);
        const char* nB = has_next ? S.b_base(nxt) : cB;
#pragma unroll
        for (int h = 0; h < 2; ++h)
#pragma unroll
            for (int i = 0; i < 2; ++i) aon[h][i] = has_next ? (S.a_off(ui + 1, nxt, h * HALF + Rr[i]) + cb[i]) : aoc[h][i];
        for (int t = 0; t < nt; t += 2) {
            const bool last = (t == nt - 2);
            if (last) { if (have_prv) { E.publish(prv, lane); have_prv = false; } if (has_next) S.a_ready(nxt); }
            const size_t k1 = (size_t)(t + 1) * kstep;
            const size_t k2 = last ? (size_t)0 : (size_t)(t + 2) * kstep;
            const char* b2 = last ? nB : cB + (size_t)(t + 2) * kstep;
            const char* b3 = b2 + kstep;
            unsigned a2o[2][2];
#pragma unroll
            for (int h = 0; h < 2; ++h)
#pragma unroll
                for (int i = 0; i < 2; ++i) a2o[h][i] = last ? aon[h][i] : aoc[h][i];
            G_LDB(B0, 0, 0); G_SCHED; G_LDA(At, 0, 0); G_STAGE_A(G_SA(1, 1), k1, aoc[1]);
            G_WAIT_L(8); G_BAR; G_WAIT_L(0); G_MMA(0, 0, At, B0); G_BAR; G_SCHED;
            G_LDB(B1, 0, 1); G_STAGE_B(G_SB(0, 0), b2);
            G_BAR; G_WAIT_L(0); G_MMA(0, 1, At, B1); G_BAR;
            G_LDA(At, 0, 1); G_STAGE_A(G_SA(0, 0), k2, a2o[0]);
            G_BAR; G_WAIT_L(0); G_MMA(1, 0, At, B0); G_BAR; G_SCHED;
            G_STAGE_B(G_SB(0, 1), b2 + hstep);
            G_WAIT_V(6); G_BAR; G_MMA(1, 1, At, B1); G_BAR;
            G_LDB(B0, 1, 0); G_SCHED; G_LDA(At, 1, 0); G_STAGE_A(G_SA(0, 1), k2, a2o[1]);
            G_WAIT_L(8); G_BAR; G_WAIT_L(0); G_MMA(0, 0, At, B0); G_BAR; G_SCHED;
            G_LDB(B1, 1, 1); G_STAGE_B(G_SB(1, 0), b3);
            G_BAR; G_WAIT_L(0); G_MMA(0, 1, At, B1); G_BAR;
            G_LDA(At, 1, 1); G_STAGE_A(G_SA(1, 0), k2 + kstep, a2o[0]);
            G_BAR; G_WAIT_L(0); G_MMA(1, 0, At, B0); G_BAR; G_SCHED;
            G_STAGE_B(G_SB(1, 1), b3 + hstep);
            G_WAIT_V(6); G_BAR; G_MMA(1, 1, At, B1); G_BAR;
        }
        E(acc, cur, wr, wc, fr, fq);
        prv = cur; have_prv = true;
        E.after_unit(cur, wid, lane);
        if (!has_next) break;
#pragma unroll
        for (int a = 0; a < 2; ++a)
#pragma unroll
            for (int b = 0; b < 2; ++b)
#pragma unroll
                for (int m = 0; m < 4; ++m)
#pragma unroll
                    for (int n = 0; n < 2; ++n) acc[a][b][m][n] = (f32x4){0.f, 0.f, 0.f, 0.f};
        cur = nxt; cB = nB; ++ui;
#pragma unroll
        for (int h = 0; h < 2; ++h)
#pragma unroll
            for (int i = 0; i < 2; ++i) aoc[h][i] = aon[h][i];
    }
    G_WAIT_V(0);
    if (have_prv) E.publish(prv, lane);
    if (wr == 0) G_BAR;
    G_BAR;
#undef G_SA
#undef G_SB
#undef G_STAGE_A
#undef G_STAGE_B
#undef G_LDA
#undef G_LDB
#undef G_MMA
#undef G_WAIT_V
#undef G_WAIT_L
#undef G_BAR
#undef G_SCHED
}

struct EpiU {
    static constexpr bool PERM = true;
    __device__ __forceinline__ void after_unit(const Unit&, int, int) const {}
    __device__ __forceinline__ void publish(const Unit&, int) const {}
    __device__ __forceinline__ void stage(const Unit&, int, int) const {}
    bf16_t* U; float* GT;
    __device__ __forceinline__ void operator()(const f32x4 (&acc)[2][2][4][2], const Unit& u, int wr, int wc, int fr, int fq) const {
        const int row0 = u.pm * BM + wr * 64 + fr;
        if (u.pn < 15) {
            const int col0 = u.pn * BM + wc * 32 + 8 * fq;
#pragma unroll
            for (int ai = 0; ai < 2; ++ai)
#pragma unroll
                for (int m = 0; m < 4; ++m) { bf16_t* rowp = U + (size_t)(row0 + ai * HALF + m * 16) * NU + col0;
#pragma unroll
                    for (int bj = 0; bj < 2; ++bj) { const f32x4 v0 = acc[ai][bj][m][0], v1 = acc[ai][bj][m][1];
                        u32x4 w; w.x = cvt_pk_bf16(v0[0], v0[1]); w.y = cvt_pk_bf16(v0[2], v0[3]); w.z = cvt_pk_bf16(v1[0], v1[1]); w.w = cvt_pk_bf16(v1[2], v1[3]);
                        ST16_NT(rowp + bj * HALF, w); } }
        } else if (wc == 0 && fq < 2) {
#pragma unroll
            for (int ai = 0; ai < 2; ++ai)
#pragma unroll
                for (int m = 0; m < 4; ++m) { float* rowp = GT + (size_t)(row0 + ai * HALF + m * 16) * 16 + 8 * fq;
#pragma unroll
                    for (int n = 0; n < 2; ++n) *(f32x4*)(rowp + 4 * n) = acc[ai][0][m][n]; }
        }
    }
};
template <int MODE  > struct EpiF32 {
    static constexpr bool PERM = false;
    __device__ __forceinline__ void after_unit(const Unit&, int, int) const {}
    __device__ __forceinline__ void publish(const Unit&, int) const {}
    __device__ __forceinline__ void stage(const Unit&, int, int) const {}
    float* C; int ldc; const float* Src;
    __device__ __forceinline__ void operator()(const f32x4 (&acc)[2][2][4][2], const Unit& u, int wr, int wc, int fr, int fq) const {
        const int row0 = u.pm * BM + wr * 64 + fr, col0 = u.pn * BM + wc * 32 + 4 * fq;
#pragma unroll
        for (int ai = 0; ai < 2; ++ai)
#pragma unroll
            for (int m = 0; m < 4; ++m) { float* rowp = C + (size_t)(row0 + ai * HALF + m * 16) * ldc + col0;
#pragma unroll
                for (int bj = 0; bj < 2; ++bj)
#pragma unroll
                    for (int n = 0; n < 2; ++n) { f32x4 v = acc[ai][bj][m][n];
                        if (MODE == 1) { const f32x4 o = *(const f32x4*)(Src + (size_t)(row0 + ai * HALF + m * 16) * ldc + col0 + bj * HALF + n * 16);
#pragma unroll
                            for (int j = 0; j < 4; ++j) v[j] = sigmoidf_(v[j]) * o[j]; }
                        *(f32x4*)(rowp + bj * HALF + n * 16) = v; } }
    }
};
template <int MODE  > struct EpiB16 {
    static constexpr bool PERM = true;
    __device__ __forceinline__ void after_unit(const Unit&, int, int) const {}
    __device__ __forceinline__ void publish(const Unit&, int) const {}
    __device__ __forceinline__ void stage(const Unit&, int, int) const {}
    bf16_t* O; int ldc; const bf16_t* Src;
    __device__ __forceinline__ void operator()(const f32x4 (&acc)[2][2][4][2], const Unit& u, int wr, int wc, int fr, int fq) const {
        const int row0 = u.pm * BM + wr * 64 + fr, col0 = u.pn * BM + wc * 32 + 8 * fq;
#pragma unroll
        for (int ai = 0; ai < 2; ++ai)
#pragma unroll
            for (int m = 0; m < 4; ++m) { const size_t off = (size_t)(row0 + ai * HALF + m * 16) * ldc + col0;
#pragma unroll
                for (int bj = 0; bj < 2; ++bj) { f32x4 v0 = acc[ai][bj][m][0], v1 = acc[ai][bj][m][1];
                    if (MODE == 1) { const u32x4 g = *(const u32x4*)(Src + off + bj * HALF);
                        v0[0] = sigmoidf_(v0[0]) * __uint_as_float(g.x << 16); v0[1] = sigmoidf_(v0[1]) * __uint_as_float(g.x & 0xffff0000u); v0[2] = sigmoidf_(v0[2]) * __uint_as_float(g.y << 16); v0[3] = sigmoidf_(v0[3]) * __uint_as_float(g.y & 0xffff0000u);
                        v1[0] = sigmoidf_(v1[0]) * __uint_as_float(g.z << 16); v1[1] = sigmoidf_(v1[1]) * __uint_as_float(g.z & 0xffff0000u); v1[2] = sigmoidf_(v1[2]) * __uint_as_float(g.w << 16); v1[3] = sigmoidf_(v1[3]) * __uint_as_float(g.w & 0xffff0000u); }
                    u32x4 w; w.x = cvt_pk_bf16(v0[0], v0[1]); w.y = cvt_pk_bf16(v0[2], v0[3]); w.z = cvt_pk_bf16(v1[0], v1[1]); w.w = cvt_pk_bf16(v1[2], v1[3]);
                    *(u32x4*)(O + off + bj * HALF) = w; } }
    }
};
struct EpiMoe1 {
    static constexpr bool PERM = true;
    Params Pc; int lnext, G, nunits;
    __device__ __forceinline__ void after_unit(const Unit& u, int wid, int lane) const {
        if (lnext >= DEPTH) return;
        const int i = u.L / G, c = u.L - i * G;
        if (i != (c & 7)) return;
        const int n9 = nunits - 8 * G > 0 ? (nunits - 8 * G < G ? nunits - 8 * G : G) : 0, n8 = G - n9;
        int x = (CV_LAYER / NWAVES - 3 * n8 + G - 1) / G; if (x < 0) x = 0;
        const int cnt = c < n9 ? x : x + 3, start = c < n9 ? c * NWAVES * x : n9 * NWAVES * x + (c - n9) * NWAVES * (x + 3);
        for (int k = 0; k < cnt; ++k) { const int idx = start + wid * cnt + k; if (idx < CV_LAYER) convert_item(Pc, lnext, idx, lane); }
    }
    bf16_t* H; const float* b_gu;
    unsigned* ready;
    LAS unsigned char* lds;
    __device__ __forceinline__ void stage(const Unit& u, int wid, int lane) const {
        if (wid == 0) { const float* src = b_gu + (size_t)u.e * 2048 + (lane >> 5) * 1024 + u.pn * HALF + (lane & 31) * 4;
            __builtin_amdgcn_global_load_lds((const unsigned*)src, (LAS unsigned*)(lds + LDS_BIAS + ((u.L / G) & 1) * 2048), 16, 0, 0); }
    }
    __device__ __forceinline__ void publish(const Unit& u, int lane) const { if (lane == 0) __hip_atomic_fetch_add(ready + 16 * u.pm, 1u, __ATOMIC_RELAXED, __HIP_MEMORY_SCOPE_AGENT); }
    __device__ __forceinline__ void operator()(const f32x4 (&acc)[2][2][4][2], const Unit& u, int wr, int wc, int fr, int fq) const {
        const int row0 = u.pm * BM + wr * 64 + fr, col0 = u.pn * HALF + wc * 32 + 8 * fq;
        f32x4 bg[2], bu[2];
#pragma unroll
        for (int n = 0; n < 2; ++n) { const LAS float* bl = (const LAS float*)(lds + LDS_BIAS + ((u.L / G) & 1) * 2048) + wc * 32 + 8 * fq + 4 * n; bg[n] = *(const LAS f32x4*)bl; bu[n] = *(const LAS f32x4*)(bl + 128); }
#pragma unroll
        for (int ai = 0; ai < 2; ++ai)
#pragma unroll
            for (int m = 0; m < 4; ++m) { float o[8];
#pragma unroll
                for (int n = 0; n < 2; ++n)
#pragma unroll
                    for (int jp = 0; jp < 2; ++jp) {
                        typedef float f32x2 __attribute__((ext_vector_type(2)));
                        f32x2 g = (f32x2){acc[ai][0][m][n][2 * jp], acc[ai][0][m][n][2 * jp + 1]} + (f32x2){bg[n][2 * jp], bg[n][2 * jp + 1]};
                        f32x2 up = (f32x2){acc[ai][1][m][n][2 * jp], acc[ai][1][m][n][2 * jp + 1]} + (f32x2){bu[n][2 * jp], bu[n][2 * jp + 1]};
                        g.x = fminf(g.x, 7.0f); g.y = fminf(g.y, 7.0f); up.x = fminf(fmaxf(up.x, -7.0f), 7.0f); up.y = fminf(fmaxf(up.y, -7.0f), 7.0f);
                        const f32x2 t = g * (f32x2){-1.702f * 1.4426950408889634f, -1.702f * 1.4426950408889634f};
                        f32x2 d = (f32x2){__builtin_amdgcn_exp2f(t.x), __builtin_amdgcn_exp2f(t.y)} + (f32x2){1.0f, 1.0f};
                        const f32x2 r = (f32x2){__builtin_amdgcn_rcpf(d.x), __builtin_amdgcn_rcpf(d.y)};
                        const f32x2 res = (up + (f32x2){1.0f, 1.0f}) * g * r;
                        o[n * 4 + 2 * jp] = res.x; o[n * 4 + 2 * jp + 1] = res.y; }
                u32x4 w; w.x = cvt_pk_bf16(o[0], o[1]); w.y = cvt_pk_bf16(o[2], o[3]); w.z = cvt_pk_bf16(o[4], o[5]); w.w = cvt_pk_bf16(o[6], o[7]);
                st16_wt(H + (size_t)(row0 + ai * HALF + m * 16) * DFF + col0, w); }
    }
};
struct EpiMoe2 {
    static constexpr bool PERM = true;
    __device__ __forceinline__ void after_unit(const Unit&, int, int) const {}
    __device__ __forceinline__ void publish(const Unit&, int) const {}
    bf16_t* Yb; const float* b_down; const float* slot_gate; int G; LAS unsigned char* lds;
    __device__ __forceinline__ void stage(const Unit& u, int wid, int lane) const {
        if (wid == 0) { LAS unsigned char* dst = lds + LDS_BIAS + ((u.L / G) & 1) * 2048;
            __builtin_amdgcn_global_load_lds((const unsigned*)(b_down + (size_t)u.e * D + u.pn * BM + lane * 4), (LAS unsigned*)dst, 16, 0, 0);
            __builtin_amdgcn_global_load_lds((const unsigned*)(slot_gate + (size_t)u.pm * BM + lane * 4), (LAS unsigned*)(dst + 1024), 16, 0, 0); }
    }
    __device__ __forceinline__ void operator()(const f32x4 (&acc)[2][2][4][2], const Unit& u, int wr, int wc, int fr, int fq) const {
        const int row0 = u.pm * BM + wr * 64 + fr, col0 = u.pn * BM + wc * 32 + 8 * fq;
        f32x4 bv[2][2];
#pragma unroll
        for (int bj = 0; bj < 2; ++bj)
#pragma unroll
            for (int n = 0; n < 2; ++n) bv[bj][n] = *(const LAS f32x4*)((const LAS float*)(lds + LDS_BIAS + ((u.L / G) & 1) * 2048) + wc * 32 + 8 * fq + bj * HALF + 4 * n);
#pragma unroll
        for (int ai = 0; ai < 2; ++ai)
#pragma unroll
            for (int m = 0; m < 4; ++m) { const int row = row0 + ai * HALF + m * 16; const float gt = ((const LAS float*)(lds + LDS_BIAS + ((u.L / G) & 1) * 2048 + 1024))[wr * 64 + fr + ai * HALF + m * 16];
#pragma unroll
                for (int bj = 0; bj < 2; ++bj) { const f32x4 v0 = (acc[ai][bj][m][0] + bv[bj][0]) * gt, v1 = (acc[ai][bj][m][1] + bv[bj][1]) * gt;
                    u32x4 w; w.x = cvt_pk_bf16(v0[0], v0[1]); w.y = cvt_pk_bf16(v0[2], v0[3]); w.z = cvt_pk_bf16(v1[0], v1[1]); w.w = cvt_pk_bf16(v1[2], v1[3]);
                    ST16_NT(Yb + (size_t)row * D + col0 + bj * HALF, w); } }
    }
};

struct Ctx {
    LAS unsigned char* lds; int tid, lane, wave, G, bid;
};
#define WSP(T_, off) ((T_*)(P.ws + (off)))
__device__ __forceinline__ unsigned* ctl_words(const Params& P) { return (unsigned*)(P.ws + WS_CTL); }

__device__ __forceinline__ int map_win(int n) { return n < 1024 ? n : (n < 1032 ? n + 2816 : (n < 3848 ? n - 8 : n)); }
__device__ __forceinline__ int map_wgu(int n) { return n < 1024 ? ((n >> 7) * 256 + (n & 127)) : ((((n - 1024) >> 7) * 256) + 128 + ((n - 1024) & 127)); }
__device__ __forceinline__ void transpose_item(const float* W, int K, int N, bf16_t* WT, int map, int item, int lane) {
    const int nblk = (N + 127) / 128, kb = item / nblk, nb = item - kb * nblk;
    const int kg = lane & 7, ng = lane >> 3, k0 = kb * 64 + 8 * kg, n0 = nb * 128 + 4 * ng;
    f32x4 v[4][8];
#pragma unroll
    for (int q = 0; q < 4; ++q) { const int n = n0 + 32 * q, nn = n < N ? n : 0;
#pragma unroll
        for (int i = 0; i < 8; ++i) v[q][i] = *(const f32x4*)(W + (size_t)(k0 + i) * N + nn); }
#pragma unroll
    for (int q = 0; q < 4; ++q) { const int n = n0 + 32 * q;
        if (n < N) {
#pragma unroll
            for (int j = 0; j < 4; ++j) { const int ngl = n + j; const int nr = map == 1 ? map_win(ngl) : (map == 2 ? map_wgu(ngl) : ngl);
                u32x4 o;
#pragma unroll
                for (int x = 0; x < 4; ++x) o[x] = cvt_pk_bf16(v[q][2 * x][j], v[q][2 * x + 1][j]);
                *(u32x4*)(WT + (size_t)nr * K + k0) = o; } } }
}
__device__ __forceinline__ void convert_item(const Params& P, int l, int r, int lane) {
    unsigned char* wl = P.ws + WS_W + (size_t)l * W_LAYER;
    const float* W; bf16_t* WT; int K = D, N = D, map = 0;
    if (r < CV_IN) { W = P.in[4] + (size_t)l * D * DIN; N = DIN; WT = (bf16_t*)(wl + W_IN); map = 1; }
    else if ((r -= CV_IN) < CV_OUT) { W = P.in[13] + (size_t)l * D * D; WT = (bf16_t*)(wl + W_OUT); }
    else if ((r -= CV_OUT) < CV_PG) { W = P.in[22] + (size_t)l * D * D; WT = (bf16_t*)(wl + W_PG); }
    else if ((r -= CV_PG) < CV_PP) { W = P.in[23] + (size_t)l * 256 * D; K = 256; WT = (bf16_t*)(wl + W_PP); }
    else if ((r -= CV_PP) < NE * CV_GU1) { const int e = r / CV_GU1; r -= e * CV_GU1; W = P.in[18] + ((size_t)l * NE + e) * D * 2048; N = 2048; WT = (bf16_t*)(wl + W_GU) + (size_t)e * 2048 * D; map = 2; }
    else { r -= NE * CV_GU1; const int e = r / CV_DN1; r -= e * CV_DN1; W = P.in[20] + ((size_t)l * NE + e) * DFF * D; WT = (bf16_t*)(wl + W_DN) + (size_t)e * D * DFF; }
    transpose_item(W, K, N, WT, map, r, lane);
}
__device__ __forceinline__ void ln_store_row(const float (&v)[16], float rstd, const float* g, const float* b, float* of, bf16_t* ob, int lane) {
#pragma unroll
    for (int j = 0; j < 4; ++j) { const int c = 4 * lane + 256 * j; const f32x4 gg = *(const f32x4*)(g + c), bb = *(const f32x4*)(b + c);
        f32x4 o; o[0] = v[4 * j] * rstd * gg[0] + bb[0]; o[1] = v[4 * j + 1] * rstd * gg[1] + bb[1]; o[2] = v[4 * j + 2] * rstd * gg[2] + bb[2]; o[3] = v[4 * j + 3] * rstd * gg[3] + bb[3];
        if (of) *(f32x4*)(of + c) = o;
        if (ob) { u32x2 w; w.x = pk2(o[0], o[1]); w.y = pk2(o[2], o[3]); *(u32x2*)(ob + c) = w; } }
}
__device__ __forceinline__ void phase_prologue(const Params& P, const Ctx& C) {
    const int gw = C.bid * NWAVES + C.wave, NGW = C.G * NWAVES;
    for (int it = gw; it < CV_LAYER; it += NGW) convert_item(P, 0, it, C.lane);
    { const float* p = P.in[1]; bf16_t* pb = WSP(bf16_t, WS_PB); const size_t n4 = (size_t)DEPTH * T * 256 / 4;
      const size_t stride = (size_t)C.G * NTHREADS;
      for (size_t i0 = (size_t)C.bid * NTHREADS + C.tid; i0 < n4; i0 += 8 * stride) {
          f32x4 v[8];
#pragma unroll
          for (int k = 0; k < 8; ++k) { const size_t i = i0 + k * stride; if (i < n4) v[k] = *(const f32x4*)(p + 4 * i); }
#pragma unroll
          for (int k = 0; k < 8; ++k) { const size_t i = i0 + k * stride; if (i < n4) { u32x2 w; w.x = pk2(v[k][0], v[k][1]); w.y = pk2(v[k][2], v[k][3]); *(u32x2*)(pb + 4 * i) = w; } } } }
    for (int row0 = gw; row0 < T; row0 += 2 * NGW) {
        float v[2][16]; float s[2] = {0.f, 0.f};
#pragma unroll
        for (int k = 0; k < 2; ++k) { const int row = row0 + k * NGW < T ? row0 + k * NGW : row0; const float* x = P.in[0] + (size_t)row * D;
#pragma unroll
            for (int j = 0; j < 4; ++j) { const f32x4 t = *(const f32x4*)(x + 4 * C.lane + 256 * j); v[k][4 * j] = t[0]; v[k][4 * j + 1] = t[1]; v[k][4 * j + 2] = t[2]; v[k][4 * j + 3] = t[3]; s[k] += (t[0] + t[1]) + (t[2] + t[3]); } }
#pragma unroll
        for (int k = 0; k < 2; ++k) { const int row = row0 + k * NGW; if (row < T) {
            const float mean = wave_sum(s[k]) * (1.f / D); float q = 0.f;
#pragma unroll
            for (int i = 0; i < 16; ++i) { v[k][i] -= mean; q += v[k][i] * v[k][i]; }
            const float rstd = rsqrtf(wave_sum(q) * (1.f / D) + LN_EPS);
            ln_store_row(v[k], rstd, P.in[2], P.in[3], nullptr, WSP(bf16_t, WS_HB) + (size_t)row * D, C.lane); } }
    }
}

__device__ __forceinline__ void phase_inproj(const Params& P, const Ctx& C, int l) {
    DenseOrder S; S.init(T, NINP, D, P.ws + WS_W + (size_t)l * W_LAYER + W_IN, C.G, C.bid);
    EpiU E{WSP(bf16_t, WS_U16), WSP(float, WS_GT)};
    gemm_phase(C.lds, C.tid, (const char*)(P.ws + WS_HB), D, S, E);
}

typedef float f32x16 __attribute__((ext_vector_type(16)));
#define MFMA32(a, b, c) __builtin_amdgcn_mfma_f32_32x32x16_bf16((a), (b), (c), 0, 0, 0)
constexpr int SB_KSTR = 72, SB_VSTR = 68, SB_KBYTES = 64 * SB_KSTR * 2, SB_BUF = SB_KBYTES + 64 * SB_VSTR * 2;
__device__ __forceinline__ float shx32(float v, int lane) { return __uint_as_float((unsigned)__builtin_amdgcn_ds_bpermute((lane ^ 32) << 2, (int)__float_as_uint(v))); }
template <bool DIAG> __device__ __forceinline__ void sb_tile_math(const f32x16& sacc, float& carry, bf16x8 (&pf)[2], int r, int hh, int lane) {
    float sg[16], om[16];
#pragma unroll
    for (int i = 0; i < 16; ++i) {
        const float t = fminf(sacc[i] * (-0.125f * 1.4426950408889634f), 80.f);
        const float e = __builtin_amdgcn_exp2f(t);
        float sgm = __builtin_amdgcn_rcpf(1.0f + e), omv = e * sgm;
        if (DIAG) { const int srow_i = (i & 3) + 8 * (i >> 2) + 4 * hh; const bool masked = srow_i >= r; sgm = masked ? 0.f : sgm; omv = masked ? 1.f : omv; }
        sg[i] = sgm; om[i] = omv;
    }
    float sfx[16], pg[4], pp[4], both[4];
#pragma unroll
    for (int g = 0; g < 4; ++g) { sfx[4 * g + 3] = 1.f; sfx[4 * g + 2] = om[4 * g + 3]; sfx[4 * g + 1] = sfx[4 * g + 2] * om[4 * g + 2]; sfx[4 * g] = sfx[4 * g + 1] * om[4 * g + 1]; pg[g] = sfx[4 * g] * om[4 * g]; }
#pragma unroll
    for (int g = 0; g < 4; ++g) { pp[g] = shx32(pg[g], lane); both[g] = pg[g] * pp[g]; }
    float outer[4];
    outer[3] = 1.f; outer[2] = both[3]; outer[1] = both[3] * both[2]; outer[0] = outer[1] * both[1];
    const float total = outer[0] * both[0];
#pragma unroll
    for (int g = 0; g < 4; ++g) { if (hh == 0) outer[g] *= pp[g]; outer[g] *= carry; }
    carry *= total;
#pragma unroll
    for (int s2 = 0; s2 < 2; ++s2) { u32x4 pk;
#pragma unroll
        for (int x = 0; x < 4; ++x) { const int i0 = 8 * s2 + 2 * x; pk[x] = cvt_pk_bf16(sg[i0] * (sfx[i0] * outer[i0 >> 2]), sg[i0 + 1] * (sfx[i0 + 1] * outer[(i0 + 1) >> 2])); }
        pf[s2] = __builtin_bit_cast(bf16x8, pk); }
}
__device__ __forceinline__ void sb_unit(const Params& P, const Ctx& C, int l, int b, int h, int qb) {
    const bf16_t* base = WSP(bf16_t, WS_U16) + (size_t)b * SEQ * NU;
    int tid_ = C.tid; asm volatile("" : "+v"(tid_));
    const int w = __builtin_amdgcn_readfirstlane(tid_ >> 6), lane = tid_ & 63, r = lane & 31, hh = lane >> 5;
    const int q0 = qb * 256 + 32 * w;
    bf16x8 qf[4];
#pragma unroll
    for (int kk = 0; kk < 4; ++kk) qf[kk] = *(const bf16x8*)(base + (size_t)(q0 + r) * NU + U_SQ + h * 64 + 16 * kk + 8 * hh);
    f32x16 oacc[2];
#pragma unroll
    for (int i = 0; i < 16; ++i) { oacc[0][i] = 0.f; oacc[1][i] = 0.f; }
    float carry = 1.f;
    const int nst = 4 * (qb + 1);
    const int srow = tid_ >> 3, scol = (tid_ & 7) * 8;
    LAS unsigned* alive = (LAS unsigned*)(C.lds + 2 * SB_BUF);
    u32x4 kreg, vreg;
    { const bf16_t* rowp = base + (size_t)(64 * (nst - 1) + srow) * NU + h * 64 + scol; kreg = *(const u32x4*)(rowp + U_SK); vreg = *(const u32x4*)(rowp + U_SV); }
    for (int st = nst - 1; st >= 0; --st) {
        LAS unsigned char* buf = C.lds + (st & 1) * SB_BUF;
        *(LAS u32x4*)(buf + (srow * SB_KSTR + scol) * 2) = kreg;
        { LAS bf16_t* vt = (LAS bf16_t*)(buf + SB_KBYTES);
#pragma unroll
          for (int j = 0; j < 4; ++j) { vt[(scol + 2 * j) * SB_VSTR + srow] = (bf16_t)(vreg[j] & 0xffffu); vt[(scol + 2 * j + 1) * SB_VSTR + srow] = (bf16_t)(vreg[j] >> 16); } }
        const bool wave_alive = __any(carry != 0.f) != 0;
        if (lane == 0) alive[(st & 1) * 8 + w] = wave_alive ? 1u : 0u;
        __syncthreads();
        { unsigned any_alive = 0u;
#pragma unroll
          for (int i = 0; i < 8; ++i) any_alive |= alive[(st & 1) * 8 + i];
          if (any_alive == 0u) break; }
        if (st > 0) { const bf16_t* rowp = base + (size_t)(64 * (st - 1) + srow) * NU + h * 64 + scol; kreg = *(const u32x4*)(rowp + U_SK); vreg = *(const u32x4*)(rowp + U_SV); }
        const LAS bf16_t* vt = (const LAS bf16_t*)(buf + SB_KBYTES);
#pragma unroll
        for (int half = 1; half >= 0; --half) {
            const int kb = 64 * st + 32 * half;
            if (kb >= q0 + 32 || !wave_alive) continue;
            const bool diag = (kb == q0);
            f32x16 sacc;
#pragma unroll
            for (int i = 0; i < 16; ++i) sacc[i] = 0.f;
#pragma unroll
            for (int kk = 0; kk < 4; ++kk) { const bf16x8 kf = *(const LAS bf16x8*)(buf + ((32 * half + r) * SB_KSTR + 16 * kk + 8 * hh) * 2); sacc = MFMA32(kf, qf[kk], sacc); }
            bf16x8 pf[2];
            if (diag) sb_tile_math<true>(sacc, carry, pf, r, hh, lane); else sb_tile_math<false>(sacc, carry, pf, r, hh, lane);
#pragma unroll
            for (int dt = 0; dt < 2; ++dt)
#pragma unroll
                for (int s2 = 0; s2 < 2; ++s2) { const LAS bf16_t* vrow = vt + (32 * dt + r) * SB_VSTR + 32 * half + 16 * s2 + 4 * hh;
                    const u32x2 lo = *(const LAS u32x2*)vrow, hi = *(const LAS u32x2*)(vrow + 8);
                    u32x4 vv; vv.x = lo.x; vv.y = lo.y; vv.z = hi.x; vv.w = hi.y;
                    oacc[dt] = MFMA32(__builtin_bit_cast(bf16x8, vv), pf[s2], oacc[dt]); }
        }
    }
    float ss = 0.f;
#pragma unroll
    for (int i = 0; i < 16; ++i) ss += oacc[0][i] * oacc[0][i] + oacc[1][i] * oacc[1][i];
    ss += shx32(ss, lane);
    const float sc = rsqrtf(ss * (1.f / 64.f) + NORM_EPS);
    const float* nw = P.in[8] + l * 256 + h * 64;
    bf16_t* yrow = WSP(bf16_t, WS_Y) + (size_t)(b * SEQ + q0 + r) * D + 256 + h * 64;
#pragma unroll
    for (int dt = 0; dt < 2; ++dt)
#pragma unroll
        for (int g = 0; g < 4; ++g) { const int d0 = 32 * dt + 8 * g + 4 * hh; const f32x4 n4 = *(const f32x4*)(nw + d0);
            u32x2 o2; o2.x = cvt_pk_bf16(oacc[dt][4 * g] * sc * n4[0], oacc[dt][4 * g + 1] * sc * n4[1]); o2.y = cvt_pk_bf16(oacc[dt][4 * g + 2] * sc * n4[2], oacc[dt][4 * g + 3] * sc * n4[3]);
            *(u32x2*)(yrow + d0) = o2; }
    __syncthreads();
}

constexpr int ML_STR = 72;
constexpr int ML_MAT = 64 * ML_STR * 2;
constexpr int ML_STAGE = 4 * ML_MAT;
constexpr int ML_K = 0, ML_Q = ML_MAT, ML_VT = 2 * ML_MAT, ML_KWT = 3 * ML_MAT;
constexpr int ML_CT = 2 * ML_STAGE  , ML_N = ML_CT + 2 * ML_MAT  , ML_SSQ = ML_N + 512  ,
              ML_GB = ML_SSQ + 1024  , ML_GWL = ML_GB + 8192, ML_GEB = ML_GWL + 8192, ML_GWG = ML_GEB + 8192  , ML_GG = ML_GWG + 8192  , ML_END = ML_GG + 128;
static_assert(ML_END <= LDS_TAB, "mLSTM LDS map");
__device__ __forceinline__ float shup(float v, int o, int lane) { return __uint_as_float((unsigned)__builtin_amdgcn_ds_bpermute((lane - o) << 2, (int)__float_as_uint(v))); }
__device__ __forceinline__ float shidx(float v, int src) { return __uint_as_float((unsigned)__builtin_amdgcn_ds_bpermute(src << 2, (int)__float_as_uint(v))); }
__device__ __forceinline__ void mlstm_unit(const Params& P, const Ctx& C, int l, int b, int h, int par) {
    const bf16_t* U = WSP(bf16_t, WS_U16) + (size_t)b * SEQ * NU; const float* GT = WSP(float, WS_GT) + (size_t)b * SEQ * 16;
    LAS unsigned char* lds = C.lds;
    const int w = C.wave, lane = C.lane, r = lane & 31, hh = lane >> 5, tid = C.tid;
    const float ib = P.in[5][l * 4 + h], fb = P.in[6][l * 4 + h];
    for (int i = tid; i < (2 * ML_MAT + 512 + 1024) / 4; i += NTHREADS) ((LAS unsigned*)(lds + ML_CT))[i] = 0u;
    for (int n = w; n < SEQ / 64; n += NWAVES) {
        const size_t tk = (size_t)64 * n + lane;
        float bcs = -softplusf_(-(GT[tk * 16 + 4 + h] + fb));
#pragma unroll
        for (int o = 1; o < 64; o <<= 1) { const float t = shup(bcs, o, lane); if (lane >= o) bcs += t; }
        const float wl = (GT[tk * 16 + h] + ib) - bcs, bL = shidx(bcs, 63);
        ((LAS float*)(lds + ML_GB))[tk] = bcs; ((LAS float*)(lds + ML_GWL))[tk] = wl; ((LAS float*)(lds + ML_GEB))[tk] = __expf(bcs); ((LAS float*)(lds + ML_GWG))[tk] = __expf(bL + wl);
        if (lane == 0) ((LAS float*)(lds + ML_GG))[n] = __expf(bL);
    }
    const int srow = tid >> 3, c0 = (tid & 7) * 8;
    u32x4 qreg, kreg, vreg;
    { const bf16_t* rowp = U + (size_t)srow * NU + h * 64 + c0; qreg = *(const u32x4*)(rowp + U_MQ); kreg = *(const u32x4*)(rowp + U_MK); vreg = *(const u32x4*)(rowp + U_MV); }
    f32x16 cacc;
#pragma unroll
    for (int i = 0; i < 16; ++i) cacc[i] = 0.f;
    float n_d = 0.f;
    const int ti = w & 1, ei = (w >> 1) & 1;
    f32x16 hv; float rs_part = 0.f; u32x2 opre[4];
#pragma unroll
    for (int i = 0; i < 16; ++i) hv[i] = 0.f;
#pragma unroll
    for (int g = 0; g < 4; ++g) opre[g] = (u32x2){0u, 0u};
    const float* nw = P.in[7] + l * 256 + h * 64;
    __syncthreads();
    for (int n = 0; n <= SEQ / 64; ++n) {
        const int cb = n & 1;
        LAS unsigned char* sb = lds + cb * ML_STAGE;
        if (n < SEQ / 64) {
            const float wgt_row = ((const LAS float*)(lds + ML_GWG))[64 * n + srow];
            u32x4 ks; float kf[8];
#pragma unroll
            for (int x = 0; x < 4; ++x) { kf[2 * x] = __uint_as_float(kreg[x] << 16) * 0.125f; kf[2 * x + 1] = __uint_as_float(kreg[x] & 0xffff0000u) * 0.125f; ks[x] = (__float_as_uint(kf[2 * x]) >> 16) | (__float_as_uint(kf[2 * x + 1]) & 0xffff0000u); }
            *(LAS u32x4*)(sb + ML_K + (srow * ML_STR + c0) * 2) = ks;
            if ((n & 1) == par) *(LAS u32x4*)(sb + ML_Q + (srow * ML_STR + c0) * 2) = qreg;
            LAS bf16_t* vt = (LAS bf16_t*)(sb + ML_VT); LAS bf16_t* kwt = (LAS bf16_t*)(sb + ML_KWT);
#pragma unroll
            for (int x = 0; x < 4; ++x) { vt[(c0 + 2 * x) * ML_STR + srow] = (bf16_t)(vreg[x] & 0xffffu); vt[(c0 + 2 * x + 1) * ML_STR + srow] = (bf16_t)(vreg[x] >> 16);
                kwt[(c0 + 2 * x) * ML_STR + srow] = (bf16_t)f2bf(kf[2 * x] * wgt_row); kwt[(c0 + 2 * x + 1) * ML_STR + srow] = (bf16_t)f2bf(kf[2 * x + 1] * wgt_row); }
        }
        __syncthreads();
        if (n + 1 < SEQ / 64) { const bf16_t* rowp = U + (size_t)(64 * (n + 1) + srow) * NU + h * 64 + c0; qreg = *(const u32x4*)(rowp + U_MQ); kreg = *(const u32x4*)(rowp + U_MK); vreg = *(const u32x4*)(rowp + U_MV); }
        if (w < 4 && n > 0 && ((n - 1) & 1) == par) {
            const float tot = rs_part + ((const LAS float*)(lds + ML_SSQ))[(cb ^ 1) * 128 + (ti * 2 + (ei ^ 1)) * 32 + r];
            const float rs = rsqrtf(tot * (1.f / 64.f) + NORM_EPS);
            const size_t tok = (size_t)64 * (n - 1) + 32 * ti + r;
            bf16_t* yrow = WSP(bf16_t, WS_Y) + ((size_t)b * SEQ + tok) * D + h * 64;
#pragma unroll
            for (int g = 0; g < 4; ++g) { const int e0 = 32 * ei + 8 * g + 4 * hh; const f32x4 n4 = *(const f32x4*)(nw + e0); const u32x2 op = opre[g];
                const float o0 = sigmoidf_(__uint_as_float(op.x << 16)), o1 = sigmoidf_(__uint_as_float(op.x & 0xffff0000u)), o2 = sigmoidf_(__uint_as_float(op.y << 16)), o3 = sigmoidf_(__uint_as_float(op.y & 0xffff0000u));
                u32x2 y2; y2.x = cvt_pk_bf16(hv[4 * g] * rs * n4[0] * o0, hv[4 * g + 1] * rs * n4[1] * o1); y2.y = cvt_pk_bf16(hv[4 * g + 2] * rs * n4[2] * o2, hv[4 * g + 3] * rs * n4[3] * o3);
                *(u32x2*)(yrow + e0) = y2; }
        }
        if (n == SEQ / 64) break;
        if (w < 4) { if ((n & 1) == par) {
            { const size_t tokp = (size_t)64 * n + 32 * ti + r;
#pragma unroll
              for (int g = 0; g < 4; ++g) opre[g] = *(const u32x2*)(U + tokp * NU + U_MO + h * 64 + 32 * ei + 8 * g + 4 * hh); }
            const LAS float* gwl = (const LAS float*)(lds + ML_GWL) + 64 * n;
            const float bt = ((const LAS float*)(lds + ML_GB))[64 * n + 32 * ti + r], ebt = ((const LAS float*)(lds + ML_GEB))[64 * n + 32 * ti + r];
            bf16x8 qf[4];
#pragma unroll
            for (int kk = 0; kk < 4; ++kk) qf[kk] = *(const LAS bf16x8*)(sb + ML_Q + ((32 * ti + r) * ML_STR + 16 * kk + 8 * hh) * 2);
            f32x16 acc1, acc2;
#pragma unroll
            for (int i = 0; i < 16; ++i) { acc1[i] = 0.f; acc2[i] = 0.f; }
            float den = 0.f;
#pragma unroll
            for (int si = 0; si < 2; ++si) {
                if (si > ti) continue;
                f32x16 sacc;
#pragma unroll
                for (int i = 0; i < 16; ++i) sacc[i] = 0.f;
#pragma unroll
                for (int kk = 0; kk < 4; ++kk) { const bf16x8 kf = *(const LAS bf16x8*)(sb + ML_K + ((32 * si + r) * ML_STR + 16 * kk + 8 * hh) * 2); sacc = MFMA32(kf, qf[kk], sacc); }
                float pv[16];
#pragma unroll
                for (int g = 0; g < 4; ++g) { const f32x4 wl4 = *(const LAS f32x4*)(gwl + 32 * si + 8 * g + 4 * hh);
#pragma unroll
                    for (int x = 0; x < 4; ++x) { const int srow_i = 8 * g + 4 * hh + x; const bool keep = (si < ti) || (srow_i <= r);
                        const float pvv = keep ? sacc[4 * g + x] * __expf(bt + wl4[x]) : 0.f; pv[4 * g + x] = pvv; den += pvv; } }
#pragma unroll
                for (int s2 = 0; s2 < 2; ++s2) { u32x4 pk;
#pragma unroll
                    for (int x = 0; x < 4; ++x) pk[x] = cvt_pk_bf16(pv[8 * s2 + 2 * x], pv[8 * s2 + 2 * x + 1]);
                    const LAS bf16_t* vrow = (const LAS bf16_t*)(sb + ML_VT) + (32 * ei + r) * ML_STR + 32 * si + 16 * s2 + 4 * hh;
                    const u32x2 lo = *(const LAS u32x2*)vrow, hi = *(const LAS u32x2*)(vrow + 8);
                    u32x4 vv; vv.x = lo.x; vv.y = lo.y; vv.z = hi.x; vv.w = hi.y;
                    acc1 = MFMA32(__builtin_bit_cast(bf16x8, vv), __builtin_bit_cast(bf16x8, pk), acc1); }
            }
#pragma unroll
            for (int kk = 0; kk < 4; ++kk) { const bf16x8 cf = *(const LAS bf16x8*)(lds + ML_CT + cb * ML_MAT + ((32 * ei + r) * ML_STR + 16 * kk + 8 * hh) * 2); acc2 = MFMA32(cf, qf[kk], acc2); }
            float qn = 0.f;
            { const LAS float* nv = (const LAS float*)(lds + ML_N + cb * 256);
#pragma unroll
              for (int kk = 0; kk < 4; ++kk) { const u32x4 qq = *(const LAS u32x4*)(sb + ML_Q + ((32 * ti + r) * ML_STR + 32 * hh + 8 * kk) * 2);
                  const f32x4 n0 = *(const LAS f32x4*)(nv + 32 * hh + 8 * kk), n1 = *(const LAS f32x4*)(nv + 32 * hh + 8 * kk + 4);
                  qn += __uint_as_float(qq[0] << 16) * n0[0] + __uint_as_float(qq[0] & 0xffff0000u) * n0[1] + __uint_as_float(qq[1] << 16) * n0[2] + __uint_as_float(qq[1] & 0xffff0000u) * n0[3]
                      + __uint_as_float(qq[2] << 16) * n1[0] + __uint_as_float(qq[2] & 0xffff0000u) * n1[1] + __uint_as_float(qq[3] << 16) * n1[2] + __uint_as_float(qq[3] & 0xffff0000u) * n1[3]; } }
            den += ebt * qn;
            den += shx32(den, lane);
            const float dinv = __builtin_amdgcn_rcpf(fmaxf(fabsf(den), 1.0f));
            rs_part = 0.f;
#pragma unroll
            for (int i = 0; i < 16; ++i) { hv[i] = (acc1[i] + ebt * acc2[i]) * dinv; rs_part += hv[i] * hv[i]; }
            rs_part += shx32(rs_part, lane);
            if (hh == 0) ((LAS float*)(lds + ML_SSQ))[cb * 128 + (ti * 2 + ei) * 32 + r] = rs_part;
        } } else {
            const int di = w & 1; const float G = ((const LAS float*)(lds + ML_GG))[n];
#pragma unroll
            for (int i = 0; i < 16; ++i) cacc[i] *= G;
#pragma unroll
            for (int kk = 0; kk < 4; ++kk) { const bf16x8 vf = *(const LAS bf16x8*)(sb + ML_VT + ((32 * ei + r) * ML_STR + 16 * kk + 8 * hh) * 2);
                const bf16x8 kf = *(const LAS bf16x8*)(sb + ML_KWT + ((32 * di + r) * ML_STR + 16 * kk + 8 * hh) * 2); cacc = MFMA32(vf, kf, cacc); }
            LAS bf16_t* ct = (LAS bf16_t*)(lds + ML_CT + (cb ^ 1) * ML_MAT);
#pragma unroll
            for (int i = 0; i < 16; ++i) ct[(32 * ei + (i & 3) + 8 * (i >> 2) + 4 * hh) * ML_STR + 32 * di + r] = (bf16_t)f2bf(cacc[i]);
            if (w == 4) { float sum = 0.f;
#pragma unroll
                for (int kk = 0; kk < 8; ++kk) { const u32x4 kk4 = *(const LAS u32x4*)(sb + ML_KWT + (lane * ML_STR + 8 * kk) * 2);
#pragma unroll
                    for (int x = 0; x < 4; ++x) sum += __uint_as_float(kk4[x] << 16) + __uint_as_float(kk4[x] & 0xffff0000u); }
                n_d = G * n_d + sum; ((LAS float*)(lds + ML_N + (cb ^ 1) * 256))[lane] = n_d; }
        }
    }
    __syncthreads();
}
constexpr int GP_W = 0, GP_QD = 16384, GP_KDT = 32768, GP_QK = 49152, GP_U = 57344, GP_CD = 73728, GP_CHUNK = 74752;
constexpr size_t WS_GP = WS_GQ;
static_assert((size_t)1024 * GP_CHUNK <= 96 * MiB, "GDN prep buffer");
constexpr int PL_KSTR = 136, PL_KN = 0, PL_QN = 17408, PL_RHS = 34816, PL_RSTR = 260, PL_M = 101376, PL_MSTR = 72  , PL_QK = 118784, PL_QKSTR = 72, PL_WC = 128000, PL_GATE = 134144, PL_UWSTR = 264;
__device__ __forceinline__ unsigned bfmul2(unsigned pk, float a) { return cvt_pk_bf16(__uint_as_float(pk << 16) * a, __uint_as_float(pk & 0xffff0000u) * a); }
__device__ __forceinline__ void gdn_prep_unit(const Params& P, const Ctx& C, int l, int b, int h, int n) {
    LAS unsigned char* lds = C.lds;
    int tid_ = C.tid; asm volatile("" : "+v"(tid_));
    const int tid = tid_, w = __builtin_amdgcn_readfirstlane(tid >> 6), lane = tid & 63, r = lane & 31, hh = lane >> 5;
    const bf16_t* U = WSP(bf16_t, WS_U16) + (size_t)b * SEQ * NU; const float* GT = WSP(float, WS_GT) + (size_t)b * SEQ * 16;
    unsigned char* outp = P.ws + WS_GP + (size_t)((b * 4 + h) * 32 + n) * GP_CHUNK;
    const int t0 = 64 * n;
    { const float* cw = P.in[9] + (size_t)l * 4 * 1536; LAS float* wc = (LAS float*)(lds + PL_WC);
      for (int idx = tid; idx < 1536; idx += NTHREADS) { const int j = idx / 384, rem = idx - j * 384, p = rem >> 7, cc = rem & 127; wc[idx] = cw[j * 1536 + p * 512 + h * 128 + cc]; } }
    float beta_l, gam_l, gamL;
    { const float A = __expf(P.in[10][l * 4 + h]), dtb = P.in[11][l * 4 + h];
      const float ga = GT[(size_t)(t0 + lane) * 16 + 8 + h], gb = GT[(size_t)(t0 + lane) * 16 + 12 + h];
      float g = -A * softplusf_(ga + dtb);
#pragma unroll
      for (int o = 1; o < 64; o <<= 1) { const float t = shup(g, o, lane); if (lane >= o) g += t; }
      gam_l = g; beta_l = sigmoidf_(gb); gamL = shidx(g, 63);
      if (w == 0) { LAS float* gt = (LAS float*)(lds + PL_GATE); gt[lane] = gam_l; gt[64 + lane] = beta_l; gt[128 + lane] = __expf(gam_l); gt[192 + lane] = __expf(gamL - gam_l); } }
    __syncthreads();
    { const int t = tid >> 3, cg = tid & 7;
      const float beta_t = shidx(beta_l, t), gam_t = shidx(gam_l, t);
      float acc[3][16];
#pragma unroll
      for (int p = 0; p < 3; ++p)
#pragma unroll
          for (int c = 0; c < 16; ++c) acc[p][c] = 0.f;
      const LAS float* wc = (const LAS float*)(lds + PL_WC);
#pragma unroll
      for (int j = 0; j < 4; ++j) { const int ts = t0 + t - 3 + j;
          if (ts >= 0) {
#pragma unroll
              for (int p = 0; p < 3; ++p) { const bf16_t* src = U + (size_t)ts * NU + U_GQ + p * 512 + h * 128 + 16 * cg; const u32x4 x0 = *(const u32x4*)src, x1 = *(const u32x4*)(src + 8);
                  const LAS float* wp = wc + j * 384 + p * 128 + 16 * cg;
#pragma unroll
                  for (int c4 = 0; c4 < 4; ++c4) { const f32x4 w4 = *(const LAS f32x4*)(wp + 4 * c4); const unsigned xa = c4 < 2 ? x0[2 * c4] : x1[2 * c4 - 4], xb = c4 < 2 ? x0[2 * c4 + 1] : x1[2 * c4 - 3];
                      acc[p][4 * c4] += w4[0] * __uint_as_float(xa << 16); acc[p][4 * c4 + 1] += w4[1] * __uint_as_float(xa & 0xffff0000u);
                      acc[p][4 * c4 + 2] += w4[2] * __uint_as_float(xb << 16); acc[p][4 * c4 + 3] += w4[3] * __uint_as_float(xb & 0xffff0000u); } } } }
      float ssq = 0.f, ssk = 0.f;
#pragma unroll
      for (int c = 0; c < 16; ++c) { acc[0][c] = siluf_(acc[0][c]); acc[1][c] = siluf_(acc[1][c]); acc[2][c] = siluf_(acc[2][c]); ssq += acc[0][c] * acc[0][c]; ssk += acc[1][c] * acc[1][c]; }
      { const int ln = lane_id_opaque();
#pragma unroll
        for (int o = 1; o < 8; o <<= 1) { ssq += shx(ssq, o, ln); ssk += shx(ssk, o, ln); } }
      const float scq = rsqrtf(ssq + NORM_EPS) * 0.08838834764831845f, sck = rsqrtf(ssk + NORM_EPS), bw = beta_t * __expf(gam_t);
      u32x4 qa, qb, ka, kb;
#pragma unroll
      for (int x = 0; x < 4; ++x) { qa[x] = cvt_pk_bf16(acc[0][2 * x] * scq, acc[0][2 * x + 1] * scq); qb[x] = cvt_pk_bf16(acc[0][8 + 2 * x] * scq, acc[0][9 + 2 * x] * scq);
                                     ka[x] = cvt_pk_bf16(acc[1][2 * x] * sck, acc[1][2 * x + 1] * sck); kb[x] = cvt_pk_bf16(acc[1][8 + 2 * x] * sck, acc[1][9 + 2 * x] * sck); }
      *(LAS u32x4*)(lds + PL_QN + (t * PL_KSTR + 16 * cg) * 2) = qa; *(LAS u32x4*)(lds + PL_QN + (t * PL_KSTR + 16 * cg + 8) * 2) = qb;
      *(LAS u32x4*)(lds + PL_KN + (t * PL_KSTR + 16 * cg) * 2) = ka; *(LAS u32x4*)(lds + PL_KN + (t * PL_KSTR + 16 * cg + 8) * 2) = kb;
      LAS float* rhs = (LAS float*)(lds + PL_RHS) + t * PL_RSTR;
#pragma unroll
      for (int c4 = 0; c4 < 4; ++c4) { f32x4 rv, rk;
#pragma unroll
          for (int x = 0; x < 4; ++x) { rv[x] = beta_t * acc[2][4 * c4 + x]; rk[x] = bw * sck * acc[1][4 * c4 + x]; }
          *(LAS f32x4*)(rhs + 16 * cg + 4 * c4) = rv; *(LAS f32x4*)(rhs + 128 + 16 * cg + 4 * c4) = rk; } }
    __syncthreads();
    { const int p = w >> 2, ti = (w >> 1) & 1, si = w & 1;
      const LAS float* gt = (const LAS float*)(lds + PL_GATE);
      if (si <= ti) {
          f32x16 acc;
#pragma unroll
          for (int i = 0; i < 16; ++i) acc[i] = 0.f;
#pragma unroll
          for (int kk = 0; kk < 8; ++kk) { const bf16x8 af = *(const LAS bf16x8*)(lds + (p ? PL_QN : PL_KN) + ((32 * ti + r) * PL_KSTR + 16 * kk + 8 * hh) * 2);
              const bf16x8 bf = *(const LAS bf16x8*)(lds + PL_KN + ((32 * si + r) * PL_KSTR + 16 * kk + 8 * hh) * 2); acc = MFMA32(af, bf, acc); }
          const float gam_s = gt[32 * si + r];
#pragma unroll
          for (int g = 0; g < 4; ++g) { const f32x4 gt4 = *(const LAS f32x4*)(gt + 32 * ti + 8 * g + 4 * hh), bt4 = *(const LAS f32x4*)(gt + 64 + 32 * ti + 8 * g + 4 * hh);
#pragma unroll
              for (int x = 0; x < 4; ++x) { const int trow = 8 * g + 4 * hh + x; const float dec = __expf(fminf(gt4[x] - gam_s, 0.f)) * acc[4 * g + x];
                  if (p == 0) { const bool keep = (si < ti) || (r < trow); ((LAS _Float16*)(lds + PL_M))[(32 * ti + trow) * PL_MSTR + 32 * si + r] = (_Float16)(keep ? bt4[x] * dec : 0.f); }
                  else { const bool keep = (si < ti) || (r <= trow); ((LAS bf16_t*)(lds + PL_QK))[(32 * ti + trow) * PL_QKSTR + 32 * si + r] = (bf16_t)f2bf(keep ? dec : 0.f); } } }
      } else if (p == 1) {
#pragma unroll
          for (int i = 0; i < 16; ++i) ((LAS bf16_t*)(lds + PL_QK))[(32 * ti + (i & 3) + 8 * (i >> 2) + 4 * hh) * PL_QKSTR + 32 * si + r] = (bf16_t)0;
      } }
    __syncthreads();
    float xs[64];
    if (w < 4) {
        int vz = 0; asm volatile("" : "+v"(vz));
        typedef _Float16 f16x8 __attribute__((ext_vector_type(8)));
        const LAS float* rhs = (const LAS float*)(lds + PL_RHS) + tid; const LAS _Float16* Mh = (const LAS _Float16*)(lds + PL_M) + vz;
#pragma clang loop unroll(full)
        for (int t = 0; t < 64; ++t) { float a = rhs[t * PL_RSTR];
            const LAS _Float16* Mrow = Mh + t * PL_MSTR;
#pragma clang loop unroll(full)
            for (int s8 = 0; s8 < (t + 7) / 8; ++s8) { const f16x8 m8 = *(const LAS f16x8*)(Mrow + 8 * s8);
#pragma unroll
                for (int x = 0; x < 8; ++x) if (8 * s8 + x < t) a -= (float)m8[x] * xs[8 * s8 + x]; }
            xs[t] = a; }
    } else {
        const LAS float* gt = (const LAS float*)(lds + PL_GATE);
        for (int it = w - 4; it < 40; it += 4) {
            u32x4 o;
            if (it < 16) { const int ti = it >> 3, kk = it & 7; const u32x4 q = *(const LAS u32x4*)(lds + PL_QN + ((32 * ti + r) * PL_KSTR + 16 * kk + 8 * hh) * 2); const float eg = gt[128 + 32 * ti + r];
#pragma unroll
                for (int x = 0; x < 4; ++x) o[x] = bfmul2(q[x], eg);
                *(u32x4*)(outp + GP_QD + (size_t)((ti * 8 + kk) * 64 + lane) * 16) = o;
            } else if (it < 32) { const int dt = (it - 16) >> 2, ks = (it - 16) & 3; const LAS bf16_t* kn = (const LAS bf16_t*)(lds + PL_KN) + 32 * dt + r;
#pragma unroll
                for (int x = 0; x < 4; ++x) { const int ta = 16 * ks + 8 * ((2 * x) >> 2) + 4 * hh + ((2 * x) & 3), tb = ta + 1;
                    o[x] = cvt_pk_bf16(bf2f(kn[ta * PL_KSTR]) * gt[192 + ta], bf2f(kn[tb * PL_KSTR]) * gt[192 + tb]); }
                *(u32x4*)(outp + GP_KDT + (size_t)((dt * 4 + ks) * 64 + lane) * 16) = o;
            } else { const int ti = (it - 32) >> 2, ks = (it - 32) & 3; const LAS bf16_t* qrow = (const LAS bf16_t*)(lds + PL_QK) + (32 * ti + r) * PL_QKSTR + 16 * ks + 4 * hh;
                const u32x2 lo = *(const LAS u32x2*)qrow, hi = *(const LAS u32x2*)(qrow + 8); o.x = lo.x; o.y = lo.y; o.z = hi.x; o.w = hi.y;
                *(u32x4*)(outp + GP_QK + (size_t)((ti * 4 + ks) * 64 + lane) * 16) = o; }
        }
    }
    __syncthreads();
    if (w < 4) { LAS bf16_t* uw = (LAS bf16_t*)(lds + PL_RHS) + tid;
#pragma unroll
        for (int t = 0; t < 64; ++t) uw[t * PL_UWSTR] = (bf16_t)f2bf(xs[t]); }
    __syncthreads();
    { const LAS bf16_t* uw = (const LAS bf16_t*)(lds + PL_RHS);
      for (int it = w; it < 24; it += 8) {
          if (it < 16) { const int ti = it >> 3, kk = it & 7; const u32x4 o = *(const LAS u32x4*)(uw + (32 * ti + r) * PL_UWSTR + 128 + 16 * kk + 8 * hh);
              *(u32x4*)(outp + GP_W + (size_t)((ti * 8 + kk) * 64 + lane) * 16) = o;
          } else { const int ti = (it - 16) >> 2, es = (it - 16) & 3; u32x4 o0, o1;
#pragma unroll
              for (int x = 0; x < 8; ++x) { const int ia = 2 * x, ib = 2 * x + 1; const int ta = 32 * ti + (ia & 3) + 8 * (ia >> 2) + 4 * hh, tb = 32 * ti + (ib & 3) + 8 * (ib >> 2) + 4 * hh;
                  const unsigned v = (unsigned)uw[ta * PL_UWSTR + 32 * es + r] | ((unsigned)uw[tb * PL_UWSTR + 32 * es + r] << 16); if (x < 4) o0[x] = v; else o1[x - 4] = v; }
              unsigned char* dst = outp + GP_U + (size_t)((ti * 4 + es) * 64 + lane) * 32; *(u32x4*)dst = o0; *(u32x4*)(dst + 16) = o1; }
      }
      if (tid == 0) *(float*)(outp + GP_CD) = __expf(gamL); }
    __syncthreads();
}
__device__ __forceinline__ void phase_gprep2(const Params& P, const Ctx& C, int l) {
    { int* slot_tok = (int*)(P.ws + WS_RT + RT_SLOTTOK); for (int i = C.bid * NTHREADS + C.tid; i < PSLOTS; i += C.G * NTHREADS) slot_tok[i] = -1; }
    for (int u = C.bid; u < 1024; u += C.G) gdn_prep_unit(P, C, l, u >> 7, (u >> 5) & 3, u & 31);
}
constexpr int GS_SLOT = 61440, GS_ST = 2 * GS_SLOT, GS_STSTR = 136, GS_STBYTES = 32 * GS_STSTR * 2;
__device__ __forceinline__ void gdn_scan_unit(const Params& P, const Ctx& C, int l, int b, int h, int es) {
    LAS unsigned char* lds = C.lds;
    const int tid = C.tid, w = C.wave, lane = C.lane, r = lane & 31, hh = lane >> 5;
    const unsigned char* gp = P.ws + WS_GP + (size_t)((b * 4 + h) * 32) * GP_CHUNK;
    float* O = WSP(float, WS_GO) + (size_t)b * SEQ * 512 + h * 128 + 32 * es;
    for (int i = tid; i < 2 * GS_STBYTES / 4; i += NTHREADS) ((LAS unsigned*)(lds + GS_ST))[i] = 0u;
#define GS_ISSUE(nn) do { const unsigned char* src = gp + (size_t)(nn) * GP_CHUNK; LAS unsigned char* dst = lds + ((nn) & 1) * GS_SLOT; \
        for (int p = w; p < 60; p += 8) { const size_t go = p < 56 ? (size_t)p * 1024 : (size_t)GP_U + (size_t)(((p - 56) >> 1) * 4 + es) * 2048 + (size_t)((p - 56) & 1) * 1024; \
            __builtin_amdgcn_global_load_lds((const unsigned*)(src + go + lane * 16), (LAS unsigned*)(dst + p * 1024), 16, 0, 0); } } while (0)
    GS_ISSUE(0);
    float cd_next = *(const float*)(gp + GP_CD);
    f32x16 sacc;
#pragma unroll
    for (int i = 0; i < 16; ++i) sacc[i] = 0.f;
    asm volatile("s_waitcnt vmcnt(0)" ::: "memory");
    __syncthreads();
    for (int n = 0; n < 32; ++n) {
        const float cd = cd_next;
        if (n + 1 < 32) { GS_ISSUE(n + 1); cd_next = *(const float*)(gp + (size_t)(n + 1) * GP_CHUNK + GP_CD); }
        const LAS unsigned char* slot = lds + (n & 1) * GS_SLOT;
        const LAS unsigned char* stc = lds + GS_ST + (n & 1) * GS_STBYTES;
        if (w < 6) {
            f32x16 xa[2];
#pragma unroll
            for (int i = 0; i < 16; ++i) { xa[0][i] = 0.f; xa[1][i] = 0.f; }
            bf16x8 sf[8];
#pragma unroll
            for (int kk = 0; kk < 8; ++kk) sf[kk] = *(const LAS bf16x8*)(stc + (r * GS_STSTR + 16 * kk + 8 * hh) * 2);
#pragma unroll
            for (int ti = 0; ti < 2; ++ti)
#pragma unroll
                for (int kk = 0; kk < 8; ++kk) { const bf16x8 wf = *(const LAS bf16x8*)(slot + GP_W + ((ti * 8 + kk) * 64 + lane) * 16); xa[ti] = MFMA32(wf, sf[kk], xa[ti]); }
            bf16x8 pf[2][2];
#pragma unroll
            for (int ti = 0; ti < 2; ++ti) { const u32x4 u0 = *(const LAS u32x4*)(slot + GP_U + ti * 2048 + lane * 32), u1 = *(const LAS u32x4*)(slot + GP_U + ti * 2048 + lane * 32 + 16);
#pragma unroll
                for (int s2 = 0; s2 < 2; ++s2) { const u32x4 uu = s2 ? u1 : u0; u32x4 pk;
#pragma unroll
                    for (int x = 0; x < 4; ++x) pk[x] = cvt_pk_bf16(__uint_as_float(uu[x] << 16) - xa[ti][8 * s2 + 2 * x], __uint_as_float(uu[x] & 0xffff0000u) - xa[ti][8 * s2 + 2 * x + 1]);
                    pf[ti][s2] = __builtin_bit_cast(bf16x8, pk); } }
            if (w < 4) {
#pragma unroll
                for (int i = 0; i < 16; ++i) sacc[i] *= cd;
#pragma unroll
                for (int ks = 0; ks < 4; ++ks) { const bf16x8 kf = *(const LAS bf16x8*)(slot + GP_KDT + ((w * 4 + ks) * 64 + lane) * 16); sacc = MFMA32(kf, pf[ks >> 1][ks & 1], sacc); }
                LAS unsigned char* stn = lds + GS_ST + ((n + 1) & 1) * GS_STBYTES;
#pragma unroll
                for (int g = 0; g < 4; ++g) { u32x2 o2; o2.x = cvt_pk_bf16(sacc[4 * g], sacc[4 * g + 1]); o2.y = cvt_pk_bf16(sacc[4 * g + 2], sacc[4 * g + 3]);
                    *(LAS u32x2*)(stn + (r * GS_STSTR + 32 * w + 8 * g + 4 * hh) * 2) = o2; }
            } else {
                const int ti = w - 4;
                f32x16 oa;
#pragma unroll
                for (int i = 0; i < 16; ++i) oa[i] = 0.f;
#pragma unroll
                for (int kk = 0; kk < 8; ++kk) { const bf16x8 qf = *(const LAS bf16x8*)(slot + GP_QD + ((ti * 8 + kk) * 64 + lane) * 16); oa = MFMA32(qf, sf[kk], oa); }
#pragma unroll
                for (int ks = 0; ks < 4; ++ks) { if ((ks >> 1) > ti) continue; const bf16x8 qf = *(const LAS bf16x8*)(slot + GP_QK + ((ti * 4 + ks) * 64 + lane) * 16); oa = MFMA32(qf, pf[ks >> 1][ks & 1], oa); }
                float* orow = O + (size_t)(64 * n + 32 * ti) * 512 + r;
#pragma unroll
                for (int i = 0; i < 16; ++i) orow[(size_t)((i & 3) + 8 * (i >> 2) + 4 * hh) * 512] = oa[i];
            }
        }
        asm volatile("s_waitcnt vmcnt(0)" ::: "memory");
        __syncthreads();
    }
#undef GS_ISSUE
}
__device__ __forceinline__ void phase_mix(const Params& P, const Ctx& C, int l, int rep) {
#ifndef MIX_SEL
#define MIX_SEL 7
#endif
    const int sel = rep ? MIX_SEL : 7;
    if (C.bid < 128) { if (sel & 1) { const int j = C.bid >> 3, bh = (j >> 2) * 8 + (C.bid & 7); gdn_scan_unit(P, C, l, bh >> 2, bh & 3, j & 3); } }
    else if (C.bid < 192) { if (sel & 2) { const int q = C.bid - 128, j = q >> 3, bh = (j >> 1) * 8 + (q & 7); mlstm_unit(P, C, l, bh >> 2, bh & 3, j & 1); } }
    if (!(sel & 4)) return;
    LAS int* qslot = (LAS int*)(C.lds + LDS_MISC + 32);
    for (;;) {
        if (C.tid == 0) *qslot = (int)atomicAdd(ctl_words(P) + CW_SBQ + (l + 4 * rep) * 64, 1u);
        __syncthreads();
        const int u = *qslot;
        __syncthreads();
        if (u >= 256) break;
        sb_unit(P, C, l, (u & 31) >> 2, u & 3, 7 - (u >> 5));
    }
}
__device__ __forceinline__ void phase_gpost(const Params& P, const Ctx& C, int l) {
    const float* O = WSP(float, WS_GO); const bf16_t* U = WSP(bf16_t, WS_U16); bf16_t* Y = WSP(bf16_t, WS_Y); const float* nw = P.in[12] + l * 128 + (C.lane & 15) * 8;
    const int gw = C.bid * NWAVES + C.wave, NGW = C.G * NWAVES, lane = C.lane;
    const f32x4 n0 = *(const f32x4*)nw, n1 = *(const f32x4*)(nw + 4);
    for (int tok0 = gw; tok0 < T; tok0 += 4 * NGW) {
        f32x4 a[4], b[4]; u32x4 z[4];
#pragma unroll
        for (int k = 0; k < 4; ++k) { const int tok = tok0 + k * NGW; if (tok < T) { a[k] = *(const f32x4*)(O + (size_t)tok * 512 + lane * 8); b[k] = *(const f32x4*)(O + (size_t)tok * 512 + lane * 8 + 4); z[k] = *(const u32x4*)(U + (size_t)tok * NU + U_GZ + lane * 8); } }
#pragma unroll
        for (int k = 0; k < 4; ++k) { const int tok = tok0 + k * NGW; if (tok < T) {
            float ss = (a[k][0] * a[k][0] + a[k][1] * a[k][1]) + (a[k][2] * a[k][2] + a[k][3] * a[k][3]) + (b[k][0] * b[k][0] + b[k][1] * b[k][1]) + (b[k][2] * b[k][2] + b[k][3] * b[k][3]);
            { const int ln = lane_id_opaque();
#pragma unroll
              for (int o = 1; o < 16; o <<= 1) ss += shx(ss, o, ln); }
            const float sc = rsqrtf(ss * (1.f / 128.f) + NORM_EPS);
            u32x4 o;
            o.x = cvt_pk_bf16(a[k][0] * sc * n0[0] * siluf_(__uint_as_float(z[k].x << 16)), a[k][1] * sc * n0[1] * siluf_(__uint_as_float(z[k].x & 0xffff0000u)));
            o.y = cvt_pk_bf16(a[k][2] * sc * n0[2] * siluf_(__uint_as_float(z[k].y << 16)), a[k][3] * sc * n0[3] * siluf_(__uint_as_float(z[k].y & 0xffff0000u)));
            o.z = cvt_pk_bf16(b[k][0] * sc * n1[0] * siluf_(__uint_as_float(z[k].z << 16)), b[k][1] * sc * n1[1] * siluf_(__uint_as_float(z[k].z & 0xffff0000u)));
            o.w = cvt_pk_bf16(b[k][2] * sc * n1[2] * siluf_(__uint_as_float(z[k].w << 16)), b[k][3] * sc * n1[3] * siluf_(__uint_as_float(z[k].w & 0xffff0000u)));
            *(u32x4*)(Y + (size_t)tok * D + 512 + lane * 8) = o; } }
    }
}
__device__ __forceinline__ void phase_outproj(const Params& P, const Ctx& C, int l) {
    DenseOrder S; S.init(T, D, D, P.ws + WS_W + (size_t)l * W_LAYER + W_OUT, C.G, C.bid);
    EpiB16<0> E{WSP(bf16_t, WS_TMP), D, nullptr};
    gemm_phase(C.lds, C.tid, (const char*)(P.ws + WS_Y), D, S, E);
}
__device__ __forceinline__ void phase_ln1(const Params& P, const Ctx& C, int l, int rep) {
    const int gw = C.bid * NWAVES + C.wave, NGW = C.G * NWAVES, lane = C.lane;
    const bf16_t* HB = WSP(bf16_t, WS_HB); const bf16_t* TMP = WSP(bf16_t, WS_TMP);
    const float* wr = P.in[16] + (size_t)l * D * NE; const float* br = P.in[17] + l * NE;
    const float* g = P.in[14] + l * D; const float* bb = P.in[15] + l * D;
    int* top_idx = (int*)(P.ws + WS_RT + RT_TOPIDX); float* top_gate = (float*)(P.ws + WS_RT + RT_TOPGATE);
    LAS float* xs = (LAS float*)(C.lds + C.wave * 16384);
    const int e_me = lane & 31, half = lane >> 5;
    LAS unsigned* hist = (LAS unsigned*)(C.lds + LDS_TAB);
    if (C.tid < NE) hist[C.tid] = 0u;
    __syncthreads();
    for (int gi = gw; gi < T / 4; gi += NGW) {
        u32x2 hbr[4][4], tbr[4][4];
#pragma unroll
        for (int rr = 0; rr < 4; ++rr)
#pragma unroll
            for (int j = 0; j < 4; ++j) { hbr[rr][j] = *(const u32x2*)(HB + (size_t)(4 * gi + rr) * D + 4 * lane + 256 * j); tbr[rr][j] = *(const u32x2*)(TMP + (size_t)(4 * gi + rr) * D + 4 * lane + 256 * j); }
#pragma unroll
        for (int rr = 0; rr < 4; ++rr) {
            const int row = 4 * gi + rr;
            float v[16]; float s = 0.f;
#pragma unroll
            for (int j = 0; j < 4; ++j) { const u32x2 hb = hbr[rr][j]; const u32x2 tb = tbr[rr][j]; const float t[4] = {__uint_as_float(tb.x << 16), __uint_as_float(tb.x & 0xffff0000u), __uint_as_float(tb.y << 16), __uint_as_float(tb.y & 0xffff0000u)};
                const float a[4] = {__uint_as_float(hb.x << 16), __uint_as_float(hb.x & 0xffff0000u), __uint_as_float(hb.y << 16), __uint_as_float(hb.y & 0xffff0000u)};
#pragma unroll
                for (int x = 0; x < 4; ++x) { v[4 * j + x] = ALPHA * a[x] + t[x]; s += v[4 * j + x]; } }
            const float mean = wave_sum(s) * (1.f / D); float q = 0.f;
#pragma unroll
            for (int i = 0; i < 16; ++i) { v[i] -= mean; q += v[i] * v[i]; }
            const float rstd = rsqrtf(wave_sum(q) * (1.f / D) + LN_EPS);
#pragma unroll
            for (int j = 0; j < 4; ++j) { const int c = 4 * lane + 256 * j; const f32x4 gg = *(const f32x4*)(g + c), b4 = *(const f32x4*)(bb + c);
                f32x4 o;
#pragma unroll
                for (int x = 0; x < 4; ++x) o[x] = v[4 * j + x] * rstd * gg[x] + b4[x];
                u32x2 w; w.x = pk2(o[0], o[1]); w.y = pk2(o[2], o[3]); *(u32x2*)(WSP(bf16_t, WS_H1B) + (size_t)row * D + c) = w;
                *(LAS f32x4*)(xs + rr * 1024 + c) = o; }
        }
        float acc[4] = {0.f, 0.f, 0.f, 0.f};
        { const float* wp = wr + (size_t)(half * 512) * NE + e_me; const LAS float* xp = xs + half * 512;
#pragma unroll 8
          for (int k = 0; k < 512; k += 4) { const float w0 = wp[(size_t)k * NE], w1 = wp[(size_t)(k + 1) * NE], w2 = wp[(size_t)(k + 2) * NE], w3 = wp[(size_t)(k + 3) * NE];
#pragma unroll
              for (int rr = 0; rr < 4; ++rr) { const f32x4 x4 = *(const LAS f32x4*)(xp + rr * 1024 + k); acc[rr] += (x4[0] * w0 + x4[1] * w1) + (x4[2] * w2 + x4[3] * w3); } } }
        const float bias = br[e_me];
#pragma unroll
        for (int rr = 0; rr < 4; ++rr) {
            const int row = 4 * gi + rr;
            float logit = acc[rr] + shx(acc[rr], 32, lane) + bias;
            float vals[4]; int ids[4];
#pragma unroll
            for (int r = 0; r < 4; ++r) {
                float bv = logit; int bi = e_me;
#pragma unroll
                for (int o = 16; o >= 1; o >>= 1) { const float ov = shx(bv, o, lane); const int oi = shxi(bi, o, lane); if (ov > bv || (ov == bv && oi < bi)) { bv = ov; bi = oi; } }
                vals[r] = bv; ids[r] = bi; if (e_me == bi) logit = -INFINITY;
            }
            float ex[4], se = 0.f;
#pragma unroll
            for (int r = 0; r < 4; ++r) { ex[r] = __expf(vals[r] - vals[0]); se += ex[r]; }
            if (lane == 0) {
#pragma unroll
                for (int r = 0; r < 4; ++r) { top_idx[row * 4 + r] = ids[r]; top_gate[row * 4 + r] = ex[r] * __builtin_amdgcn_rcpf(se); __hip_atomic_fetch_add(&hist[ids[r]], 1u, __ATOMIC_RELAXED, __HIP_MEMORY_SCOPE_WORKGROUP); }
            }
        }
    }
    __syncthreads();
    if (C.tid < NE) ((unsigned*)(P.ws + WS_RT + RT_WGCNT))[(size_t)rep * 256 * NE + C.bid * NE + C.tid] = hist[C.tid];
}
__device__ __forceinline__ void phase_scatter(const Params& P, const Ctx& C, int l, int rep) {
    LAS int* pad_start = (LAS int*)(C.lds + LDS_TAB);
    LAS unsigned* cur = (LAS unsigned*)(C.lds + LDS_TAB + 256);
    LAS unsigned* ptot = (LAS unsigned*)(C.lds + LDS_TAB + 512);
    LAS unsigned* ppre = (LAS unsigned*)(C.lds + LDS_TAB + 512 + 2048);
    const unsigned* wgcnt = (const unsigned*)(P.ws + WS_RT + RT_WGCNT);
    { const int e = C.tid & 31, part = C.tid >> 5; unsigned st = 0, sp = 0;
      unsigned cv[16];
#pragma unroll
      for (int i = 0; i < 16; ++i) { const int wb = part * 16 + i; cv[i] = wb < C.G ? wgcnt[wb * NE + e] : 0u; }
#pragma unroll
      for (int i = 0; i < 16; ++i) { const int wb = part * 16 + i; st += cv[i]; if (wb < C.bid) sp += cv[i]; }
      ptot[part * 32 + e] = st; ppre[part * 32 + e] = sp; }
    __syncthreads();
    if (C.tid < NE) { unsigned st = 0, sp = 0; for (int p = 0; p < 16; ++p) { st += ptot[p * 32 + C.tid]; sp += ppre[p * 32 + C.tid]; } ptot[C.tid] = st; ppre[C.tid] = sp; }
    __syncthreads();
    if (C.tid == 0) { int acc = 0; for (int e = 0; e < NE; ++e) { pad_start[e] = acc; cur[e] = (unsigned)acc + ppre[e]; acc += ((int)ptot[e] + MOEB - 1) / MOEB * MOEB; } pad_start[NE] = acc; }
    __syncthreads();
    const int* top_idx = (const int*)(P.ws + WS_RT + RT_TOPIDX); const float* top_gate = (const float*)(P.ws + WS_RT + RT_TOPGATE);
    int* tok_slot = (int*)(P.ws + WS_RT + RT_TOKSLOT); int* slot_tok = (int*)(P.ws + WS_RT + RT_SLOTTOK); float* slot_gate = (float*)(P.ws + WS_RT + RT_SLOTGATE);
    { const int gw = C.bid * NWAVES + C.wave, NGW = C.G * NWAVES;
      for (int gi = gw; gi < T / 4; gi += NGW) if (C.lane < 16) { const int a = 16 * gi + C.lane;
          const int e = top_idx[a]; const int slot = (int)__hip_atomic_fetch_add(&cur[e], 1u, __ATOMIC_RELAXED, __HIP_MEMORY_SCOPE_WORKGROUP);
          slot_tok[slot] = a >> 2; slot_gate[slot] = top_gate[a]; tok_slot[a] = slot; } }
    if (C.bid == 0) { int* block_e = (int*)(P.ws + WS_RT + RT_BLOCKE);
        for (int nb = C.tid; nb < NBLK; nb += NTHREADS) { int c = 0; for (int e = 0; e < NE; ++e) c += (pad_start[e + 1] <= nb * MOEB) ? 1 : 0; block_e[nb] = c < NE - 1 ? c : NE - 1; }
        if (C.tid == 0) block_e[NBLK] = pad_start[NE] / MOEB; }
    __syncthreads();
    DenseOrder S; S.init(T, D, 256, P.ws + WS_W + (size_t)l * W_LAYER + W_PP, C.G, C.bid);
    EpiB16<0> E{WSP(bf16_t, WS_PLE), D, nullptr};
    gemm_phase(C.lds, C.tid, (const char*)(P.ws + WS_PB + (size_t)l * T * 256 * 2), 256, S, E);
}
template <bool GATHER> __device__ __forceinline__ void moe_order_init(MoeOrder<GATHER>& S, const Params& P, const Ctx& C, int nN, int K, const void* Wt, size_t estride, bool mirror = false) {
    const int* block_e = (const int*)(P.ws + WS_RT + RT_BLOCKE); const int* slot_tok = (const int*)(P.ws + WS_RT + RT_SLOTTOK);
    LAS int* tab = (LAS int*)(C.lds + LDS_TAB); LAS int* ue = (LAS int*)(C.lds + LDS_UE);
    const int nblk = block_e[NBLK];
    S.nN = nN; S.nunits = nblk * nN; S.G = C.G; S.cm = (C.G % 8 == 0) ? (C.bid % 8) * (C.G / 8) + C.bid / 8 : C.bid; if (mirror) S.cm = C.G - 1 - S.cm; S.K = K; S.Wt = (const char*)Wt; S.estride = estride; S.tab = tab; S.ue = ue;
    { int ev[12], tk[12];
#pragma unroll
      for (int i = 0; i < 12; ++i) { const int L = i * S.G + S.cm; const bool ok = L < S.nunits; const int rb = ok ? L / nN : 0;
          ev[i] = (ok && C.tid < 64) ? block_e[rb] : 0; tk[i] = (GATHER && ok && C.tid < 256) ? slot_tok[rb * 256 + C.tid] : 0; }
#pragma unroll
      for (int i = 0; i < 12; ++i) { if (C.tid == 0) ue[i] = ev[i]; if (GATHER && C.tid < 256) tab[i * 256 + C.tid] = tk[i] < 0 ? 0 : tk[i]; } }
    __syncthreads();
}
__device__ __forceinline__ void phase_moe1(const Params& P, const Ctx& C, int l) {
    { DenseOrder S; S.init(T, D, D, P.ws + WS_W + (size_t)l * W_LAYER + W_PG, C.G, C.bid);
      EpiB16<1> E{WSP(bf16_t, WS_TMP), D, WSP(bf16_t, WS_PLE)};
      gemm_phase(C.lds, C.tid, (const char*)(P.ws + WS_H1B), D, S, E); }
    unsigned* ready = ctl_words(P) + CW_MOEC + l * NBLK * 16;
    { MoeOrder<true> S; moe_order_init<true>(S, P, C, 8, D, P.ws + WS_W + (size_t)l * W_LAYER + W_GU, (size_t)2048 * D * 2); S.ready = ready;
      EpiMoe1 E{P, l + 1, C.G, S.nunits, WSP(bf16_t, WS_HM), P.in[19] + (size_t)l * NE * 2048, ready, C.lds};
      gemm_phase(C.lds, C.tid, (const char*)(P.ws + WS_H1B), D, S, E); }
    { MoeOrder<false> S; moe_order_init<false>(S, P, C, 4, DFF, P.ws + WS_W + (size_t)l * W_LAYER + W_DN, (size_t)D * DFF * 2, true); S.ready = ready;
      EpiMoe2 E{WSP(bf16_t, WS_YB), P.in[21] + (size_t)l * NE * D, (const float*)(P.ws + WS_RT + RT_SLOTGATE), C.G, C.lds};
      gemm_phase(C.lds, C.tid, (const char*)(P.ws + WS_HM), DFF, S, E); }
}
__device__ __forceinline__ void phase_moe2(const Params& P, const Ctx& C, int l) {}
__device__ __forceinline__ void phase_ln2(const Params& P, const Ctx& C, int l) {
    const int gw = C.bid * NWAVES + C.wave, NGW = C.G * NWAVES, lane = C.lane;
    const bf16_t* H1B = WSP(bf16_t, WS_H1B); const bf16_t* PLE = WSP(bf16_t, WS_TMP); const bf16_t* Yb = WSP(bf16_t, WS_YB); const int* tok_slot = (const int*)(P.ws + WS_RT + RT_TOKSLOT);
    for (int row0 = gw; row0 < T; row0 += 2 * NGW) {
        int sl[2][4];
#pragma unroll
        for (int k = 0; k < 2; ++k) { const int row = row0 + k * NGW < T ? row0 + k * NGW : row0;
#pragma unroll
            for (int r = 0; r < 4; ++r) sl[k][r] = tok_slot[row * 4 + r]; }
        float v[2][16]; float s[2] = {0.f, 0.f};
#pragma unroll
        for (int k = 0; k < 2; ++k) { const int row = row0 + k * NGW < T ? row0 + k * NGW : row0;
#pragma unroll
            for (int j = 0; j < 4; ++j) { const int c = 4 * lane + 256 * j; const u32x2 hb = *(const u32x2*)(H1B + (size_t)row * D + c); const u32x2 plb = *(const u32x2*)(PLE + (size_t)row * D + c);
                float f[4] = {__uint_as_float(plb.x << 16), __uint_as_float(plb.x & 0xffff0000u), __uint_as_float(plb.y << 16), __uint_as_float(plb.y & 0xffff0000u)};
#pragma unroll
                for (int r = 0; r < 4; ++r) { const u32x2 y = *(const u32x2*)(Yb + (size_t)sl[k][r] * D + c); f[0] += __uint_as_float(y.x << 16); f[1] += __uint_as_float(y.x & 0xffff0000u); f[2] += __uint_as_float(y.y << 16); f[3] += __uint_as_float(y.y & 0xffff0000u); }
                v[k][4 * j] = ALPHA * __uint_as_float(hb.x << 16) + f[0]; v[k][4 * j + 1] = ALPHA * __uint_as_float(hb.x & 0xffff0000u) + f[1];
                v[k][4 * j + 2] = ALPHA * __uint_as_float(hb.y << 16) + f[2]; v[k][4 * j + 3] = ALPHA * __uint_as_float(hb.y & 0xffff0000u) + f[3];
                s[k] += (v[k][4 * j] + v[k][4 * j + 1]) + (v[k][4 * j + 2] + v[k][4 * j + 3]); } }
#pragma unroll
        for (int k = 0; k < 2; ++k) { const int row = row0 + k * NGW; if (row < T) {
            const float mean = wave_sum(s[k]) * (1.f / D); float q = 0.f;
#pragma unroll
            for (int i = 0; i < 16; ++i) { v[k][i] -= mean; q += v[k][i] * v[k][i]; }
            const float rstd = rsqrtf(wave_sum(q) * (1.f / D) + LN_EPS);
            float* of = (l == DEPTH - 1) ? P.out + (size_t)row * D : nullptr;
            ln_store_row(v[k], rstd, P.in[24] + l * D, P.in[25] + l * D, of, (l == DEPTH - 1) ? nullptr : WSP(bf16_t, WS_HB) + (size_t)row * D, lane); } }
    }
}

enum { PH_PRO = 0, PH_INPROJ, PH_GPREP, PH_MIX, PH_GPOST, PH_OUTPROJ, PH_LN1, PH_SCAT, PH_MOE1, PH_MOE2, PH_LN2 };
__device__ __forceinline__ Ctx make_ctx(unsigned char* lds) {
    Ctx C; C.lds = (LAS unsigned char*)lds; C.tid = threadIdx.x; C.lane = C.tid & 63; C.wave = __builtin_amdgcn_readfirstlane(C.tid >> 6); C.G = gridDim.x; C.bid = blockIdx.x; return C;
}
template <int PH> __device__ __forceinline__ void run_phase(const Params& P, const Ctx& C, int l, int rep = 0) {
    if (PH == PH_PRO) phase_prologue(P, C);
    if (PH == PH_INPROJ) phase_inproj(P, C, l);
    if (PH == PH_GPREP) phase_gprep2(P, C, l);
    if (PH == PH_MIX) phase_mix(P, C, l, rep);
    if (PH == PH_GPOST) phase_gpost(P, C, l);
    if (PH == PH_OUTPROJ) phase_outproj(P, C, l);
    if (PH == PH_LN1) phase_ln1(P, C, l, rep);
    if (PH == PH_SCAT) phase_scatter(P, C, l, rep);
    if (PH == PH_MOE1) phase_moe1(P, C, l);
    if (PH == PH_MOE2) phase_moe2(P, C, l);
    if (PH == PH_LN2) phase_ln2(P, C, l);
}
#if MK_MULTI
template <int PH> __global__ void __launch_bounds__(NTHREADS, 2) kphase(Params P, int l) {
    extern __shared__ __attribute__((aligned(16))) unsigned char lds[];
    const Ctx C = make_ctx(lds);
    run_phase<PH>(P, C, l);
}
#else
__device__ __forceinline__ Params load_params() {
    Params r{};
#if defined(__HIP_DEVICE_COMPILE__)
    const __attribute__((address_space(4))) unsigned long long* p = (const __attribute__((address_space(4))) unsigned long long*)__builtin_amdgcn_kernarg_segment_ptr();
    asm volatile("" : "+s"(p));
#pragma unroll
    for (int i = 0; i < 26; ++i) r.in[i] = (const float*)(const __attribute__((address_space(1))) float*)p[i];
    r.out = (float*)(__attribute__((address_space(1))) float*)p[26]; r.ws = (unsigned char*)(__attribute__((address_space(1))) unsigned char*)p[27];
#endif
    return r;
}
__device__ __forceinline__ Ctx make_ctx_opaque(unsigned char* lds) {
    int t = threadIdx.x, b = blockIdx.x, g = gridDim.x; asm volatile("" : "+v"(t)); asm volatile("" : "+s"(b), "+s"(g));
    LAS unsigned char* lp = (LAS unsigned char*)lds; asm volatile("" : "+s"(lp));
    Ctx C; C.lds = lp; C.tid = t; C.lane = t & 63; C.wave = __builtin_amdgcn_readfirstlane(t >> 6); C.G = g; C.bid = b; return C;
}
#define GRID_BAR() do { XcdBarrier b2 = bar; asm volatile("" : "+s"(b2.bar), "+s"(b2.x)); xcd_barrier(b2); } while (0)
#ifndef PROBE_MASK
#define PROBE_MASK 0
#endif
#define PHASE1(PH, l, rep) do { asm volatile("; PHASE_BEGIN " #PH); const Params Pl = load_params(); const Ctx Cl = make_ctx_opaque(lds); run_phase<PH>(Pl, Cl, (l), (rep)); asm volatile("; PHASE_END " #PH); } while (0)
#define PHASE(PH, l) do { PHASE1(PH, l, 0); if ((PROBE_MASK >> PH) & 1) { GRID_BAR(); PHASE1(PH, l, 1); } } while (0)
__global__ void __launch_bounds__(NTHREADS, 2) mega(Params Pk) {
    extern __shared__ __attribute__((aligned(16))) unsigned char lds[];
    const Ctx C = make_ctx(lds);
    if (C.tid < 4) ((LAS unsigned*)(C.lds + LDS_MISC))[C.tid] = 0u;
    __syncthreads();
    XcdBarrier bar;
    { const Params Pl = load_params(); bar = xcd_barrier_post(ctl_words(Pl) + CW_BAR, (volatile LAS unsigned*)(C.lds + LDS_MISC)); }
    PHASE(PH_PRO, 0); GRID_BAR();
#define LAYER(l) do { PHASE(PH_INPROJ, l); GRID_BAR(); PHASE(PH_GPREP, l); GRID_BAR(); PHASE(PH_MIX, l); GRID_BAR(); PHASE(PH_GPOST, l); GRID_BAR(); \
        PHASE(PH_OUTPROJ, l); GRID_BAR(); PHASE(PH_LN1, l); GRID_BAR(); PHASE(PH_SCAT, l); GRID_BAR(); PHASE(PH_MOE1, l); GRID_BAR(); \
        PHASE(PH_LN2, l); if ((l) + 1 < DEPTH) GRID_BAR(); } while (0)
    LAYER(0); LAYER(1); LAYER(2); LAYER(3);
}
#endif
}

extern "C" void kernel_launch(void* const* d_in, const int* in_sizes, int n_in, void* d_out, int out_size, void* d_ws, size_t ws_size, hipStream_t stream) {
    static int grid = 0;
    if (grid == 0) {
        if (n_in != 26 || out_size != T * D || ws_size < WS_END) { fprintf(stderr, "kernel_launch: unexpected shapes (n_in %d out %d ws %zu need %zu)\n", n_in, out_size, ws_size, (size_t)WS_END); grid = -1; return; }
        int dev = 0, cus = 0; hipGetDevice(&dev); hipDeviceGetAttribute(&cus, hipDeviceAttributeMultiprocessorCount, dev);
#if MK_MULTI
#define SETATTR(PH) hipFuncSetAttribute((const void*)kphase<PH>, hipFuncAttributeMaxDynamicSharedMemorySize, LDS_BYTES)
        SETATTR(PH_PRO); SETATTR(PH_INPROJ); SETATTR(PH_GPREP); SETATTR(PH_MIX); SETATTR(PH_GPOST); SETATTR(PH_OUTPROJ); SETATTR(PH_LN1); SETATTR(PH_SCAT); SETATTR(PH_MOE1); SETATTR(PH_MOE2); SETATTR(PH_LN2);
#else
        hipFuncSetAttribute((const void*)mega, hipFuncAttributeMaxDynamicSharedMemorySize, LDS_BYTES);
        int per_cu = 0; hipOccupancyMaxActiveBlocksPerMultiprocessor(&per_cu, (const void*)mega, NTHREADS, LDS_BYTES);
        if (per_cu < 1) fprintf(stderr, "kernel_launch: occupancy query reports %d blocks per CU\n", per_cu);
#endif
        (void)hipGetLastError();
        grid = cus > 0 ? cus : 256;
    }
    if (grid < 0) return;
    hipMemsetAsync((char*)d_ws + WS_CTL, 0, CTL_BYTES, stream);
    Params P{};
    for (int i = 0; i < 26; ++i) P.in[i] = (const float*)d_in[i];
    P.out = (float*)d_out; P.ws = (unsigned char*)d_ws;
#if MK_MULTI
#define LAUNCH(PH, l) hipLaunchKernelGGL(kphase<PH>, dim3(grid), dim3(NTHREADS), LDS_BYTES, stream, P, l)
    LAUNCH(PH_PRO, 0);
    for (int l = 0; l < DEPTH; ++l) {
        LAUNCH(PH_INPROJ, l); LAUNCH(PH_GPREP, l); LAUNCH(PH_MIX, l); LAUNCH(PH_GPOST, l); LAUNCH(PH_OUTPROJ, l);
        LAUNCH(PH_LN1, l); LAUNCH(PH_SCAT, l); LAUNCH(PH_MOE1, l); LAUNCH(PH_MOE2, l); LAUNCH(PH_LN2, l);
    }
#else
    hipLaunchKernelGGL(mega, dim3(grid), dim3(NTHREADS), LDS_BYTES, stream, P);
#endif
}
```
